# Optimizing an MI355X kernel written in HIP

```python
import jax
import jax.numpy as jnp
from jax import lax
import numpy as np

D_MODEL = 2048
BATCH = 2
SEQ = 8192
DEPTH = 1

HEAD_DIM = 128
GRID_W = 64
NA_HEADS = 8
NA_KH = 8
NA_KW = 16
NA_QC = 16
NA_KC = NA_QC + NA_KW
DIL_GROUPS = ((128, 1), (512, 4), (2048, 16))
DIL_HEADS_PER_GROUP = 4
DIL_HEADS = DIL_HEADS_PER_GROUP * len(DIL_GROUPS)
DIL_BLOCK = 128
N_GROUPS = 8
EXPERTS_PER_GROUP = 8
N_EXPERTS = N_GROUPS * EXPERTS_PER_GROUP
TOP_K = 2
D_EXPERT = D_MODEL // 4
MOE_BLOCK = 128
LN_EPS = 1e-5
DN_ALPHA = (2 * DEPTH) ** 0.25
DN_BETA = (8 * DEPTH) ** -0.25
NA_WIDTH = NA_HEADS * HEAD_DIM
DIL_WIDTH = DIL_HEADS * HEAD_DIM
DIL_OUT_WIDTH = DIL_HEADS_PER_GROUP * HEAD_DIM
IN_WIDTHS = (NA_WIDTH, NA_WIDTH, NA_WIDTH, DIL_WIDTH, DIL_WIDTH, DIL_WIDTH, D_MODEL, D_MODEL)

kernel_name = 'hybrid_natten_dilated_hmoe_deepnorm'


def layer_norm(x, g, b):
    xf = x.astype(jnp.float32)
    mu = jnp.mean(xf, axis=-1, keepdims=True)
    var = jnp.mean(jnp.square(xf - mu), axis=-1, keepdims=True)
    y = (xf - mu) * lax.rsqrt(var + LN_EPS)
    return (y * g.astype(jnp.float32) + b.astype(jnp.float32)).astype(x.dtype)


def alibi_slopes(n):
    return np.array([2.0 ** (-8.0 * (i + 1) / n) for i in range(n)], dtype=np.float32)


def neighborhood_attention(q, k, v, rpb):
    B, H, S, hd = q.shape
    rows = S // GRID_W
    kh = min(NA_KH, rows)
    nc = GRID_W // NA_QC
    K = kh * NA_KC
    chunk_c0 = np.arange(nc) * NA_QC
    kc_start = np.clip(chunk_c0 - NA_KW // 2, 0, GRID_W - NA_KC)
    key_cols = kc_start[:, None] + np.arange(NA_KC)[None, :]
    qcol = chunk_c0[:, None] + np.arange(NA_QC)[None, :]
    qcs = np.clip(qcol - NA_KW // 2, 0, GRID_W - NA_KW)
    kc_slot = np.tile(key_cols, (1, kh))
    valid = jnp.asarray((kc_slot[:, None, :] >= qcs[:, :, None]) &
                        (kc_slot[:, None, :] < qcs[:, :, None] + NA_KW))
    dc = jnp.asarray(np.clip(kc_slot[:, None, :] - qcol[:, :, None] + NA_KW - 1,
                             0, 2 * NA_KW - 2), jnp.int32)
    ri_slot = jnp.asarray(np.repeat(np.arange(kh), NA_KC), jnp.int32)
    qg = q.reshape(B, H, rows, nc, NA_QC, hd)
    kg = k.reshape(B, H, rows, GRID_W, hd)
    vg = v.reshape(B, H, rows, GRID_W, hd)
    scale = HEAD_DIM ** -0.5

    def row_block(r):
        start = jnp.clip(r - kh // 2, 0, rows - kh)
        qr = lax.dynamic_index_in_dim(qg, r, axis=2, keepdims=False)
        kr = lax.dynamic_slice_in_dim(kg, start, kh, axis=2)[:, :, :, key_cols]
        vr = lax.dynamic_slice_in_dim(vg, start, kh, axis=2)[:, :, :, key_cols]
        kb = kr.transpose(0, 1, 3, 2, 4, 5).reshape(B, H, nc, K, hd)
        vb = vr.transpose(0, 1, 3, 2, 4, 5).reshape(B, H, nc, K, hd)
        dr = start - r + ri_slot + (NA_KH - 1)
        bias = rpb[:, dr[None, None, :], dc].astype(jnp.float32)
        s = jnp.einsum('bhcqe,bhcke->bhcqk', qr, kb,
                       preferred_element_type=jnp.float32) * scale + bias
        s = jnp.where(valid, s, -jnp.inf)
        p = jax.nn.softmax(s, axis=-1).astype(v.dtype)
        o = jnp.einsum('bhcqk,bhcke->bhcqe', p, vb)
        return o.reshape(B, H, GRID_W, hd)

    out = lax.map(row_block, jnp.arange(rows, dtype=jnp.int32))
    return out.transpose(1, 2, 0, 3, 4).reshape(B, H, S, hd)


def dilated_window_attention(q, k, v, slopes, dilation, half_w):
    B, G, S, hd = q.shape
    L = S // dilation
    blk = min(DIL_BLOCK, L)
    nb = -(-L // blk)
    Lp = nb * blk
    K = blk + 2 * half_w

    def split(t):
        return t.reshape(B, G, L, dilation, hd).transpose(0, 1, 3, 2, 4)

    qs = jnp.pad(split(q), ((0, 0), (0, 0), (0, 0), (0, Lp - L), (0, 0)))
    qs = qs.reshape(B, G, dilation, nb, blk, hd)
    pad_kv = ((0, 0), (0, 0), (0, 0), (half_w, Lp - L + half_w), (0, 0))
    kidx = np.arange(nb)[:, None] * blk + np.arange(K)[None, :]
    kb = jnp.pad(split(k), pad_kv)[:, :, :, kidx]
    vb = jnp.pad(split(v), pad_kv)[:, :, :, kidx]
    qpos = np.arange(nb)[:, None] * blk + np.arange(blk)[None, :]
    kpos = kidx - half_w
    rel = kpos[:, None, :] - qpos[:, :, None]
    in_seq = (kpos[:, None, :] >= 0) & (kpos[:, None, :] < L)
    valid = jnp.asarray((np.abs(rel) <= half_w) & (in_seq | (rel == 0)))
    dist = jnp.asarray(np.abs(rel) * dilation, jnp.float32)
    alibi = -jnp.asarray(slopes, jnp.float32)[:, None, None, None, None] * dist
    s = jnp.einsum('bgdnqe,bgdnke->bgdnqk', qs, kb,
                   preferred_element_type=jnp.float32) * HEAD_DIM ** -0.5 + alibi
    s = jnp.where(valid, s, -jnp.inf)
    lse = jax.nn.logsumexp(s, axis=-1)
    p = jnp.exp(s - lse[..., None]).astype(v.dtype)
    o = jnp.einsum('bgdnqk,bgdnke->bgdnqe', p, vb)
    o = o.reshape(B, G, dilation, Lp, hd)[:, :, :, :L].transpose(0, 1, 3, 2, 4).reshape(B, G, S, hd)
    lse = lse.reshape(B, G, dilation, Lp)[..., :L].transpose(0, 1, 3, 2).reshape(B, G, S)
    return o, lse


def dilated_mixture(q, k, v):
    slopes = alibi_slopes(DIL_HEADS)
    G = DIL_HEADS_PER_GROUP
    outs, lses = [], []
    for g, (window, dil) in enumerate(DIL_GROUPS):
        sl = slice(g * G, (g + 1) * G)
        o, lse = dilated_window_attention(q[:, sl], k[:, sl], v[:, sl], slopes[sl],
                                          dil, (window // 2) // dil)
        outs.append(o)
        lses.append(lse)
    w = jax.nn.softmax(jnp.stack(lses), axis=0)
    o = jnp.sum(w[..., None] * jnp.stack(outs).astype(jnp.float32), axis=0)
    return o.astype(q.dtype)


def token_mixer(h, w_in, b_in, rpb, w_proj_a, w_proj_b, w_o, b_o):
    B, S, D = h.shape
    z = jnp.einsum('bsd,de->bse', h, w_in) + b_in
    splits = np.cumsum(IN_WIDTHS)[:-1].tolist()
    qa, ka, va, qb, kb, vb, ga, gb = jnp.split(z, splits, axis=-1)

    def heads(t, n):
        return t.reshape(B, S, n, HEAD_DIM).transpose(0, 2, 1, 3)

    ya = neighborhood_attention(heads(qa, NA_HEADS), heads(ka, NA_HEADS), heads(va, NA_HEADS), rpb)
    ya = ya.transpose(0, 2, 1, 3).reshape(B, S, NA_WIDTH) @ w_proj_a
    yb = dilated_mixture(heads(qb, DIL_HEADS), heads(kb, DIL_HEADS), heads(vb, DIL_HEADS))
    yb = yb.transpose(0, 2, 1, 3).reshape(B, S, DIL_OUT_WIDTH) @ w_proj_b
    m = jax.nn.sigmoid(ga) * ya + jax.nn.sigmoid(gb) * yb
    return m @ w_o + b_o


def hierarchical_moe(h, w_rg, b_rg, w_re, b_re, w_gate, w_up, w_down):
    B, S, D = h.shape
    N = B * S
    xf = h.reshape(N, D)
    g_logits = (xf @ w_rg + b_rg).astype(jnp.float32)
    g_sel = jnp.argmax(g_logits, axis=-1).astype(jnp.int32)
    g_prob = jnp.take_along_axis(jax.nn.softmax(g_logits, axis=-1), g_sel[:, None], axis=-1)
    e_logits = (xf @ w_re + b_re).astype(jnp.float32).reshape(N, N_GROUPS, EXPERTS_PER_GROUP)
    e_logits = jnp.take_along_axis(e_logits, g_sel[:, None, None], axis=1)[:, 0]
    top_val, top_idx = lax.top_k(e_logits, TOP_K)
    gate = g_prob * jax.nn.softmax(top_val, axis=-1)
    expert_id = (g_sel[:, None] * EXPERTS_PER_GROUP + top_idx).astype(jnp.int32)

    A = N * TOP_K
    e_flat = expert_id.reshape(A)
    w_flat = gate.reshape(A).astype(h.dtype)
    tok = jnp.repeat(jnp.arange(N, dtype=jnp.int32), TOP_K)
    order = jnp.argsort(e_flat)
    e_s, tok_s, w_s = e_flat[order], tok[order], w_flat[order]
    counts = jnp.bincount(e_flat, length=N_EXPERTS).astype(jnp.int32)
    starts = jnp.cumsum(counts) - counts
    pcounts = (counts + MOE_BLOCK - 1) // MOE_BLOCK * MOE_BLOCK
    pends = jnp.cumsum(pcounts)
    pstarts = pends - pcounts
    dest = pstarts[e_s] + (jnp.arange(A, dtype=jnp.int32) - starts[e_s])
    nb = -(-A // MOE_BLOCK) + N_EXPERTS
    P = nb * MOE_BLOCK
    slot_tok = jnp.full((P,), N, jnp.int32).at[dest].set(tok_s)
    slot_w = jnp.zeros((P,), h.dtype).at[dest].set(w_s)
    block_e = jnp.minimum(jnp.searchsorted(pends, jnp.arange(nb, dtype=jnp.int32) * MOE_BLOCK,
                                           side='right'), N_EXPERTS - 1).astype(jnp.int32)
    xpad = jnp.concatenate([xf, jnp.zeros((1, D), xf.dtype)], axis=0)
    xs = xpad[slot_tok].reshape(nb, MOE_BLOCK, D)

    def expert_block(args):
        xb, e = args
        hid = jax.nn.silu(xb @ w_gate[e]) * (xb @ w_up[e])
        return hid @ w_down[e]

    ys = lax.map(expert_block, (xs, block_e)).reshape(P, D) * slot_w[:, None]
    y = jax.ops.segment_sum(ys, slot_tok, num_segments=N + 1)[:N]
    return y.reshape(B, S, D)


def setup_inputs(seed: int = 0) -> dict:
    key = jax.random.key(seed)
    ks = jax.random.split(key, 24)

    def nrm(k, shape, scale):
        return jax.random.normal(k, shape, jnp.float32) * scale

    col_scale = np.concatenate([np.full((w,), DN_BETA if i in (2, 5) else 1.0, np.float32)
                                for i, w in enumerate(IN_WIDTHS)])
    d_in = int(sum(IN_WIDTHS))
    return {
        'x': nrm(ks[0], (BATCH, SEQ, D_MODEL), 1.0),
        'ln0_g': 1.0 + nrm(ks[1], (D_MODEL,), 0.02),
        'ln0_b': nrm(ks[2], (D_MODEL,), 0.02),
        'w_in': nrm(ks[3], (DEPTH, D_MODEL, d_in), D_MODEL ** -0.5) * jnp.asarray(col_scale),
        'b_in': nrm(ks[4], (DEPTH, d_in), 0.02),
        'rpb': nrm(ks[5], (DEPTH, NA_HEADS, 2 * NA_KH - 1, 2 * NA_KW - 1), 0.1),
        'w_proj_a': nrm(ks[6], (DEPTH, NA_WIDTH, D_MODEL), NA_WIDTH ** -0.5 * DN_BETA),
        'w_proj_b': nrm(ks[7], (DEPTH, DIL_OUT_WIDTH, D_MODEL), DIL_OUT_WIDTH ** -0.5 * DN_BETA),
        'w_o': nrm(ks[8], (DEPTH, D_MODEL, D_MODEL), D_MODEL ** -0.5 * DN_BETA),
        'b_o': nrm(ks[9], (DEPTH, D_MODEL), 0.02),
        'ln1_g': 1.0 + nrm(ks[10], (DEPTH, D_MODEL), 0.02),
        'ln1_b': nrm(ks[11], (DEPTH, D_MODEL), 0.02),
        'w_router_group': nrm(ks[12], (DEPTH, D_MODEL, N_GROUPS), D_MODEL ** -0.5),
        'b_router_group': nrm(ks[13], (DEPTH, N_GROUPS), 0.01),
        'w_router_expert': nrm(ks[14], (DEPTH, D_MODEL, N_EXPERTS), D_MODEL ** -0.5),
        'b_router_expert': nrm(ks[15], (DEPTH, N_EXPERTS), 0.01),
        'w_gate': nrm(ks[16], (DEPTH, N_EXPERTS, D_MODEL, D_EXPERT), D_MODEL ** -0.5 * DN_BETA),
        'w_up': nrm(ks[17], (DEPTH, N_EXPERTS, D_MODEL, D_EXPERT), D_MODEL ** -0.5 * DN_BETA),
        'w_down': nrm(ks[18], (DEPTH, N_EXPERTS, D_EXPERT, D_MODEL), D_EXPERT ** -0.5 * DN_BETA),
        'ln2_g': 1.0 + nrm(ks[19], (DEPTH, D_MODEL), 0.02),
        'ln2_b': nrm(ks[20], (DEPTH, D_MODEL), 0.02),
    }


def reference(x, ln0_g, ln0_b, w_in, b_in, rpb, w_proj_a, w_proj_b, w_o, b_o, ln1_g, ln1_b,
              w_router_group, b_router_group, w_router_expert, b_router_expert,
              w_gate, w_up, w_down, ln2_g, ln2_b):
    h = layer_norm(x, ln0_g, ln0_b)
    for l in range(DEPTH):
        mix = token_mixer(h, w_in[l], b_in[l], rpb[l], w_proj_a[l], w_proj_b[l], w_o[l], b_o[l])
        h = layer_norm(DN_ALPHA * h + mix, ln1_g[l], ln1_b[l])
        ffn = hierarchical_moe(h, w_router_group[l], b_router_group[l], w_router_expert[l],
                               b_router_expert[l], w_gate[l], w_up[l], w_down[l])
        h = layer_norm(DN_ALPHA * h + ffn, ln2_g[l], ln2_b[l])
    return h
```

```cpp
#include <hip/hip_runtime.h>
#include <hip/hip_cooperative_groups.h>
#include <cstdio>
#include <cstdint>
namespace pg8 {
#define PG8_LAS __attribute__((address_space(3)))
typedef unsigned short bf16_t;
typedef short bf16x8 __attribute__((ext_vector_type(8)));
typedef float f32x4 __attribute__((ext_vector_type(4)));
typedef unsigned u32x4 __attribute__((ext_vector_type(4)));
constexpr int BM = 256, BK = 64, HALF = 128, HTB = HALF * BK * 2  , STAGE_BYTES = 8 * HTB, NXCD = 8, WGM = 8;

__host__ __device__ __forceinline__ int lds_byte(int r, int c) { const int st = (r >> 4) * 2 + (c >> 5), rr = r & 15, cc = c & 31, ob = rr * 64 + cc * 2; return st * 1024 + (ob ^ (((ob >> 9) & 1) << 5)); }
__host__ __device__ __forceinline__ void stage_rc(int b, int& R, int& C) { const int st = b / 1024, sb = b % 1024, swz = sb ^ (((sb >> 9) & 1) << 5); R = (st >> 1) * 16 + swz / 64; C = (st & 1) * 32 + (swz % 64) / 2; }
__host__ __device__ __forceinline__ int perm32(int rho) { const int n = rho >> 4, i = rho & 15; return 8 * (i >> 2) + 4 * n + (i & 3); }

struct Unit { int pm, pn; };
struct Gemm { const bf16_t* A; const bf16_t* Bt; int M, N, K; };

struct StaticOrder {
    int nM, nN, nwg, G, c;
    __host__ __device__ void init(int M, int N, int G_, int c_) { nM = M / BM; nN = N / BM; nwg = nM * nN; G = G_; c = c_; }
    __host__ __device__ bool next(int i, Unit& u) const {
        const long L = (long)i * G + c; if (L >= nwg) return false;
        int wgid = (int)L; { const int q = nwg / NXCD, r = nwg % NXCD, xcd = wgid % NXCD, off = wgid / NXCD; wgid = (xcd < r ? xcd * (q + 1) : r * (q + 1) + (xcd - r) * q) + off; }
        const int nig = WGM * nN, gid = wgid / nig, fm = gid * WGM, gsz = (nM - fm) < WGM ? (nM - fm) : WGM;
        u.pm = fm + ((wgid % nig) % gsz); u.pn = (wgid % nig) / gsz; return true;
    }
    __device__ __forceinline__ void a_ready(const Unit&) const {}
    __device__ __forceinline__ void done(const Unit&) const {}
};
__device__ __forceinline__ unsigned cvt_pk_bf16(float lo, float hi) { unsigned r; asm volatile("v_cvt_pk_bf16_f32 %0, %1, %2" : "=v"(r) : "v"(lo), "v"(hi)); return r; }
typedef float f32x2 __attribute__((ext_vector_type(2)));
__device__ __forceinline__ float sigm(float x) { return __builtin_amdgcn_rcpf(1.0f + __builtin_amdgcn_exp2f(-1.4426950408889634f * x)); }
__device__ __forceinline__ float bf_lo(unsigned w) { return __uint_as_float(w << 16); }
__device__ __forceinline__ float bf_hi(unsigned w) { return __uint_as_float(w & 0xffff0000u); }
struct EpiZ {
    static constexpr bool PERM = true, AFTER_DRAIN = false;
    bf16_t* O; int ldc; const float* bias; int sig_pn;
    __device__ __forceinline__ void operator()(const f32x4 (&acc)[2][2][4][2], const Unit& u, int wr, int wc, int fr, int fq) const {
        const int row0 = u.pm * BM + wr * 64 + fr, col0 = u.pn * BM + wc * 32 + 8 * fq; const bool sg = u.pn >= sig_pn;
        f32x4 bv[2][2];
#pragma unroll
        for (int bj = 0; bj < 2; ++bj)
#pragma unroll
            for (int n = 0; n < 2; ++n) bv[bj][n] = *(const f32x4*)(bias + col0 + bj * HALF + 4 * n);
#pragma unroll
        for (int ai = 0; ai < 2; ++ai)
#pragma unroll
            for (int m = 0; m < 4; ++m) { bf16_t* rowp = O + (size_t)(row0 + ai * HALF + m * 16) * ldc + col0;
#pragma unroll
                for (int bj = 0; bj < 2; ++bj) { f32x4 v0 = acc[ai][bj][m][0] + bv[bj][0], v1 = acc[ai][bj][m][1] + bv[bj][1];
                    if (sg) {
#pragma unroll
                        for (int j = 0; j < 4; ++j) { v0[j] = sigm(v0[j]); v1[j] = sigm(v1[j]); } }
                    u32x4 w; w.x = cvt_pk_bf16(v0[0], v0[1]); w.y = cvt_pk_bf16(v0[2], v0[3]); w.z = cvt_pk_bf16(v1[0], v1[1]); w.w = cvt_pk_bf16(v1[2], v1[3]);
                    *(u32x4*)(rowp + bj * HALF) = w; } }
    }
};
template <int MODE> struct EpiGate {
    static constexpr bool PERM = true, AFTER_DRAIN = false;
    bf16_t* O; const bf16_t* T; const bf16_t* gate; int ldg;
    __device__ __forceinline__ void operator()(const f32x4 (&acc)[2][2][4][2], const Unit& u, int wr, int wc, int fr, int fq) const {
        const int row0 = u.pm * BM + wr * 64 + fr, col0 = u.pn * BM + wc * 32 + 8 * fq;
#pragma unroll
        for (int ai = 0; ai < 2; ++ai)
#pragma unroll
            for (int m = 0; m < 4; ++m) { const size_t r = (size_t)(row0 + ai * HALF + m * 16);
#pragma unroll
                for (int bj = 0; bj < 2; ++bj) {
                    const u32x4 gw = *(const u32x4*)(gate + r * ldg + col0 + bj * HALF);
                    f32x4 v0 = acc[ai][bj][m][0], v1 = acc[ai][bj][m][1];
                    v0[0] *= bf_lo(gw.x); v0[1] *= bf_hi(gw.x); v0[2] *= bf_lo(gw.y); v0[3] *= bf_hi(gw.y);
                    v1[0] *= bf_lo(gw.z); v1[1] *= bf_hi(gw.z); v1[2] *= bf_lo(gw.w); v1[3] *= bf_hi(gw.w);
                    if (MODE == 1) { const u32x4 tw = *(const u32x4*)(T + r * 2048 + col0 + bj * HALF);
                        v0[0] += bf_lo(tw.x); v0[1] += bf_hi(tw.x); v0[2] += bf_lo(tw.y); v0[3] += bf_hi(tw.y);
                        v1[0] += bf_lo(tw.z); v1[1] += bf_hi(tw.z); v1[2] += bf_lo(tw.w); v1[3] += bf_hi(tw.w); }
                    u32x4 w; w.x = cvt_pk_bf16(v0[0], v0[1]); w.y = cvt_pk_bf16(v0[2], v0[3]); w.z = cvt_pk_bf16(v1[0], v1[1]); w.w = cvt_pk_bf16(v1[2], v1[3]);
                    *(u32x4*)(O + r * 2048 + col0 + bj * HALF) = w; } }
    }
};
struct EpiY1 {
    static constexpr bool PERM = false, AFTER_DRAIN = false;
    float* Y; const float* X; const float* stats; const float* g0; const float* b0; const float* bo; float alpha;
    __device__ __forceinline__ void operator()(const f32x4 (&acc)[2][2][4][2], const Unit& u, int wr, int wc, int fr, int fq) const {
        const int row0 = u.pm * BM + wr * 64 + fr, col0 = u.pn * BM + wc * 32 + 4 * fq;
        f32x4 ag[2][2], cb[2][2];
#pragma unroll
        for (int bj = 0; bj < 2; ++bj)
#pragma unroll
            for (int n = 0; n < 2; ++n) { const int c = col0 + bj * HALF + n * 16; ag[bj][n] = *(const f32x4*)(g0 + c) * alpha; cb[bj][n] = *(const f32x4*)(b0 + c) * alpha + *(const f32x4*)(bo + c); }
#pragma unroll
        for (int ai = 0; ai < 2; ++ai)
#pragma unroll
            for (int m = 0; m < 4; ++m) { const size_t r = (size_t)(row0 + ai * HALF + m * 16); const float mu = stats[2 * r], rs = stats[2 * r + 1];
#pragma unroll
                for (int bj = 0; bj < 2; ++bj)
#pragma unroll
                    for (int n = 0; n < 2; ++n) { const size_t o = r * 2048 + col0 + bj * HALF + n * 16; const f32x4 xv = *(const f32x4*)(X + o);
                        *(f32x4*)(Y + o) = (xv - mu) * rs * ag[bj][n] + cb[bj][n] + acc[ai][bj][m][n]; }
                asm volatile("" ::: "memory"); }
    }
};
struct EpiSwiGLU {
    static constexpr bool PERM = true, AFTER_DRAIN = false;
    bf16_t* H;
    __device__ __forceinline__ void operator()(const f32x4 (&acc)[2][2][4][2], const Unit& u, int wr, int wc, int fr, int fq) const {
        const int row0 = u.pm * BM + wr * 64 + fr, col0 = (u.pn & 3) * 128 + wc * 32 + 8 * fq;
#pragma unroll
        for (int ai = 0; ai < 2; ++ai)
#pragma unroll
            for (int m = 0; m < 4; ++m) { f32x4 v0, v1;
#pragma unroll
                for (int j = 0; j < 4; ++j) { const float a = acc[ai][0][m][0][j], b = acc[ai][0][m][1][j]; v0[j] = a * sigm(a) * acc[ai][1][m][0][j]; v1[j] = b * sigm(b) * acc[ai][1][m][1][j]; }
                u32x4 w; w.x = cvt_pk_bf16(v0[0], v0[1]); w.y = cvt_pk_bf16(v0[2], v0[3]); w.z = cvt_pk_bf16(v1[0], v1[1]); w.w = cvt_pk_bf16(v1[2], v1[3]);
                *(u32x4*)(H + (size_t)(row0 + ai * HALF + m * 16) * 512 + col0) = w; }
    }
};
struct EpiYs {
    static constexpr bool PERM = true, AFTER_DRAIN = false;
    bf16_t* O; int ldc; int pn_mask;
    __device__ __forceinline__ void operator()(const f32x4 (&acc)[2][2][4][2], const Unit& u, int wr, int wc, int fr, int fq) const {
        const int row0 = u.pm * BM + wr * 64 + fr, col0 = (u.pn & pn_mask) * BM + wc * 32 + 8 * fq;
#pragma unroll
        for (int ai = 0; ai < 2; ++ai)
#pragma unroll
            for (int m = 0; m < 4; ++m) { bf16_t* rowp = O + (size_t)(row0 + ai * HALF + m * 16) * ldc + col0;
#pragma unroll
                for (int bj = 0; bj < 2; ++bj) { const f32x4 v0 = acc[ai][bj][m][0], v1 = acc[ai][bj][m][1];
                    u32x4 w; w.x = cvt_pk_bf16(v0[0], v0[1]); w.y = cvt_pk_bf16(v0[2], v0[3]); w.z = cvt_pk_bf16(v1[0], v1[1]); w.w = cvt_pk_bf16(v1[2], v1[3]);
                    *(u32x4*)(rowp + bj * HALF) = w; } }
    }
};
struct MoeOrder {
    const int* tile_e; int ntiles, nper, G, c;
    __device__ __forceinline__ bool next(int i, Unit& u) const {
        const long L = (long)i * G + c; if (L >= (long)ntiles * nper) return false;
        const int j = (int)(L / nper), t = (int)(L % nper); u.pm = j; u.pn = tile_e[j] * nper + t; return true;
    }
    __device__ __forceinline__ void a_ready(const Unit&) const {}
    __device__ __forceinline__ void done(const Unit&) const {}
};
template <class Epi, class Sched, bool ALIGN_EPI = false, bool SP2 = false>
__device__ __forceinline__ void gemm_phase(PG8_LAS unsigned char* lds, const Gemm g, const Sched& S, const Epi& E) {
    const int tid = threadIdx.x, wid = __builtin_amdgcn_readfirstlane(tid >> 6), lane = tid & 63, wr = wid >> 2, wc = wid & 3, fr = lane & 15, fq = lane >> 4;
    const int K = g.K, nt = K / BK;
    unsigned voffA[2], voffB[2];
#pragma unroll
    for (int i = 0; i < 2; ++i) { int R, C; stage_rc(tid * 16 + i * 8192, R, C); const int Rb = Epi::PERM ? ((R & ~31) + perm32(R & 31)) : R;
        voffA[i] = (unsigned)(R * K + C) * 2u; voffB[i] = (unsigned)(Rb * K + C) * 2u; }
    const size_t kstep = (size_t)(BK * 2);
    const size_t hstep = (size_t)HALF * K * 2;
    const size_t tstep = 2 * hstep;
    const unsigned ldsw = (unsigned)wid * 1024u;
    const int aoff = lds_byte(wr * 64 + fr, fq * 8), boff = lds_byte(wc * 32 + fr, fq * 8);
#define PG8_SA(b, h) (((b) * 2 + (h)) * HTB)
#define PG8_SB(b, h) ((4 + (b) * 2 + (h)) * HTB)
#define PG8_STAGE(bufoff, gbase, voff) do { _Pragma("unroll") for (int _i = 0; _i < 2; ++_i) \
        __builtin_amdgcn_global_load_lds((const unsigned*)((const char*)(gbase) + (voff)[_i]), (PG8_LAS unsigned*)(lds + (bufoff) + ldsw + _i * 8192), 16, 0, 0); } while (0)
#define PG8_LDA(dst, b, h) do { _Pragma("unroll") for (int m = 0; m < 4; ++m) _Pragma("unroll") for (int k = 0; k < 2; ++k) dst[m][k] = *(const PG8_LAS bf16x8*)(lds + PG8_SA(b, h) + aoff + m * 2048 + k * 1024); } while (0)
#define PG8_LDB(dst, b, h) do { _Pragma("unroll") for (int n = 0; n < 2; ++n) _Pragma("unroll") for (int k = 0; k < 2; ++k) dst[n][k] = *(const PG8_LAS bf16x8*)(lds + PG8_SB(b, h) + boff + n * 2048 + k * 1024); } while (0)
#define PG8_MMA(ai, bj, At, Bt) do { __builtin_amdgcn_s_setprio(1); _Pragma("unroll") for (int m = 0; m < 4; ++m) _Pragma("unroll") for (int n = 0; n < 2; ++n) _Pragma("unroll") for (int k = 0; k < 2; ++k) \
        acc[ai][bj][m][n] = __builtin_amdgcn_mfma_f32_16x16x32_bf16(Bt[n][k], At[m][k], acc[ai][bj][m][n], 0, 0, 0); __builtin_amdgcn_s_setprio(0); } while (0)
#define PG8_WAIT_V(n) asm volatile("s_waitcnt vmcnt(" #n ")" ::: "memory")
#define PG8_WAIT_L(n) asm volatile("s_waitcnt lgkmcnt(" #n ")" ::: "memory")
#define PG8_BAR __builtin_amdgcn_s_barrier()
#define PG8_SCHED __builtin_amdgcn_sched_barrier(0)
    Unit cur, nxt; int ui = 0;
    if (!S.next(0, cur)) return;
    f32x4 acc[2][2][4][2];
#pragma unroll
    for (int a = 0; a < 2; ++a)
#pragma unroll
        for (int b = 0; b < 2; ++b)
#pragma unroll
            for (int m = 0; m < 4; ++m)
#pragma unroll
                for (int n = 0; n < 2; ++n) acc[a][b][m][n] = (f32x4){0.f, 0.f, 0.f, 0.f};
    bf16x8 At[4][2], B0[2][2], B1[2][2];
    const char* cA = (const char*)g.A + (size_t)cur.pm * tstep; const char* cB = (const char*)g.Bt + (size_t)cur.pn * tstep;
    S.a_ready(cur);
    if constexpr (SP2) {
        PG8_STAGE(PG8_SB(0, 0), cB, voffB); PG8_STAGE(PG8_SB(0, 1), cB + hstep, voffB); PG8_STAGE(PG8_SA(0, 0), cA, voffA); PG8_STAGE(PG8_SA(0, 1), cA + hstep, voffA);
        if (wr == 1) PG8_BAR;
        PG8_WAIT_V(2); PG8_BAR;
        PG8_STAGE(PG8_SB(1, 0), cB + kstep, voffB); PG8_STAGE(PG8_SA(1, 0), cA + kstep, voffA); PG8_STAGE(PG8_SB(1, 1), cB + hstep + kstep, voffB);
        PG8_WAIT_V(6); PG8_BAR;
    } else {
        PG8_STAGE(PG8_SB(0, 0), cB, voffB); PG8_STAGE(PG8_SA(0, 0), cA, voffA); PG8_STAGE(PG8_SB(0, 1), cB + hstep, voffB); PG8_STAGE(PG8_SA(0, 1), cA + hstep, voffA);
        if (wr == 1) PG8_BAR;
        PG8_WAIT_V(4); PG8_BAR;
        PG8_STAGE(PG8_SB(1, 0), cB + kstep, voffB); PG8_STAGE(PG8_SA(1, 0), cA + kstep, voffA); PG8_STAGE(PG8_SB(1, 1), cB + hstep + kstep, voffB);
        PG8_WAIT_V(6); PG8_BAR;
    }
    for (;;) {
        const bool has_next = S.next(ui + 1, nxt);
        const char* nA = has_next ? (const char*)g.A + (size_t)nxt.pm * tstep : cA; const char* nB = has_next ? (const char*)g.Bt + (size_t)nxt.pn * tstep : cB;
        for (int t = 0; t < nt; t += 2) {
            const bool last = (t == nt - 2);
            const char* a1 = cA + (size_t)(t + 1) * kstep;
            const char* a2 = last ? nA : cA + (size_t)(t + 2) * kstep; const char* b2 = last ? nB : cB + (size_t)(t + 2) * kstep;
            const char* a3 = a2 + kstep; const char* b3 = b2 + kstep;
            if (last && has_next) S.a_ready(nxt);
            if constexpr (SP2) {
            PG8_LDB(B0, 0, 0); PG8_LDB(B1, 0, 1); PG8_SCHED; PG8_LDA(At, 0, 0); PG8_STAGE(PG8_SA(1, 1), a1 + hstep, voffA);
            PG8_WAIT_V(8); PG8_WAIT_L(0); PG8_BAR; PG8_MMA(0, 0, At, B0); PG8_MMA(0, 1, At, B1); PG8_BAR; PG8_SCHED;
            PG8_LDA(At, 0, 1); PG8_STAGE(PG8_SB(0, 0), b2, voffB); PG8_STAGE(PG8_SB(0, 1), b2 + hstep, voffB); PG8_STAGE(PG8_SA(0, 0), a2, voffA);
            PG8_WAIT_V(8); PG8_WAIT_L(0); PG8_BAR; PG8_MMA(1, 0, At, B0); PG8_MMA(1, 1, At, B1); PG8_BAR; PG8_SCHED;
            PG8_LDB(B0, 1, 0); PG8_LDB(B1, 1, 1); PG8_SCHED; PG8_LDA(At, 1, 0); PG8_STAGE(PG8_SA(0, 1), a2 + hstep, voffA);
            PG8_WAIT_V(8); PG8_WAIT_L(0); PG8_BAR; PG8_MMA(0, 0, At, B0); PG8_MMA(0, 1, At, B1); PG8_BAR; PG8_SCHED;
            PG8_LDA(At, 1, 1); PG8_STAGE(PG8_SB(1, 0), b3, voffB); PG8_STAGE(PG8_SB(1, 1), b3 + hstep, voffB); PG8_STAGE(PG8_SA(1, 0), a3, voffA);
            PG8_WAIT_V(8); PG8_WAIT_L(0); PG8_BAR; PG8_MMA(1, 0, At, B0); PG8_MMA(1, 1, At, B1); PG8_BAR; PG8_SCHED;
            } else {
            PG8_LDB(B0, 0, 0); PG8_SCHED; PG8_LDA(At, 0, 0); PG8_STAGE(PG8_SA(1, 1), a1 + hstep, voffA);
            PG8_WAIT_L(8); PG8_BAR; PG8_WAIT_L(0); PG8_MMA(0, 0, At, B0); PG8_BAR; PG8_SCHED;
            PG8_LDB(B1, 0, 1); PG8_STAGE(PG8_SB(0, 0), b2, voffB);
            PG8_BAR; PG8_WAIT_L(0); PG8_MMA(0, 1, At, B1); PG8_BAR;
            PG8_LDA(At, 0, 1); PG8_STAGE(PG8_SA(0, 0), a2, voffA);
            PG8_BAR; PG8_WAIT_L(0); PG8_MMA(1, 0, At, B0); PG8_BAR; PG8_SCHED;
            PG8_STAGE(PG8_SB(0, 1), b2 + hstep, voffB);
            PG8_WAIT_V(6); PG8_BAR; PG8_MMA(1, 1, At, B1); PG8_BAR;
            PG8_LDB(B0, 1, 0); PG8_SCHED; PG8_LDA(At, 1, 0); PG8_STAGE(PG8_SA(0, 1), a2 + hstep, voffA);
            PG8_WAIT_L(8); PG8_BAR; PG8_WAIT_L(0); PG8_MMA(0, 0, At, B0); PG8_BAR; PG8_SCHED;
            PG8_LDB(B1, 1, 1); PG8_STAGE(PG8_SB(1, 0), b3, voffB);
            PG8_BAR; PG8_WAIT_L(0); PG8_MMA(0, 1, At, B1); PG8_BAR;
            PG8_LDA(At, 1, 1); PG8_STAGE(PG8_SA(1, 0), a3, voffA);
            PG8_BAR; PG8_WAIT_L(0); PG8_MMA(1, 0, At, B0); PG8_BAR; PG8_SCHED;
            PG8_STAGE(PG8_SB(1, 1), b3 + hstep, voffB);
            PG8_WAIT_V(6); PG8_BAR; PG8_MMA(1, 1, At, B1); PG8_BAR;
            }
        }
        if constexpr (ALIGN_EPI) { if (wr == 0) PG8_BAR; }
        if constexpr (!Epi::AFTER_DRAIN) { E(acc, cur, wr, wc, fr, fq); S.done(cur); }
        if (!has_next) break;
#pragma unroll
        for (int a = 0; a < 2; ++a)
#pragma unroll
            for (int b = 0; b < 2; ++b)
#pragma unroll
                for (int m = 0; m < 4; ++m)
#pragma unroll
                    for (int n = 0; n < 2; ++n) acc[a][b][m][n] = (f32x4){0.f, 0.f, 0.f, 0.f};
        cur = nxt; cA = nA; cB = nB; ++ui;
        if constexpr (ALIGN_EPI) { if (wr == 1) PG8_BAR; }
    }
    PG8_WAIT_V(0);
    if constexpr (!ALIGN_EPI) { if (wr == 0) PG8_BAR; }
    PG8_BAR;
    if constexpr (Epi::AFTER_DRAIN) { E.fused(acc, cur, wr, wc, fr, fq, lds, wid, lane); S.done(cur); }
#undef PG8_SA
#undef PG8_SB
#undef PG8_STAGE
#undef PG8_LDA
#undef PG8_LDB
#undef PG8_MMA
#undef PG8_WAIT_V
#undef PG8_WAIT_L
#undef PG8_BAR
#undef PG8_SCHED
}
}

#ifndef MK_N_LAUNCHES
#define MK_N_LAUNCHES 1
#endif
namespace cg = cooperative_groups;
#define GAS __attribute__((address_space(1)))
#define LAS __attribute__((address_space(3)))
typedef unsigned short bf16;
typedef unsigned u32x4 __attribute__((ext_vector_type(4)));
typedef unsigned u32x2 __attribute__((ext_vector_type(2)));
typedef float f32x4 __attribute__((ext_vector_type(4)));
typedef float f32x2 __attribute__((ext_vector_type(2)));
typedef short bf16x8 __attribute__((ext_vector_type(8)));
typedef short s16x4 __attribute__((ext_vector_type(4)));
typedef __bf16 bf16v2 __attribute__((ext_vector_type(2)));

constexpr int NWAVES = 8, NTHREADS = 512;
constexpr int BATCH = 2, SEQ = 8192, DM = 2048, MTOK = BATCH * SEQ;
constexpr int DIN = 11776, OFF_QA = 0, OFF_KA = 1024, OFF_VA = 2048, OFF_QB = 3072, OFF_KB = 4608, OFF_VB = 6144, OFF_GA = 7680, OFF_GB = 9728;
constexpr int GRID_W = 64, GRID_ROWS = SEQ / GRID_W, NA_HEADS = 8, DIL_HEADS = 12;
constexpr int NEXP = 64, DEXP = 512, PMAX = 49152, MAXTILES = PMAX / 256;
constexpr float LN_EPS = 1e-5f, DN_ALPHA = 1.189207115002721f, ATT_SCALE = 0.08838834764831845f;
constexpr int NRW = 80;
constexpr size_t MiB = 1u << 20, KiB = 1u << 10;
constexpr size_t WS_CTL = 0, CTL_ZERO_BYTES = 4096;
constexpr size_t WS_STATS0 = 1 * MiB, WS_STATS1 = 1 * MiB + 128 * KiB, WS_TOKE = 1 * MiB + 256 * KiB, WS_TOKW = 1 * MiB + 384 * KiB, WS_TOKP = 1 * MiB + 512 * KiB, WS_TOKS = 1 * MiB + 640 * KiB, WS_TILE = 1 * MiB + 768 * KiB;
constexpr size_t WS_LSE = 2 * MiB;
constexpr size_t WS_WRH = 3 * MiB, WS_WRL = 3 * MiB + 512 * KiB;
constexpr size_t WS_WIN = 4 * MiB, WS_WA = 50 * MiB, WS_WB = 54 * MiB, WS_WO = 56 * MiB;
constexpr size_t WS_ACT = 64 * MiB;
constexpr size_t WS_NA = 128 * MiB, WS_DILG = 160 * MiB, WS_DILO = 208 * MiB;
constexpr size_t WS_Z = 224 * MiB;
constexpr size_t WS_WUP = 592 * MiB, WS_WDN = 848 * MiB, WS_END = 976 * MiB;
constexpr size_t WS_XS = 224 * MiB, WS_HID = 416 * MiB, WS_YS = 224 * MiB, WS_LO = 464 * MiB;
static_assert(WS_WIN + (size_t)DIN * DM * 2 <= WS_WA && WS_Z + (size_t)MTOK * DIN * 2 <= WS_WUP && WS_XS + (size_t)PMAX * DM * 2 <= WS_HID && WS_HID + (size_t)PMAX * DEXP * 2 <= WS_LO && WS_LO + (size_t)MTOK * DM * 2 <= WS_WUP, "ws map");
constexpr int RING_BYTES = 131072, MISC_OFF = RING_BYTES, LDS_BYTES = 147456;

__device__ __forceinline__ unsigned pk2(float lo, float hi) { f32x2 v = {lo, hi}; bf16v2 b = __builtin_convertvector(v, bf16v2); return __builtin_bit_cast(unsigned, b); }
__device__ __forceinline__ float bfl(unsigned w) { return __uint_as_float(w << 16); }
__device__ __forceinline__ float bfh(unsigned w) { return __uint_as_float(w & 0xffff0000u); }
__device__ __forceinline__ float wave_sum(float v) {
#pragma unroll
    for (int o = 1; o < 64; o <<= 1) v += __shfl_xor(v, o);
    return v;
}
#define LDS_WAIT() asm volatile("s_waitcnt lgkmcnt(0)" ::: "memory")
#define VM_WAIT() asm volatile("s_waitcnt vmcnt(0)" ::: "memory")

struct Args { const float* in[21]; float* out; unsigned char* ws; int ph_lo, ph_hi; };
enum { IN_X = 0, IN_LN0G, IN_LN0B, IN_WIN, IN_BIN, IN_RPB, IN_WPA, IN_WPB, IN_WO, IN_BO, IN_LN1G, IN_LN1B, IN_WRG, IN_BRG, IN_WRE, IN_BRE, IN_WG, IN_WU, IN_WD, IN_LN2G, IN_LN2B };

__device__ __forceinline__ void p0_transpose_item(const float* W, int N, int K, bf16* WT, long dst_row0, int k0, int n0, LAS float* scr, int lane) {
#pragma unroll 8
    for (int i = 0; i < 32; ++i) { const int kk = 2 * i + (lane >> 5); scr[kk * 33 + (lane & 31)] = W[(size_t)(k0 + kk) * N + n0 + (lane & 31)]; }
    LDS_WAIT();
    const int c = lane & 7;
#pragma unroll
    for (int j = 0; j < 4; ++j) { const int n = (lane >> 3) + 8 * j; const LAS float* s = scr + (8 * c) * 33 + n;
        u32x4 o; o.x = pk2(s[0 * 33], s[1 * 33]); o.y = pk2(s[2 * 33], s[3 * 33]); o.z = pk2(s[4 * 33], s[5 * 33]); o.w = pk2(s[6 * 33], s[7 * 33]);
        *(u32x4*)(WT + (size_t)(dst_row0 + n) * K + k0 + 8 * c) = o; }
    LDS_WAIT();
}
__device__ __forceinline__ void p0_prologue(const Args& a, LAS unsigned char* lds, int gw, int NGW, int wave, int lane) {
    LAS float* scr = (LAS float*)(lds + wave * 16384);
    unsigned char* ws = a.ws;
    constexpr int I0 = 32 * 368, I1 = 16 * 64, I2 = 8 * 64, I3 = 32 * 64, I4 = NEXP * 32 * 16, I5 = I4, I6 = NEXP * 8 * 64;
    constexpr int NITEMS = I0 + I1 + I2 + I3 + I4 + I5 + I6;
    for (int it = gw; it < NITEMS; it += NGW) {
        int r = it;
        if (r < I0) { const int kb = r / 368, nb = r % 368; p0_transpose_item(a.in[IN_WIN], DIN, DM, (bf16*)(ws + WS_WIN), 32 * nb, 64 * kb, 32 * nb, scr, lane); continue; } r -= I0;
        if (r < I1) { const int kb = r / 64, nb = r % 64; p0_transpose_item(a.in[IN_WPA], DM, 1024, (bf16*)(ws + WS_WA), 32 * nb, 64 * kb, 32 * nb, scr, lane); continue; } r -= I1;
        if (r < I2) { const int kb = r / 64, nb = r % 64; p0_transpose_item(a.in[IN_WPB], DM, 512, (bf16*)(ws + WS_WB), 32 * nb, 64 * kb, 32 * nb, scr, lane); continue; } r -= I2;
        if (r < I3) { const int kb = r / 64, nb = r % 64; p0_transpose_item(a.in[IN_WO], DM, DM, (bf16*)(ws + WS_WO), 32 * nb, 64 * kb, 32 * nb, scr, lane); continue; } r -= I3;
        if (r < I4 + I5) { const int mat = r >= I4; if (mat) r -= I4; const int e = r / 512, q = r % 512, kb = q / 16, nb = q % 16, n0 = 32 * nb;
            const float* W = (mat ? a.in[IN_WU] : a.in[IN_WG]) + (size_t)e * DM * DEXP;
            p0_transpose_item(W, DEXP, DM, (bf16*)(ws + WS_WUP), (long)e * 1024 + (n0 >> 7) * 256 + mat * 128 + (n0 & 127), 64 * kb, n0, scr, lane); continue; } r -= I4 + I5;
        { const int e = r / 512, q = r % 512, kb = q / 64, nb = q % 64;
            p0_transpose_item(a.in[IN_WD] + (size_t)e * DEXP * DM, DM, DEXP, (bf16*)(ws + WS_WDN), (long)e * 2048 + 32 * nb, 64 * kb, 32 * nb, scr, lane); }
    }
    { bf16* wh = (bf16*)(ws + WS_WRH); bf16* wl = (bf16*)(ws + WS_WRL);
      for (int i = gw * 64 + lane; i < NRW * DM; i += NGW * 64) { const int n = i / DM, k = i % DM;
          const float v = n < 8 ? a.in[IN_WRG][(size_t)k * 8 + n] : (n < 72 ? a.in[IN_WRE][(size_t)k * 64 + (n - 8)] : 0.f);
          const unsigned h = pk2(v, 0.f) & 0xffffu; const float r = v - __uint_as_float(h << 16);
          wh[i] = (bf16)h; wl[i] = (bf16)(pk2(r, 0.f) & 0xffffu); } }
    { const float* g = a.in[IN_LN0G]; const float* bb = a.in[IN_LN0B]; float* st = (float*)(ws + WS_STATS0); bf16* H = (bf16*)(ws + WS_ACT);
      f32x4 gv[8], bv[8];
#pragma unroll
      for (int j = 0; j < 8; ++j) { gv[j] = *(const f32x4*)(g + 256 * j + 4 * lane); bv[j] = *(const f32x4*)(bb + 256 * j + 4 * lane); }
      for (int m = gw; m < MTOK; m += NGW) {
          const float* xr = a.in[IN_X] + (size_t)m * DM + 4 * lane; f32x4 v[8]; float s = 0.f;
#pragma unroll
          for (int j = 0; j < 8; ++j) { v[j] = *(const f32x4*)(xr + 256 * j); s += (v[j].x + v[j].y) + (v[j].z + v[j].w); }
          const float mean = wave_sum(s) * (1.f / DM); float s2 = 0.f;
#pragma unroll
          for (int j = 0; j < 8; ++j) { v[j] = v[j] - mean; s2 += (v[j].x * v[j].x + v[j].y * v[j].y) + (v[j].z * v[j].z + v[j].w * v[j].w); }
          const float rstd = 1.0f / sqrtf(wave_sum(s2) * (1.f / DM) + LN_EPS);
          if (lane == 0) { st[2 * m] = mean; st[2 * m + 1] = rstd; }
          bf16* orow = H + (size_t)m * DM + 4 * lane;
#pragma unroll
          for (int j = 0; j < 8; ++j) { const f32x4 y = v[j] * rstd * gv[j] + bv[j]; u32x2 w; w.x = pk2(y.x, y.y); w.y = pk2(y.z, y.w); *(u32x2*)(orow + 256 * j) = w; }
      } }
}

__device__ __forceinline__ unsigned off_b(unsigned row, unsigned ch) { return 256u * row + 16u * (ch ^ (((row & 3) << 2) | ((row >> 2) & 3))); }
__device__ __forceinline__ unsigned tr_read_addr_16(unsigned lane, unsigned c, unsigned t) { const unsigned g = lane >> 4, q = (lane & 15) >> 2, p = lane & 3; return off_b(8 * g + 4 * t + q, 2 * c + (p >> 1)) + 8 * (p & 1); }

struct NaSpec {
    static constexpr int NKS = 8;
    const bf16* zb; int h, r, c, start, kc0; const LAS float* rpb;
    __device__ __forceinline__ const bf16* q_ptr(int q) const { return zb + (size_t)(r * GRID_W + 16 * c + q) * DIN + OFF_QA + h * 128; }
    __device__ __forceinline__ const bf16* k_ptr(int ks, int idx) const { return zb + (size_t)((start + ks) * GRID_W + kc0 + idx) * DIN + OFF_KA + h * 128; }
    __device__ __forceinline__ const bf16* v_ptr(int ks, int idx) const { return zb + (size_t)((start + ks) * GRID_W + kc0 + idx) * DIN + OFF_VA + h * 128; }
    __device__ __forceinline__ float fix(float s, int ks, int idx, int q) const {
        const int kcol = kc0 + idx, qcol = 16 * c + q; int qcs = qcol - 8; qcs = qcs < 0 ? 0 : (qcs > 48 ? 48 : qcs);
        int dc = kcol - qcol + 15; dc = dc < 0 ? 0 : (dc > 30 ? 30 : dc);
        const float bias = rpb[(start + ks - r + 7) * 31 + dc];
        return (kcol >= qcs && kcol < qcs + 16) ? s * ATT_SCALE + bias : -INFINITY;
    }
};
struct DilSpec {
    static constexpr int NKS = 5;
    const bf16* zb; int hd, d, res, pq0, L; float slope_d;
    __device__ __forceinline__ size_t tok(int p) const { p = p < 0 ? 0 : (p > L - 1 ? L - 1 : p); return (size_t)(p * d + res); }
    __device__ __forceinline__ const bf16* q_ptr(int q) const { return zb + tok(pq0 + q) * DIN + OFF_QB + hd * 128; }
    __device__ __forceinline__ const bf16* k_ptr(int ks, int idx) const { return zb + tok(pq0 - 64 + 32 * ks + idx) * DIN + OFF_KB + hd * 128; }
    __device__ __forceinline__ const bf16* v_ptr(int ks, int idx) const { return zb + tok(pq0 - 64 + 32 * ks + idx) * DIN + OFF_VB + hd * 128; }
    __device__ __forceinline__ float fix(float s, int ks, int idx, int q) const {
        const int rel = -64 + 32 * ks + idx - q, pk = pq0 - 64 + 32 * ks + idx; const int ar = rel < 0 ? -rel : rel;
        return (ar <= 64 && pk >= 0 && pk < L) ? s * ATT_SCALE - slope_d * (float)ar : -INFINITY;
    }
};
template <class SP>
__device__ __forceinline__ void attn_wave(const SP& sp, LAS unsigned char* vlds, int lane, f32x4 (&o)[8], float& lse) {
    constexpr int NKS = SP::NKS;
    const int q = lane & 15, g = lane >> 4;
    f32x4 s[NKS][2];
    {
        bf16x8 qf[4];
        const bf16* qrow = sp.q_ptr(q) + 8 * g;
#pragma unroll
        for (int dk = 0; dk < 4; ++dk) qf[dk] = *(const bf16x8*)(qrow + 32 * dk);
        const int ki = 8 * (q >> 2) + (q & 3);
        bf16x8 kf[2][4];
#pragma unroll
        for (int blk = 0; blk < 2; ++blk) { const bf16* krow = sp.k_ptr(0, ki + 4 * blk) + 8 * g;
#pragma unroll
            for (int dk = 0; dk < 4; ++dk) kf[blk][dk] = *(const bf16x8*)(krow + 32 * dk); }
#pragma unroll
        for (int ks = 0; ks < NKS; ++ks) {
            bf16x8 kn[2][4];
            if (ks + 1 < NKS) {
#pragma unroll
                for (int blk = 0; blk < 2; ++blk) { const bf16* krow = sp.k_ptr(ks + 1, ki + 4 * blk) + 8 * g;
#pragma unroll
                    for (int dk = 0; dk < 4; ++dk) kn[blk][dk] = *(const bf16x8*)(krow + 32 * dk); }
            }
            __builtin_amdgcn_sched_barrier(0);
#pragma unroll
            for (int blk = 0; blk < 2; ++blk) {
                f32x4 acc = {0.f, 0.f, 0.f, 0.f};
#pragma unroll
                for (int dk = 0; dk < 4; ++dk) acc = __builtin_amdgcn_mfma_f32_16x16x32_bf16(kf[blk][dk], qf[dk], acc, 0, 0, 0);
                s[ks][blk] = acc;
            }
            __builtin_amdgcn_sched_barrier(0);
            if (ks + 1 < NKS) {
#pragma unroll
                for (int blk = 0; blk < 2; ++blk)
#pragma unroll
                    for (int dk = 0; dk < 4; ++dk) kf[blk][dk] = kn[blk][dk];
            }
        }
    }
    const int vrow = lane >> 4;
#define ATT_STAGE_V(ks_, bufoff_) do { _Pragma("unroll") for (int i_ = 0; i_ < 8; ++i_) { const unsigned row_ = 4u * i_ + vrow; const unsigned ch_ = (lane & 15u) ^ (((row_ & 3u) << 2) | ((row_ >> 2) & 3u)); \
        __builtin_amdgcn_global_load_lds((const unsigned*)(sp.v_ptr(ks_, (int)row_) + 8 * ch_), (LAS unsigned*)(vlds + (bufoff_) + i_ * 1024), 16, 0, 0); } } while (0)
    ATT_STAGE_V(0, 0);
    float mx = -INFINITY;
#pragma unroll
    for (int ks = 0; ks < NKS; ++ks)
#pragma unroll
        for (int blk = 0; blk < 2; ++blk)
#pragma unroll
            for (int r = 0; r < 4; ++r) { const float v = sp.fix(s[ks][blk][r], ks, 8 * g + 4 * blk + r, q); s[ks][blk][r] = v; mx = fmaxf(mx, v); if (blk == 1 && r == 3) __builtin_amdgcn_sched_barrier(0); }
    mx = fmaxf(mx, __shfl_xor(mx, 16)); mx = fmaxf(mx, __shfl_xor(mx, 32));
    float sum = 0.f;
#pragma unroll
    for (int ks = 0; ks < NKS; ++ks)
#pragma unroll
        for (int blk = 0; blk < 2; ++blk)
#pragma unroll
            for (int r = 0; r < 4; ++r) { const float p = __builtin_amdgcn_exp2f((s[ks][blk][r] - mx) * 1.4426950408889634f); s[ks][blk][r] = p; sum += p; }
    sum += __shfl_xor(sum, 16); sum += __shfl_xor(sum, 32);
    lse = mx + __logf(sum);
    const float inv = 1.0f / sum;
    __builtin_amdgcn_sched_barrier(0);
    u32x4 pw[NKS];
#pragma unroll
    for (int ks = 0; ks < NKS; ++ks) { pw[ks].x = pk2(s[ks][0][0] * inv, s[ks][0][1] * inv); pw[ks].y = pk2(s[ks][0][2] * inv, s[ks][0][3] * inv); pw[ks].z = pk2(s[ks][1][0] * inv, s[ks][1][1] * inv); pw[ks].w = pk2(s[ks][1][2] * inv, s[ks][1][3] * inv);
        asm volatile("" : "+v"(pw[ks].x), "+v"(pw[ks].y), "+v"(pw[ks].z), "+v"(pw[ks].w)); }
    __builtin_amdgcn_sched_barrier(0);
#pragma unroll
    for (int c = 0; c < 8; ++c) o[c] = (f32x4){0.f, 0.f, 0.f, 0.f};
    unsigned tra[2];
#pragma unroll
    for (int t = 0; t < 2; ++t) tra[t] = tr_read_addr_16(lane, 0, t);
#pragma unroll
    for (int ks = 0; ks < NKS; ++ks) {
        LAS unsigned char* buf = vlds + (ks & 1) * 8192;
        VM_WAIT();
        if (ks + 1 < NKS) ATT_STAGE_V(ks + 1, ((ks + 1) & 1) * 8192);
        const bf16x8 pf = __builtin_bit_cast(bf16x8, pw[ks]);
#pragma unroll
        for (int c = 0; c < 8; ++c) {
            const s16x4 t0 = __builtin_amdgcn_ds_read_tr16_b64_v4i16((LAS s16x4*)(buf + (tra[0] ^ (32u * c))));
            const s16x4 t1 = __builtin_amdgcn_ds_read_tr16_b64_v4i16((LAS s16x4*)(buf + (tra[1] ^ (32u * c))));
            const bf16x8 vf = __builtin_shufflevector(t0, t1, 0, 1, 2, 3, 4, 5, 6, 7);
            o[c] = __builtin_amdgcn_mfma_f32_16x16x32_bf16(vf, pf, o[c], 0, 0, 0);
        }
        __builtin_amdgcn_sched_barrier(0);
    }
#undef ATT_STAGE_V
}
__device__ __forceinline__ void p2_attention(const Args& a, LAS unsigned char* lds, int gw, int NGW, int wave, int lane) {
    unsigned char* ws = a.ws; const bf16* z = (const bf16*)(ws + WS_Z);
    LAS float* rpb = (LAS float*)(lds + MISC_OFF);
    for (int i = threadIdx.x; i < NA_HEADS * 465; i += NTHREADS) rpb[i] = a.in[IN_RPB][i];
    __syncthreads();
    LAS unsigned char* vlds = lds + wave * 16384;
    constexpr int N_NA = BATCH * NA_HEADS * GRID_ROWS * 4, N_DIL = DIL_HEADS * BATCH * 64 * 8;
    for (int it = gw; it < N_NA + N_DIL; it += NGW) {
        f32x4 o[8]; float lse;
        asm volatile("" : "+v"(lane));
        const int q = lane & 15, g = lane >> 4;
        if (it < N_NA) {
            const int c = it & 3, r = (it >> 2) & 127, h = (it >> 9) & 7, b = it >> 12;
            NaSpec sp; sp.zb = z + (size_t)b * SEQ * DIN; sp.h = h; sp.r = r; sp.c = c; int st = r - 4; st = st < 0 ? 0 : (st > GRID_ROWS - 8 ? GRID_ROWS - 8 : st); sp.start = st;
            int kc = 16 * c - 8; kc = kc < 0 ? 0 : (kc > 32 ? 32 : kc); sp.kc0 = kc; sp.rpb = rpb + h * 465;
            attn_wave(sp, vlds, lane, o, lse);
            bf16* orow = (bf16*)(ws + WS_NA) + (size_t)(b * SEQ + r * GRID_W + 16 * c + q) * 1024 + h * 128 + 4 * g;
#pragma unroll
            for (int cc = 0; cc < 8; ++cc) { u32x2 w; w.x = pk2(o[cc][0], o[cc][1]); w.y = pk2(o[cc][2], o[cc][3]); *(u32x2*)(orow + 16 * cc) = w; }
        } else {
            const int j = it - N_NA; const int sub = j & 7, blk = (j >> 3) & 63, b = (j >> 9) & 1, hd = j >> 10;
            const int grp = hd >> 2, slot = hd & 3, d = grp == 0 ? 1 : (grp == 1 ? 4 : 16), L = SEQ / d, nb = L / 128;
            DilSpec sp; sp.zb = z + (size_t)b * SEQ * DIN; sp.hd = hd; sp.d = d; sp.res = blk / nb; sp.pq0 = (blk % nb) * 128 + 16 * sub; sp.L = L;
            sp.slope_d = exp2f(-8.0f * (float)(hd + 1) / 12.0f) * (float)d;
            attn_wave(sp, vlds, lane, o, lse);
            const size_t row = (size_t)b * SEQ + (size_t)(sp.pq0 + q) * d + sp.res;
            bf16* orow = (bf16*)(ws + WS_DILG) + ((size_t)grp * MTOK + row) * 512 + slot * 128 + 4 * g;
#pragma unroll
            for (int cc = 0; cc < 8; ++cc) { u32x2 w; w.x = pk2(o[cc][0], o[cc][1]); w.y = pk2(o[cc][2], o[cc][3]); *(u32x2*)(orow + 16 * cc) = w; }
            if (g == 0) ((float*)(ws + WS_LSE))[((size_t)grp * MTOK + row) * 4 + slot] = lse;
        }
    }
}
__device__ __forceinline__ void p3_combine(const Args& a, int gtid, int NT) {
    unsigned char* ws = a.ws; const float* lse = (const float*)(ws + WS_LSE); const bf16* og = (const bf16*)(ws + WS_DILG); bf16* out = (bf16*)(ws + WS_DILO);
    for (int i = gtid; i < MTOK * 64; i += NT) {
        const int row = i >> 6, ch = i & 63, slot = ch >> 4;
        const float l0 = lse[((size_t)0 * MTOK + row) * 4 + slot], l1 = lse[((size_t)1 * MTOK + row) * 4 + slot], l2 = lse[((size_t)2 * MTOK + row) * 4 + slot];
        const float mx = fmaxf(l0, fmaxf(l1, l2)); float w0 = __expf(l0 - mx), w1 = __expf(l1 - mx), w2 = __expf(l2 - mx); const float inv = 1.0f / (w0 + w1 + w2); w0 *= inv; w1 *= inv; w2 *= inv;
        const u32x4 a0 = *(const u32x4*)(og + ((size_t)0 * MTOK + row) * 512 + 8 * ch), a1 = *(const u32x4*)(og + ((size_t)1 * MTOK + row) * 512 + 8 * ch), a2 = *(const u32x4*)(og + ((size_t)2 * MTOK + row) * 512 + 8 * ch);
        u32x4 r;
        r.x = pk2(w0 * bfl(a0.x) + w1 * bfl(a1.x) + w2 * bfl(a2.x), w0 * bfh(a0.x) + w1 * bfh(a1.x) + w2 * bfh(a2.x));
        r.y = pk2(w0 * bfl(a0.y) + w1 * bfl(a1.y) + w2 * bfl(a2.y), w0 * bfh(a0.y) + w1 * bfh(a1.y) + w2 * bfh(a2.y));
        r.z = pk2(w0 * bfl(a0.z) + w1 * bfl(a1.z) + w2 * bfl(a2.z), w0 * bfh(a0.z) + w1 * bfh(a1.z) + w2 * bfh(a2.z));
        r.w = pk2(w0 * bfl(a0.w) + w1 * bfl(a1.w) + w2 * bfl(a2.w), w0 * bfh(a0.w) + w1 * bfh(a1.w) + w2 * bfh(a2.w));
        *(u32x4*)(out + (size_t)row * 512 + 8 * ch) = r;
    }
}

__device__ __forceinline__ void p6_ln1_router(const Args& a, LAS unsigned char* lds, int wave, int lane) {
    unsigned char* ws = a.ws; const float* Y = a.out; bf16* HI = (bf16*)(ws + WS_ACT); bf16* LO = (bf16*)(ws + WS_LO); float* st = (float*)(ws + WS_STATS1);
    const bf16* WH = (const bf16*)(ws + WS_WRH); const bf16* WL = (const bf16*)(ws + WS_WRL);
    LAS float* P = (LAS float*)lds;
    const float* g1 = a.in[IN_LN1G]; const float* b1 = a.in[IN_LN1B];
    for (int rg = blockIdx.x; rg < MTOK / 64; rg += gridDim.x) {
#pragma unroll 1
        for (int i = 0; i < 8; ++i) {
            const int m = rg * 64 + wave * 8 + i;
            const float* yr = Y + (size_t)m * DM + 4 * lane; f32x4 v[8]; float s = 0.f;
#pragma unroll
            for (int j = 0; j < 8; ++j) { v[j] = *(const f32x4*)(yr + 256 * j); s += (v[j].x + v[j].y) + (v[j].z + v[j].w); }
            const float mean = wave_sum(s) * (1.f / DM); float s2 = 0.f;
#pragma unroll
            for (int j = 0; j < 8; ++j) { v[j] = v[j] - mean; s2 += (v[j].x * v[j].x + v[j].y * v[j].y) + (v[j].z * v[j].z + v[j].w * v[j].w); }
            const float rstd = 1.0f / sqrtf(wave_sum(s2) * (1.f / DM) + LN_EPS);
            if (lane == 0) { st[2 * m] = mean; st[2 * m + 1] = rstd; }
            bf16* hrow = HI + (size_t)m * DM + 4 * lane; bf16* lrow = LO + (size_t)m * DM + 4 * lane;
#pragma unroll
            for (int j = 0; j < 8; ++j) { const f32x4 gv = *(const f32x4*)(g1 + 256 * j + 4 * lane), bv = *(const f32x4*)(b1 + 256 * j + 4 * lane); const f32x4 y = v[j] * rstd * gv + bv;
                u32x2 h; h.x = pk2(y.x, y.y); h.y = pk2(y.z, y.w);
                u32x2 l; l.x = pk2(y.x - bfl(h.x), y.y - bfh(h.x)); l.y = pk2(y.z - bfl(h.y), y.w - bfh(h.y));
                *(u32x2*)(hrow + 256 * j) = h; *(u32x2*)(lrow + 256 * j) = l; }
        }
        VM_WAIT(); __syncthreads();
        {
            const int rb = wave & 3, kh = wave >> 2, fr = lane & 15, fq = lane >> 4;
            const size_t arow = (size_t)(rg * 64 + rb * 16 + fr) * DM + kh * 1024 + 8 * fq;
            f32x4 acc[5];
#pragma unroll
            for (int cb = 0; cb < 5; ++cb) acc[cb] = (f32x4){0.f, 0.f, 0.f, 0.f};
#pragma unroll 2
            for (int s = 0; s < 32; ++s) {
                const bf16x8 ah = *(const bf16x8*)(HI + arow + 32 * s), al = *(const bf16x8*)(LO + arow + 32 * s);
#pragma unroll
                for (int cb = 0; cb < 5; ++cb) { const size_t brow = (size_t)(16 * cb + fr) * DM + kh * 1024 + 8 * fq + 32 * s;
                    const bf16x8 bh = *(const bf16x8*)(WH + brow), bl = *(const bf16x8*)(WL + brow);
                    acc[cb] = __builtin_amdgcn_mfma_f32_16x16x32_bf16(ah, bh, acc[cb], 0, 0, 0);
                    acc[cb] = __builtin_amdgcn_mfma_f32_16x16x32_bf16(ah, bl, acc[cb], 0, 0, 0);
                    acc[cb] = __builtin_amdgcn_mfma_f32_16x16x32_bf16(al, bh, acc[cb], 0, 0, 0); }
            }
#pragma unroll
            for (int cb = 0; cb < 5; ++cb)
#pragma unroll
                for (int r = 0; r < 4; ++r) P[((kh * 4 + rb) * 16 + 4 * fq + r) * NRW + 16 * cb + fr] = acc[cb][r];
        }
        __syncthreads();
        if (threadIdx.x < 64) {
            const int t = threadIdx.x, m = rg * 64 + t; const LAS float* p0 = P + (size_t)t * NRW; const LAS float* p1 = P + (size_t)(64 + t) * NRW;
            float gl[8]; int gs = 0; float gm = -INFINITY;
#pragma unroll
            for (int n = 0; n < 8; ++n) { gl[n] = p0[n] + p1[n] + a.in[IN_BRG][n]; if (gl[n] > gm) { gm = gl[n]; gs = n; } }
            float gsum = 0.f;
#pragma unroll
            for (int n = 0; n < 8; ++n) gsum += __expf(gl[n] - gm);
            const float gprob = 1.0f / gsum;
            float v0 = -INFINITY, v1 = -INFINITY; int i0 = 0, i1 = 0;
#pragma unroll
            for (int n = 0; n < 8; ++n) { const float e = p0[8 + gs * 8 + n] + p1[8 + gs * 8 + n] + a.in[IN_BRE][gs * 8 + n];
                if (e > v0) { v1 = v0; i1 = i0; v0 = e; i0 = n; } else if (e > v1) { v1 = e; i1 = n; } }
            const float e1 = __expf(v1 - v0), w0 = gprob / (1.0f + e1), w1 = gprob * e1 / (1.0f + e1);
            const int x0 = gs * 8 + i0, x1 = gs * 8 + i1;
            unsigned* cnt = (unsigned*)(ws + WS_CTL);
            const unsigned q0 = atomicAdd(cnt + x0, 1u), q1 = atomicAdd(cnt + x1, 1u);
            int* te = (int*)(ws + WS_TOKE); float* tw = (float*)(ws + WS_TOKW); int* tp = (int*)(ws + WS_TOKP);
            te[2 * m] = x0; te[2 * m + 1] = x1; tw[2 * m] = w0; tw[2 * m + 1] = w1; tp[2 * m] = (int)q0; tp[2 * m + 1] = (int)q1;
        }
        __syncthreads();
    }
}
__device__ __forceinline__ void p7_permute(const Args& a, LAS unsigned char* lds, int gw, int NGW, int lane) {
    unsigned char* ws = a.ws; const unsigned* cnt = (const unsigned*)(ws + WS_CTL);
    LAS int* pstart = (LAS int*)lds; LAS int* pcnt = pstart + 64; LAS int* rcnt = pstart + 128;
    int* tile = (int*)(ws + WS_TILE);
    if (threadIdx.x == 0) {
        int pos = 0, nt = 0;
        for (int e = 0; e < NEXP; ++e) { const int c = (int)cnt[e], pc = (c + 255) & ~255; pstart[e] = pos; rcnt[e] = c; pcnt[e] = pc;
            if (blockIdx.x == 0) for (int j = 0; j < pc / 256; ++j) tile[1 + nt + j] = e;
            nt += pc / 256; pos += pc; }
        if (blockIdx.x == 0) tile[0] = nt;
    }
    __syncthreads();
    const bf16* H = (const bf16*)(ws + WS_ACT); bf16* XS = (bf16*)(ws + WS_XS);
    const int* te = (const int*)(ws + WS_TOKE); const int* tp = (const int*)(ws + WS_TOKP); int* ts = (int*)(ws + WS_TOKS);
    for (int m = gw; m < MTOK; m += NGW) {
        const u32x4* src = (const u32x4*)(H + (size_t)m * DM) + lane; u32x4 v[4];
#pragma unroll
        for (int j = 0; j < 4; ++j) v[j] = src[64 * j];
#pragma unroll
        for (int k = 0; k < 2; ++k) { const int slot = pstart[te[2 * m + k]] + tp[2 * m + k]; if (lane == 0) ts[2 * m + k] = slot;
            u32x4* dst = (u32x4*)(XS + (size_t)slot * DM) + lane;
#pragma unroll
            for (int j = 0; j < 4; ++j) dst[64 * j] = v[j]; }
    }
    { const int e = gw & 63; const int base = pstart[e] + rcnt[e], npad = pcnt[e] - rcnt[e];
      for (int j = gw >> 6; j < npad; j += (NGW >> 6)) { u32x4* dst = (u32x4*)(XS + (size_t)(base + j) * DM) + lane;
#pragma unroll
          for (int q = 0; q < 4; ++q) dst[64 * q] = (u32x4){0u, 0u, 0u, 0u}; } }
}
__device__ __forceinline__ void p10_final(const Args& a, int gw, int NGW, int lane) {
    unsigned char* ws = a.ws; float* Y = a.out; const float* st = (const float*)(ws + WS_STATS1); const bf16* YS = (const bf16*)(ws + WS_YS);
    const int* ts = (const int*)(ws + WS_TOKS); const float* tw = (const float*)(ws + WS_TOKW);
    const float* g1 = a.in[IN_LN1G]; const float* b1 = a.in[IN_LN1B]; const float* g2 = a.in[IN_LN2G]; const float* b2 = a.in[IN_LN2B];
    for (int m = gw; m < MTOK; m += NGW) {
        float* yr = Y + (size_t)m * DM + 4 * lane; const float mu = st[2 * m], rs = st[2 * m + 1];
        const int s0 = ts[2 * m], s1 = ts[2 * m + 1]; const float w0 = tw[2 * m], w1 = tw[2 * m + 1];
        const bf16* e0 = YS + (size_t)s0 * DM + 4 * lane; const bf16* e1 = YS + (size_t)s1 * DM + 4 * lane;
        f32x4 v[8]; float s = 0.f;
#pragma unroll
        for (int j = 0; j < 8; ++j) { const f32x4 y = *(const f32x4*)(yr + 256 * j); const f32x4 gv = *(const f32x4*)(g1 + 256 * j + 4 * lane), bv = *(const f32x4*)(b1 + 256 * j + 4 * lane);
            const u32x2 c0 = *(const u32x2*)(e0 + 256 * j), c1 = *(const u32x2*)(e1 + 256 * j);
            f32x4 f; f.x = w0 * bfl(c0.x) + w1 * bfl(c1.x); f.y = w0 * bfh(c0.x) + w1 * bfh(c1.x); f.z = w0 * bfl(c0.y) + w1 * bfl(c1.y); f.w = w0 * bfh(c0.y) + w1 * bfh(c1.y);
            v[j] = ((y - mu) * rs * gv + bv) * DN_ALPHA + f; s += (v[j].x + v[j].y) + (v[j].z + v[j].w); }
        const float mean = wave_sum(s) * (1.f / DM); float s2 = 0.f;
#pragma unroll
        for (int j = 0; j < 8; ++j) { v[j] = v[j] - mean; s2 += (v[j].x * v[j].x + v[j].y * v[j].y) + (v[j].z * v[j].z + v[j].w * v[j].w); }
        const float rstd = 1.0f / sqrtf(wave_sum(s2) * (1.f / DM) + LN_EPS);
#pragma unroll
        for (int j = 0; j < 8; ++j) { const f32x4 gv = *(const f32x4*)(g2 + 256 * j + 4 * lane), bv = *(const f32x4*)(b2 + 256 * j + 4 * lane); *(f32x4*)(yr + 256 * j) = v[j] * rstd * gv + bv; }
    }
}

constexpr int N_PHASES = 11;
__global__ void __launch_bounds__(NTHREADS, 2) mk_fwd(Args args) {
    extern __shared__ __attribute__((aligned(16))) unsigned char lds_raw[];
    LAS unsigned char* lds = (LAS unsigned char*)lds_raw;
    const int tid = threadIdx.x, lane = tid & 63, wave = __builtin_amdgcn_readfirstlane(tid >> 6);
    const int G = gridDim.x, gw = blockIdx.x * NWAVES + wave, NGW = G * NWAVES;
    unsigned char* ws = args.ws;
    const int lo = args.ph_lo, hi = args.ph_hi;
#ifndef PHASE_MASK
#define PHASE_MASK 0x7ff
#endif
#define IN(k) (((PHASE_MASK >> (k)) & 1) && lo <= (k) && (k) < hi)
#if MK_N_LAUNCHES == 1
    cg::grid_group grid = cg::this_grid();
#define SEAM(k) do { if (IN(k) && IN((k) + 1)) grid.sync(); } while (0)
#else
#define SEAM(k) do { } while (0)
#endif
    if (IN(0)) p0_prologue(args, lds, gw, NGW, wave, lane);
    SEAM(0);
    if (IN(1)) { pg8::Gemm g{(const bf16*)(ws + WS_ACT), (const bf16*)(ws + WS_WIN), MTOK, DIN, DM}; pg8::StaticOrder S; S.init(MTOK, DIN, G, (int)blockIdx.x);
        pg8::EpiZ E{(bf16*)(ws + WS_Z), DIN, args.in[IN_BIN], OFF_GA / 256};
        pg8::gemm_phase<pg8::EpiZ, pg8::StaticOrder, true, true>(lds, g, S, E); }
    SEAM(1);
    if (IN(2)) p2_attention(args, lds, gw, NGW, wave, lane);
    SEAM(2);
    if (IN(3)) p3_combine(args, blockIdx.x * NTHREADS + tid, G * NTHREADS);
    SEAM(3);
    if (IN(4)) {
        { pg8::Gemm g{(const bf16*)(ws + WS_DILO), (const bf16*)(ws + WS_WB), MTOK, DM, 512}; pg8::StaticOrder S; S.init(MTOK, DM, G, (int)blockIdx.x);
          pg8::EpiGate<0> E{(bf16*)args.out, nullptr, (const bf16*)(ws + WS_Z) + OFF_GB, DIN};
          pg8::gemm_phase<pg8::EpiGate<0>, pg8::StaticOrder, true, true>(lds, g, S, E); }
        __syncthreads();
        { pg8::Gemm g{(const bf16*)(ws + WS_NA), (const bf16*)(ws + WS_WA), MTOK, DM, 1024}; pg8::StaticOrder S; S.init(MTOK, DM, G, (int)blockIdx.x);
          pg8::EpiGate<1> E{(bf16*)(ws + WS_ACT), (const bf16*)args.out, (const bf16*)(ws + WS_Z) + OFF_GA, DIN};
          pg8::gemm_phase<pg8::EpiGate<1>, pg8::StaticOrder, true, true>(lds, g, S, E); }
    }
    SEAM(4);
    if (IN(5)) { pg8::Gemm g{(const bf16*)(ws + WS_ACT), (const bf16*)(ws + WS_WO), MTOK, DM, DM}; pg8::StaticOrder S; S.init(MTOK, DM, G, (int)blockIdx.x);
        pg8::EpiY1 E{args.out, args.in[IN_X], (const float*)(ws + WS_STATS0), args.in[IN_LN0G], args.in[IN_LN0B], args.in[IN_BO], DN_ALPHA};
        pg8::gemm_phase<pg8::EpiY1, pg8::StaticOrder, true, true>(lds, g, S, E); }
    SEAM(5);
    if (IN(6)) p6_ln1_router(args, lds, wave, lane);
    SEAM(6);
    if (IN(7)) p7_permute(args, lds, gw, NGW, lane);
    SEAM(7);
    if (IN(8)) { const int* tile = (const int*)(ws + WS_TILE);
        pg8::Gemm g{(const bf16*)(ws + WS_XS), (const bf16*)(ws + WS_WUP), PMAX, NEXP * 1024, DM}; pg8::MoeOrder S{tile + 1, tile[0], 4, G, (int)blockIdx.x};
        pg8::EpiSwiGLU E{(bf16*)(ws + WS_HID)};
        pg8::gemm_phase<pg8::EpiSwiGLU, pg8::MoeOrder, true, true>(lds, g, S, E); }
    SEAM(8);
    if (IN(9)) { const int* tile = (const int*)(ws + WS_TILE);
        pg8::Gemm g{(const bf16*)(ws + WS_HID), (const bf16*)(ws + WS_WDN), PMAX, NEXP * 2048, DEXP}; pg8::MoeOrder S{tile + 1, tile[0], 8, G, (int)blockIdx.x};
        pg8::EpiYs E{(bf16*)(ws + WS_YS), DM, 7};
        pg8::gemm_phase<pg8::EpiYs, pg8::MoeOrder, true, true>(lds, g, S, E); }
    SEAM(9);
    if (IN(10)) p10_final(args, gw, NGW, lane);
#undef IN
#undef SEAM
}

extern "C" void kernel_launch(void* const* d_in, const int* in_sizes, int n_in, void* d_out, int out_size, void* d_ws, size_t ws_size, hipStream_t stream) {
    static int grid = 0;
    if (grid == 0) {
        if (n_in != 21 || in_sizes[0] != MTOK * DM || out_size != MTOK * DM || ws_size < WS_END) { fprintf(stderr, "kernel_launch: unexpected shapes (n_in %d, in0 %d, out %d, ws %zu < %zu)\n", n_in, n_in > 0 ? in_sizes[0] : -1, out_size, ws_size, (size_t)WS_END); grid = -1; return; }
        int dev = 0, cus = 0, per_cu = 0;
        if (hipGetDevice(&dev) != hipSuccess || hipDeviceGetAttribute(&cus, hipDeviceAttributeMultiprocessorCount, dev) != hipSuccess) { fprintf(stderr, "kernel_launch: device query failed\n"); grid = -1; return; }
        if (hipFuncSetAttribute((const void*)mk_fwd, hipFuncAttributeMaxDynamicSharedMemorySize, LDS_BYTES) != hipSuccess) { fprintf(stderr, "kernel_launch: hipFuncSetAttribute failed\n"); grid = -1; return; }
        if (hipOccupancyMaxActiveBlocksPerMultiprocessor(&per_cu, (const void*)mk_fwd, NTHREADS, LDS_BYTES) != hipSuccess || per_cu < 1) { fprintf(stderr, "kernel_launch: occupancy query says %d blocks per CU\n", per_cu); (void)hipGetLastError(); per_cu = 1; }
        grid = cus * 1;
        fprintf(stderr, "kernel_launch: %d CUs, occupancy %d per CU, grid %d\n", cus, per_cu, grid);
    }
    if (grid < 0) return;
    if (hipMemsetAsync((char*)d_ws + WS_CTL, 0, CTL_ZERO_BYTES, stream) != hipSuccess) { fprintf(stderr, "kernel_launch: memset failed\n"); return; }
    Args a{};
    for (int i = 0; i < 21; ++i) a.in[i] = (const float*)d_in[i];
    a.out = (float*)d_out; a.ws = (unsigned char*)d_ws;
#if MK_N_LAUNCHES == 1
    a.ph_lo = 0; a.ph_hi = N_PHASES;
    void* kargs[] = {&a};
    hipError_t e = hipLaunchCooperativeKernel((const void*)mk_fwd, dim3(grid), dim3(NTHREADS), kargs, LDS_BYTES, stream);
    if (e != hipSuccess) fprintf(stderr, "kernel_launch: cooperative launch failed: %s (grid %d)\n", hipGetErrorString(e), grid);
#else
    for (int p = 0; p < N_PHASES; ++p) { a.ph_lo = p; a.ph_hi = p + 1; hipLaunchKernelGGL(mk_fwd, dim3(grid), dim3(NTHREADS), LDS_BYTES, stream, a);
        const hipError_t le = hipPeekAtLastError(); if (le != hipSuccess) { fprintf(stderr, "kernel_launch: launch %d failed: %s\n", p, hipGetErrorName(le)); break; } }
#endif
}
```

```cpp
#include <hip/hip_runtime.h>
#include <hip/hip_cooperative_groups.h>
#include <cstdio>
#include <cstdint>
namespace pg8 {
#define PG8_LAS __attribute__((address_space(3)))
typedef unsigned short bf16_t;
typedef short bf16x8 __attribute__((ext_vector_type(8)));
typedef float f32x4 __attribute__((ext_vector_type(4)));
typedef unsigned u32x4 __attribute__((ext_vector_type(4)));
constexpr int BM = 256, BK = 64, HALF = 128, HTB = HALF * BK * 2  , STAGE_BYTES = 8 * HTB, NXCD = 8, WGM = 8;

__host__ __device__ __forceinline__ int lds_byte(int r, int c) { const int st = (r >> 4) * 2 + (c >> 5), rr = r & 15, cc = c & 31, ob = rr * 64 + cc * 2; return st * 1024 + (ob ^ (((ob >> 9) & 1) << 5)); }
__host__ __device__ __forceinline__ void stage_rc(int b, int& R, int& C) { const int st = b / 1024, sb = b % 1024, swz = sb ^ (((sb >> 9) & 1) << 5); R = (st >> 1) * 16 + swz / 64; C = (st & 1) * 32 + (swz % 64) / 2; }
__host__ __device__ __forceinline__ int perm32(int rho) { const int n = rho >> 4, i = rho & 15; return 8 * (i >> 2) + 4 * n + (i & 3); }

struct Unit { int pm, pn; };
struct Gemm { const bf16_t* A; const bf16_t* Bt; int M, N, K; };

struct StaticOrder {
    int nM, nN, nwg, G, c;
    __host__ __device__ void init(int M, int N, int G_, int c_) { nM = M / BM; nN = N / BM; nwg = nM * nN; G = G_; c = c_; }
    __host__ __device__ bool next(int i, Unit& u) const {
        const long L = (long)i * G + c; if (L >= nwg) return false;
        int wgid = (int)L; { const int q = nwg / NXCD, r = nwg % NXCD, xcd = wgid % NXCD, off = wgid / NXCD; wgid = (xcd < r ? xcd * (q + 1) : r * (q + 1) + (xcd - r) * q) + off; }
        const int nig = WGM * nN, gid = wgid / nig, fm = gid * WGM, gsz = (nM - fm) < WGM ? (nM - fm) : WGM;
        u.pm = fm + ((wgid % nig) % gsz); u.pn = (wgid % nig) / gsz; return true;
    }
    __device__ __forceinline__ void a_ready(const Unit&) const {}
    __device__ __forceinline__ void done(const Unit&) const {}
};
__device__ __forceinline__ unsigned cvt_pk_bf16(float lo, float hi) { unsigned r; asm volatile("v_cvt_pk_bf16_f32 %0, %1, %2" : "=v"(r) : "v"(lo), "v"(hi)); return r; }
typedef float f32x2 __attribute__((ext_vector_type(2)));
__device__ __forceinline__ float sigm(float x) { return __builtin_amdgcn_rcpf(1.0f + __builtin_amdgcn_exp2f(-1.4426950408889634f * x)); }
__device__ __forceinline__ float bf_lo(unsigned w) { return __uint_as_float(w << 16); }
__device__ __forceinline__ float bf_hi(unsigned w) { return __uint_as_float(w & 0xffff0000u); }
struct EpiZ {
    static constexpr bool PERM = true, AFTER_DRAIN = false;
    bf16_t* O; int ldc; const float* bias; int sig_pn;
    __device__ __forceinline__ void operator()(const f32x4 (&acc)[2][2][4][2], const Unit& u, int wr, int wc, int fr, int fq) const {
        const int row0 = u.pm * BM + wr * 64 + fr, col0 = u.pn * BM + wc * 32 + 8 * fq; const bool sg = u.pn >= sig_pn;
        f32x4 bv[2][2];
#pragma unroll
        for (int bj = 0; bj < 2; ++bj)
#pragma unroll
            for (int n = 0; n < 2; ++n) bv[bj][n] = *(const f32x4*)(bias + col0 + bj * HALF + 4 * n);
#pragma unroll
        for (int ai = 0; ai < 2; ++ai)
#pragma unroll
            for (int m = 0; m < 4; ++m) { bf16_t* rowp = O + (size_t)(row0 + ai * HALF + m * 16) * ldc + col0;
#pragma unroll
                for (int bj = 0; bj < 2; ++bj) { f32x4 v0 = acc[ai][bj][m][0] + bv[bj][0], v1 = acc[ai][bj][m][1] + bv[bj][1];
                    if (sg) {
#pragma unroll
                        for (int j = 0; j < 4; ++j) { v0[j] = sigm(v0[j]); v1[j] = sigm(v1[j]); } }
                    u32x4 w; w.x = cvt_pk_bf16(v0[0], v0[1]); w.y = cvt_pk_bf16(v0[2], v0[3]); w.z = cvt_pk_bf16(v1[0], v1[1]); w.w = cvt_pk_bf16(v1[2], v1[3]);
                    *(u32x4*)(rowp + bj * HALF) = w; } }
    }
};
template <int MODE> struct EpiGate {
    static constexpr bool PERM = true, AFTER_DRAIN = false;
    bf16_t* O; const bf16_t* T; const bf16_t* gate; int ldg;
    __device__ __forceinline__ void operator()(const f32x4 (&acc)[2][2][4][2], const Unit& u, int wr, int wc, int fr, int fq) const {
        const int row0 = u.pm * BM + wr * 64 + fr, col0 = u.pn * BM + wc * 32 + 8 * fq;
#pragma unroll
        for (int ai = 0; ai < 2; ++ai)
#pragma unroll
            for (int m = 0; m < 4; ++m) { const size_t r = (size_t)(row0 + ai * HALF + m * 16);
#pragma unroll
                for (int bj = 0; bj < 2; ++bj) {
                    const u32x4 gw = *(const u32x4*)(gate + r * ldg + col0 + bj * HALF);
                    f32x4 v0 = acc[ai][bj][m][0], v1 = acc[ai][bj][m][1];
                    v0[0] *= bf_lo(gw.x); v0[1] *= bf_hi(gw.x); v0[2] *= bf_lo(gw.y); v0[3] *= bf_hi(gw.y);
                    v1[0] *= bf_lo(gw.z); v1[1] *= bf_hi(gw.z); v1[2] *= bf_lo(gw.w); v1[3] *= bf_hi(gw.w);
                    if (MODE == 1) { const u32x4 tw = *(const u32x4*)(T + r * 2048 + col0 + bj * HALF);
                        v0[0] += bf_lo(tw.x); v0[1] += bf_hi(tw.x); v0[2] += bf_lo(tw.y); v0[3] += bf_hi(tw.y);
                        v1[0] += bf_lo(tw.z); v1[1] += bf_hi(tw.z); v1[2] += bf_lo(tw.w); v1[3] += bf_hi(tw.w); }
                    u32x4 w; w.x = cvt_pk_bf16(v0[0], v0[1]); w.y = cvt_pk_bf16(v0[2], v0[3]); w.z = cvt_pk_bf16(v1[0], v1[1]); w.w = cvt_pk_bf16(v1[2], v1[3]);
                    *(u32x4*)(O + r * 2048 + col0 + bj * HALF) = w; } }
    }
};
struct EpiY1 {
    static constexpr bool PERM = false, AFTER_DRAIN = false;
    float* Y; const float* X; const float* stats; const float* g0; const float* b0; const float* bo; float alpha;
    __device__ __forceinline__ void operator()(const f32x4 (&acc)[2][2][4][2], const Unit& u, int wr, int wc, int fr, int fq) const {
        const int row0 = u.pm * BM + wr * 64 + fr, col0 = u.pn * BM + wc * 32 + 4 * fq;
        f32x4 ag[2][2], cb[2][2];
#pragma unroll
        for (int bj = 0; bj < 2; ++bj)
#pragma unroll
            for (int n = 0; n < 2; ++n) { const int c = col0 + bj * HALF + n * 16; ag[bj][n] = *(const f32x4*)(g0 + c) * alpha; cb[bj][n] = *(const f32x4*)(b0 + c) * alpha + *(const f32x4*)(bo + c); }
#pragma unroll
        for (int ai = 0; ai < 2; ++ai)
#pragma unroll
            for (int m = 0; m < 4; ++m) { const size_t r = (size_t)(row0 + ai * HALF + m * 16); const float mu = stats[2 * r], rs = stats[2 * r + 1];
#pragma unroll
                for (int bj = 0; bj < 2; ++bj)
#pragma unroll
                    for (int n = 0; n < 2; ++n) { const size_t o = r * 2048 + col0 + bj * HALF + n * 16; const f32x4 xv = *(const f32x4*)(X + o);
                        *(f32x4*)(Y + o) = (xv - mu) * rs * ag[bj][n] + cb[bj][n] + acc[ai][bj][m][n]; }
                asm volatile("" ::: "memory"); }
    }
};
struct EpiSwiGLU {
    static constexpr bool PERM = true, AFTER_DRAIN = false;
    bf16_t* H;
    __device__ __forceinline__ void operator()(const f32x4 (&acc)[2][2][4][2], const Unit& u, int wr, int wc, int fr, int fq) const {
        const int row0 = u.pm * BM + wr * 64 + fr, col0 = (u.pn & 3) * 128 + wc * 32 + 8 * fq;
#pragma unroll
        for (int ai = 0; ai < 2; ++ai)
#pragma unroll
            for (int m = 0; m < 4; ++m) { f32x4 v0, v1;
#pragma unroll
                for (int j = 0; j < 4; ++j) { const float a = acc[ai][0][m][0][j], b = acc[ai][0][m][1][j]; v0[j] = a * sigm(a) * acc[ai][1][m][0][j]; v1[j] = b * sigm(b) * acc[ai][1][m][1][j]; }
                u32x4 w; w.x = cvt_pk_bf16(v0[0], v0[1]); w.y = cvt_pk_bf16(v0[2], v0[3]); w.z = cvt_pk_bf16(v1[0], v1[1]); w.w = cvt_pk_bf16(v1[2], v1[3]);
                *(u32x4*)(H + (size_t)(row0 + ai * HALF + m * 16) * 512 + col0) = w; }
    }
};
struct EpiYs {
    static constexpr bool PERM = true, AFTER_DRAIN = false;
    bf16_t* O; int ldc; int pn_mask;
    __device__ __forceinline__ void operator()(const f32x4 (&acc)[2][2][4][2], const Unit& u, int wr, int wc, int fr, int fq) const {
        const int row0 = u.pm * BM + wr * 64 + fr, col0 = (u.pn & pn_mask) * BM + wc * 32 + 8 * fq;
#pragma unroll
        for (int ai = 0; ai < 2; ++ai)
#pragma unroll
            for (int m = 0; m < 4; ++m) { bf16_t* rowp = O + (size_t)(row0 + ai * HALF + m * 16) * ldc + col0;
#pragma unroll
                for (int bj = 0; bj < 2; ++bj) { const f32x4 v0 = acc[ai][bj][m][0], v1 = acc[ai][bj][m][1];
                    u32x4 w; w.x = cvt_pk_bf16(v0[0], v0[1]); w.y = cvt_pk_bf16(v0[2], v0[3]); w.z = cvt_pk_bf16(v1[0], v1[1]); w.w = cvt_pk_bf16(v1[2], v1[3]);
                    *(u32x4*)(rowp + bj * HALF) = w; } }
    }
};
struct MoeOrder {
    const int* tile_e; int ntiles, nper, G, c;
    __device__ __forceinline__ bool next(int i, Unit& u) const {
        const long L = (long)i * G + c; if (L >= (long)ntiles * nper) return false;
        const int j = (int)(L / nper), t = (int)(L % nper); u.pm = j; u.pn = tile_e[j] * nper + t; return true;
    }
    __device__ __forceinline__ void a_ready(const Unit&) const {}
    __device__ __forceinline__ void done(const Unit&) const {}
};
template <class Epi, class Sched, bool ALIGN_EPI = false, bool SP2 = false>
__device__ __forceinline__ void gemm_phase(PG8_LAS unsigned char* lds, const Gemm g, const Sched& S, const Epi& E) {
    const int tid = threadIdx.x, wid = __builtin_amdgcn_readfirstlane(tid >> 6), lane = tid & 63, wr = wid >> 2, wc = wid & 3, fr = lane & 15, fq = lane >> 4;
    const int K = g.K, nt = K / BK;
    unsigned voffA[2], voffB[2];
#pragma unroll
    for (int i = 0; i < 2; ++i) { int R, C; stage_rc(tid * 16 + i * 8192, R, C); const int Rb = Epi::PERM ? ((R & ~31) + perm32(R & 31)) : R;
        voffA[i] = (unsigned)(R * K + C) * 2u; voffB[i] = (unsigned)(Rb * K + C) * 2u; }
    const size_t kstep = (size_t)(BK * 2);
    const size_t hstep = (size_t)HALF * K * 2;
    const size_t tstep = 2 * hstep;
    const unsigned ldsw = (unsigned)wid * 1024u;
    const int aoff = lds_byte(wr * 64 + fr, fq * 8), boff = lds_byte(wc * 32 + fr, fq * 8);
#define PG8_SA(b, h) (((b) * 2 + (h)) * HTB)
#define PG8_SB(b, h) ((4 + (b) * 2 + (h)) * HTB)
#define PG8_STAGE(bufoff, gbase, voff) do { _Pragma("unroll") for (int _i = 0; _i < 2; ++_i) \
        __builtin_amdgcn_global_load_lds((const unsigned*)((const char*)(gbase) + (voff)[_i]), (PG8_LAS unsigned*)(lds + (bufoff) + ldsw + _i * 8192), 16, 0, 0); } while (0)
#define PG8_LDA(dst, b, h) do { _Pragma("unroll") for (int m = 0; m < 4; ++m) _Pragma("unroll") for (int k = 0; k < 2; ++k) dst[m][k] = *(const PG8_LAS bf16x8*)(lds + PG8_SA(b, h) + aoff + m * 2048 + k * 1024); } while (0)
#define PG8_LDB(dst, b, h) do { _Pragma("unroll") for (int n = 0; n < 2; ++n) _Pragma("unroll") for (int k = 0; k < 2; ++k) dst[n][k] = *(const PG8_LAS bf16x8*)(lds + PG8_SB(b, h) + boff + n * 2048 + k * 1024); } while (0)
#define PG8_MMA(ai, bj, At, Bt) do { __builtin_amdgcn_s_setprio(1); _Pragma("unroll") for (int m = 0; m < 4; ++m) _Pragma("unroll") for (int n = 0; n < 2; ++n) _Pragma("unroll") for (int k = 0; k < 2; ++k) \
        acc[ai][bj][m][n] = __builtin_amdgcn_mfma_f32_16x16x32_bf16(Bt[n][k], At[m][k], acc[ai][bj][m][n], 0, 0, 0); __builtin_amdgcn_s_setprio(0); } while (0)
#define PG8_WAIT_V(n) asm volatile("s_waitcnt vmcnt(" #n ")" ::: "memory")
#define PG8_WAIT_L(n) asm volatile("s_waitcnt lgkmcnt(" #n ")" ::: "memory")
#define PG8_BAR __builtin_amdgcn_s_barrier()
#define PG8_SCHED __builtin_amdgcn_sched_barrier(0)
    Unit cur, nxt; int ui = 0;
    if (!S.next(0, cur)) return;
    f32x4 acc[2][2][4][2];
#pragma unroll
    for (int a = 0; a < 2; ++a)
#pragma unroll
        for (int b = 0; b < 2; ++b)
#pragma unroll
            for (int m = 0; m < 4; ++m)
#pragma unroll
                for (int n = 0; n < 2; ++n) acc[a][b][m][n] = (f32x4){0.f, 0.f, 0.f, 0.f};
    bf16x8 At[4][2], B0[2][2], B1[2][2];
    const char* cA = (const char*)g.A + (size_t)cur.pm * tstep; const char* cB = (const char*)g.Bt + (size_t)cur.pn * tstep;
    S.a_ready(cur);
    if constexpr (SP2) {
        PG8_STAGE(PG8_SB(0, 0), cB, voffB); PG8_STAGE(PG8_SB(0, 1), cB + hstep, voffB); PG8_STAGE(PG8_SA(0, 0), cA, voffA); PG8_STAGE(PG8_SA(0, 1), cA + hstep, voffA);
        if (wr == 1) PG8_BAR;
        PG8_WAIT_V(2); PG8_BAR;
        PG8_STAGE(PG8_SB(1, 0), cB + kstep, voffB); PG8_STAGE(PG8_SA(1, 0), cA + kstep, voffA); PG8_STAGE(PG8_SB(1, 1), cB + hstep + kstep, voffB);
        PG8_WAIT_V(6); PG8_BAR;
    } else {
        PG8_STAGE(PG8_SB(0, 0), cB, voffB); PG8_STAGE(PG8_SA(0, 0), cA, voffA); PG8_STAGE(PG8_SB(0, 1), cB + hstep, voffB); PG8_STAGE(PG8_SA(0, 1), cA + hstep, voffA);
        if (wr == 1) PG8_BAR;
        PG8_WAIT_V(4); PG8_BAR;
        PG8_STAGE(PG8_SB(1, 0), cB + kstep, voffB); PG8_STAGE(PG8_SA(1, 0), cA + kstep, voffA); PG8_STAGE(PG8_SB(1, 1), cB + hstep + kstep, voffB);
        PG8_WAIT_V(6); PG8_BAR;
    }
    for (;;) {
        const bool has_next = S.next(ui + 1, nxt);
        const char* nA = has_next ? (const char*)g.A + (size_t)nxt.pm * tstep : cA; const char* nB = has_next ? (const char*)g.Bt + (size_t)nxt.pn * tstep : cB;
        for (int t = 0; t < nt; t += 2) {
            const bool last = (t == nt - 2);
            const char* a1 = cA + (size_t)(t + 1) * kstep;
            const char* a2 = last ? nA : cA + (size_t)(t + 2) * kstep; const char* b2 = last ? nB : cB + (size_t)(t + 2) * kstep;
            const char* a3 = a2 + kstep; const char* b3 = b2 + kstep;
            if (last && has_next) S.a_ready(nxt);
            if constexpr (SP2) {
            PG8_LDB(B0, 0, 0); PG8_LDB(B1, 0, 1); PG8_SCHED; PG8_LDA(At, 0, 0); PG8_STAGE(PG8_SA(1, 1), a1 + hstep, voffA);
            PG8_WAIT_V(8); PG8_WAIT_L(0); PG8_BAR; PG8_MMA(0, 0, At, B0); PG8_MMA(0, 1, At, B1); PG8_BAR; PG8_SCHED;
            PG8_LDA(At, 0, 1); PG8_STAGE(PG8_SB(0, 0), b2, voffB); PG8_STAGE(PG8_SB(0, 1), b2 + hstep, voffB); PG8_STAGE(PG8_SA(0, 0), a2, voffA);
            PG8_WAIT_V(8); PG8_WAIT_L(0); PG8_BAR; PG8_MMA(1, 0, At, B0); PG8_MMA(1, 1, At, B1); PG8_BAR; PG8_SCHED;
            PG8_LDB(B0, 1, 0); PG8_LDB(B1, 1, 1); PG8_SCHED; PG8_LDA(At, 1, 0); PG8_STAGE(PG8_SA(0, 1), a2 + hstep, voffA);
            PG8_WAIT_V(8); PG8_WAIT_L(0); PG8_BAR; PG8_MMA(0, 0, At, B0); PG8_MMA(0, 1, At, B1); PG8_BAR; PG8_SCHED;
            PG8_LDA(At, 1, 1); PG8_STAGE(PG8_SB(1, 0), b3, voffB); PG8_STAGE(PG8_SB(1, 1), b3 + hstep, voffB); PG8_STAGE(PG8_SA(1, 0), a3, voffA);
            PG8_WAIT_V(8); PG8_WAIT_L(0); PG8_BAR; PG8_MMA(1, 0, At, B0); PG8_MMA(1, 1, At, B1); PG8_BAR; PG8_SCHED;
            } else {
            PG8_LDB(B0, 0, 0); PG8_SCHED; PG8_LDA(At, 0, 0); PG8_STAGE(PG8_SA(1, 1), a1 + hstep, voffA);
            PG8_WAIT_L(8); PG8_BAR; PG8_WAIT_L(0); PG8_MMA(0, 0, At, B0); PG8_BAR; PG8_SCHED;
            PG8_LDB(B1, 0, 1); PG8_STAGE(PG8_SB(0, 0), b2, voffB);
            PG8_BAR; PG8_WAIT_L(0); PG8_MMA(0, 1, At, B1); PG8_BAR;
            PG8_LDA(At, 0, 1); PG8_STAGE(PG8_SA(0, 0), a2, voffA);
            PG8_BAR; PG8_WAIT_L(0); PG8_MMA(1, 0, At, B0); PG8_BAR; PG8_SCHED;
            PG8_STAGE(PG8_SB(0, 1), b2 + hstep, voffB);
            PG8_WAIT_V(6); PG8_BAR; PG8_MMA(1, 1, At, B1); PG8_BAR;
            PG8_LDB(B0, 1, 0); PG8_SCHED; PG8_LDA(At, 1, 0); PG8_STAGE(PG8_SA(0, 1), a2 + hstep, voffA);
            PG8_WAIT_L(8); PG8_BAR; PG8_WAIT_L(0); PG8_MMA(0, 0, At, B0); PG8_BAR; PG8_SCHED;
            PG8_LDB(B1, 1, 1); PG8_STAGE(PG8_SB(1, 0), b3, voffB);
            PG8_BAR; PG8_WAIT_L(0); PG8_MMA(0, 1, At, B1); PG8_BAR;
            PG8_LDA(At, 1, 1); PG8_STAGE(PG8_SA(1, 0), a3, voffA);
            PG8_BAR; PG8_WAIT_L(0); PG8_MMA(1, 0, At, B0); PG8_BAR; PG8_SCHED;
            PG8_STAGE(PG8_SB(1, 1), b3 + hstep, voffB);
            PG8_WAIT_V(6); PG8_BAR; PG8_MMA(1, 1, At, B1); PG8_BAR;
            }
        }
        if constexpr (ALIGN_EPI) { if (wr == 0) PG8_BAR; }
        if constexpr (!Epi::AFTER_DRAIN) { E(acc, cur, wr, wc, fr, fq); S.done(cur); }
        if (!has_next) break;
#pragma unroll
        for (int a = 0; a < 2; ++a)
#pragma unroll
            for (int b = 0; b < 2; ++b)
#pragma unroll
                for (int m = 0; m < 4; ++m)
#pragma unroll
                    for (int n = 0; n < 2; ++n) acc[a][b][m][n] = (f32x4){0.f, 0.f, 0.f, 0.f};
        cur = nxt; cA = nA; cB = nB; ++ui;
        if constexpr (ALIGN_EPI) { if (wr == 1) PG8_BAR; }
    }
    PG8_WAIT_V(0);
    if constexpr (!ALIGN_EPI) { if (wr == 0) PG8_BAR; }
    PG8_BAR;
    if constexpr (Epi::AFTER_DRAIN) { E.fused(acc, cur, wr, wc, fr, fq, lds, wid, lane); S.done(cur); }
#undef PG8_SA
#undef PG8_SB
#undef PG8_STAGE
#undef PG8_LDA
#undef PG8_LDB
#undef PG8_MMA
#undef PG8_WAIT_V
#undef PG8_WAIT_L
#undef PG8_BAR
#undef PG8_SCHED
}
}

#ifndef MK_N_LAUNCHES
#define MK_N_LAUNCHES 1
#endif
namespace cg = cooperative_groups;
#define GAS __attribute__((address_space(1)))
#define LAS __attribute__((address_space(3)))
typedef unsigned short bf16;
typedef unsigned u32x4 __attribute__((ext_vector_type(4)));
typedef unsigned u32x2 __attribute__((ext_vector_type(2)));
typedef float f32x4 __attribute__((ext_vector_type(4)));
typedef float f32x2 __attribute__((ext_vector_type(2)));
typedef short bf16x8 __attribute__((ext_vector_type(8)));
typedef short s16x4 __attribute__((ext_vector_type(4)));
typedef __bf16 bf16v2 __attribute__((ext_vector_type(2)));

constexpr int NWAVES = 8, NTHREADS = 512;
constexpr int BATCH = 2, SEQ = 8192, DM = 2048, MTOK = BATCH * SEQ;
constexpr int DIN = 11776, OFF_QA = 0, OFF_KA = 1024, OFF_VA = 2048, OFF_QB = 3072, OFF_KB = 4608, OFF_VB = 6144, OFF_GA = 7680, OFF_GB = 9728;
constexpr int GRID_W = 64, GRID_ROWS = SEQ / GRID_W, NA_HEADS = 8, DIL_HEADS = 12;
constexpr int NEXP = 64, DEXP = 512, PMAX = 49152, MAXTILES = PMAX / 256;
constexpr float LN_EPS = 1e-5f, DN_ALPHA = 1.189207115002721f, ATT_SCALE = 0.08838834764831845f;
constexpr int NRW = 80;
constexpr size_t MiB = 1u << 20, KiB = 1u << 10;
constexpr size_t WS_CTL = 0, WS_BAR = 16384, CTL_ZERO_BYTES = 65536;
constexpr size_t WS_STATS0 = 1 * MiB, WS_STATS1 = 1 * MiB + 128 * KiB, WS_TOKE = 1 * MiB + 256 * KiB, WS_TOKW = 1 * MiB + 384 * KiB, WS_TOKP = 1 * MiB + 512 * KiB, WS_TOKS = 1 * MiB + 640 * KiB, WS_TILE = 1 * MiB + 768 * KiB;
constexpr size_t WS_LSE = 2 * MiB;
constexpr size_t WS_WRH = 3 * MiB, WS_WRL = 3 * MiB + 512 * KiB;
constexpr size_t WS_WIN = 4 * MiB, WS_WA = 50 * MiB, WS_WB = 54 * MiB, WS_WO = 56 * MiB;
constexpr size_t WS_ACT = 64 * MiB;
constexpr size_t WS_NA = 128 * MiB, WS_DILG = 160 * MiB, WS_DILO = 208 * MiB;
constexpr size_t WS_Z = 224 * MiB;
constexpr size_t WS_WUP = 592 * MiB, WS_WDN = 848 * MiB, WS_END = 976 * MiB;
constexpr size_t WS_XS = 224 * MiB, WS_HID = 416 * MiB, WS_YS = 224 * MiB, WS_LO = 464 * MiB;
static_assert(WS_WIN + (size_t)DIN * DM * 2 <= WS_WA && WS_Z + (size_t)MTOK * DIN * 2 <= WS_WUP && WS_XS + (size_t)PMAX * DM * 2 <= WS_HID && WS_HID + (size_t)PMAX * DEXP * 2 <= WS_LO && WS_LO + (size_t)MTOK * DM * 2 <= WS_WUP, "ws map");
constexpr int RING_BYTES = 131072, MISC_OFF = RING_BYTES, XB_LDS_OFF = RING_BYTES + 15360, LDS_BYTES = 147456;
#ifndef CG_SEAM_MASK
#define CG_SEAM_MASK 1
#endif

__device__ __forceinline__ unsigned pk2(float lo, float hi) { f32x2 v = {lo, hi}; bf16v2 b = __builtin_convertvector(v, bf16v2); return __builtin_bit_cast(unsigned, b); }
__device__ __forceinline__ float bfl(unsigned w) { return __uint_as_float(w << 16); }
__device__ __forceinline__ float bfh(unsigned w) { return __uint_as_float(w & 0xffff0000u); }
__device__ __forceinline__ float wave_sum(float v) {
#pragma unroll
    for (int o = 1; o < 64; o <<= 1) v += __shfl_xor(v, o);
    return v;
}
#define LDS_WAIT() asm volatile("s_waitcnt lgkmcnt(0)" ::: "memory")
#define VM_WAIT() asm volatile("s_waitcnt vmcnt(0)" ::: "memory")

struct Args { const float* in[21]; float* out; unsigned char* ws; int ph_lo, ph_hi; };
enum { IN_X = 0, IN_LN0G, IN_LN0B, IN_WIN, IN_BIN, IN_RPB, IN_WPA, IN_WPB, IN_WO, IN_BO, IN_LN1G, IN_LN1B, IN_WRG, IN_BRG, IN_WRE, IN_BRE, IN_WG, IN_WU, IN_WD, IN_LN2G, IN_LN2B };

__device__ __forceinline__ void p0_transpose_item(const float* W, int N, int K, bf16* WT, long dst_row0, int k0, int n0, LAS float* scr, int lane) {
#pragma unroll 8
    for (int i = 0; i < 32; ++i) { const int kk = 2 * i + (lane >> 5); scr[kk * 33 + (lane & 31)] = W[(size_t)(k0 + kk) * N + n0 + (lane & 31)]; }
    LDS_WAIT();
    const int c = lane & 7;
#pragma unroll
    for (int j = 0; j < 4; ++j) { const int n = (lane >> 3) + 8 * j; const LAS float* s = scr + (8 * c) * 33 + n;
        u32x4 o; o.x = pk2(s[0 * 33], s[1 * 33]); o.y = pk2(s[2 * 33], s[3 * 33]); o.z = pk2(s[4 * 33], s[5 * 33]); o.w = pk2(s[6 * 33], s[7 * 33]);
        *(u32x4*)(WT + (size_t)(dst_row0 + n) * K + k0 + 8 * c) = o; }
    LDS_WAIT();
}
__device__ __forceinline__ void p0_prologue(const Args& a, LAS unsigned char* lds, int gw, int NGW, int wave, int lane) {
    LAS float* scr = (LAS float*)(lds + wave * 16384);
    unsigned char* ws = a.ws;
    constexpr int I0 = 32 * 368, I1 = 16 * 64, I2 = 8 * 64, I3 = 32 * 64, I4 = NEXP * 32 * 16, I5 = I4, I6 = NEXP * 8 * 64;
    constexpr int NITEMS = I0 + I1 + I2 + I3 + I4 + I5 + I6;
    for (int it = gw; it < NITEMS; it += NGW) {
        int r = it;
        if (r < I0) { const int kb = r / 368, nb = r % 368; p0_transpose_item(a.in[IN_WIN], DIN, DM, (bf16*)(ws + WS_WIN), 32 * nb, 64 * kb, 32 * nb, scr, lane); continue; } r -= I0;
        if (r < I1) { const int kb = r / 64, nb = r % 64; p0_transpose_item(a.in[IN_WPA], DM, 1024, (bf16*)(ws + WS_WA), 32 * nb, 64 * kb, 32 * nb, scr, lane); continue; } r -= I1;
        if (r < I2) { const int kb = r / 64, nb = r % 64; p0_transpose_item(a.in[IN_WPB], DM, 512, (bf16*)(ws + WS_WB), 32 * nb, 64 * kb, 32 * nb, scr, lane); continue; } r -= I2;
        if (r < I3) { const int kb = r / 64, nb = r % 64; p0_transpose_item(a.in[IN_WO], DM, DM, (bf16*)(ws + WS_WO), 32 * nb, 64 * kb, 32 * nb, scr, lane); continue; } r -= I3;
        if (r < I4 + I5) { const int mat = r >= I4; if (mat) r -= I4; const int e = r / 512, q = r % 512, kb = q / 16, nb = q % 16, n0 = 32 * nb;
            const float* W = (mat ? a.in[IN_WU] : a.in[IN_WG]) + (size_t)e * DM * DEXP;
            p0_transpose_item(W, DEXP, DM, (bf16*)(ws + WS_WUP), (long)e * 1024 + (n0 >> 7) * 256 + mat * 128 + (n0 & 127), 64 * kb, n0, scr, lane); continue; } r -= I4 + I5;
        { const int e = r / 512, q = r % 512, kb = q / 64, nb = q % 64;
            p0_transpose_item(a.in[IN_WD] + (size_t)e * DEXP * DM, DM, DEXP, (bf16*)(ws + WS_WDN), (long)e * 2048 + 32 * nb, 64 * kb, 32 * nb, scr, lane); }
    }
    { bf16* wh = (bf16*)(ws + WS_WRH); bf16* wl = (bf16*)(ws + WS_WRL);
      for (int i = gw * 64 + lane; i < NRW * DM; i += NGW * 64) { const int n = i / DM, k = i % DM;
          const float v = n < 8 ? a.in[IN_WRG][(size_t)k * 8 + n] : (n < 72 ? a.in[IN_WRE][(size_t)k * 64 + (n - 8)] : 0.f);
          const unsigned h = pk2(v, 0.f) & 0xffffu; const float r = v - __uint_as_float(h << 16);
          wh[i] = (bf16)h; wl[i] = (bf16)(pk2(r, 0.f) & 0xffffu); } }
    { const float* g = a.in[IN_LN0G]; const float* bb = a.in[IN_LN0B]; float* st = (float*)(ws + WS_STATS0); bf16* H = (bf16*)(ws + WS_ACT);
      f32x4 gv[8], bv[8];
#pragma unroll
      for (int j = 0; j < 8; ++j) { gv[j] = *(const f32x4*)(g + 256 * j + 4 * lane); bv[j] = *(const f32x4*)(bb + 256 * j + 4 * lane); }
      for (int m = gw; m < MTOK; m += NGW) {
          const float* xr = a.in[IN_X] + (size_t)m * DM + 4 * lane; f32x4 v[8]; float s = 0.f;
#pragma unroll
          for (int j = 0; j < 8; ++j) { v[j] = *(const f32x4*)(xr + 256 * j); s += (v[j].x + v[j].y) + (v[j].z + v[j].w); }
          const float mean = wave_sum(s) * (1.f / DM); float s2 = 0.f;
#pragma unroll
          for (int j = 0; j < 8; ++j) { v[j] = v[j] - mean; s2 += (v[j].x * v[j].x + v[j].y * v[j].y) + (v[j].z * v[j].z + v[j].w * v[j].w); }
          const float rstd = 1.0f / sqrtf(wave_sum(s2) * (1.f / DM) + LN_EPS);
          if (lane == 0) { st[2 * m] = mean; st[2 * m + 1] = rstd; }
          bf16* orow = H + (size_t)m * DM + 4 * lane;
#pragma unroll
          for (int j = 0; j < 8; ++j) { const f32x4 y = v[j] * rstd * gv[j] + bv[j]; u32x2 w; w.x = pk2(y.x, y.y); w.y = pk2(y.z, y.w); *(u32x2*)(orow + 256 * j) = w; }
      } }
}
#define XB_TMO      128
#define XB_XCNT(j)  (256  + 64 * (j))
#define XB_XSUB(j)  (1280 + 64 * (j))
#define XB_XGEN(j)  (2304 + 64 * (j))
#define XB_TOP      3328
#define XB_TOPGEN   3392
#define XCD_BAR_WORDS 3456
#define XB_SPIN_CAP (1u << 18)

__device__ __forceinline__ unsigned xb_ld(unsigned* p)              { return __hip_atomic_load(p, __ATOMIC_RELAXED, __HIP_MEMORY_SCOPE_AGENT); }
__device__ __forceinline__ unsigned xb_add(unsigned* p, unsigned v) { return __hip_atomic_fetch_add(p, v, __ATOMIC_RELAXED, __HIP_MEMORY_SCOPE_AGENT); }
__device__ __forceinline__ unsigned xb_xcc_id() { return (unsigned)__builtin_amdgcn_s_getreg((3 << 11) | 20) & 0xFu; }
#define XB_SPIN(cond, bar) do { unsigned _sp = 0; while (cond) { __builtin_amdgcn_s_sleep(1); \
    if ((++_sp & 255u) == 0u) { if (xb_ld(&(bar)[XB_TMO])) break; if (_sp > XB_SPIN_CAP) { atomicAdd(&(bar)[XB_TMO], 1u); break; } } } } while (0)

struct XcdBarrier {
    unsigned* bar; unsigned x;
    volatile LAS unsigned* st;
};

__device__ __forceinline__ XcdBarrier xcd_barrier_post(unsigned* bar, volatile LAS unsigned* st) {
    XcdBarrier b; b.bar = bar; b.x = xb_xcc_id(); b.st = st;
    if (threadIdx.x == 0) (void)xb_add(&bar[XB_XCNT(b.x)], 1u);
    return b;
}
__device__ __forceinline__ void xcd_barrier_complete(unsigned* bar, unsigned x, unsigned& nloc, unsigned& nx) {
    const unsigned G = gridDim.x * gridDim.y * gridDim.z;
    unsigned sum, cnt, mine, sp = 0u;
    for (;;) {
        sum = 0u; cnt = 0u; mine = 0u;
#pragma unroll
        for (unsigned j = 0; j < 16; ++j) { const unsigned c = xb_ld(&bar[XB_XCNT(j)]); sum += c; cnt += (c > 0u) ? 1u : 0u; mine = (j == x) ? c : mine; }
        if (sum == G) break;
        __builtin_amdgcn_s_sleep(1);
        if ((++sp & 255u) == 0u) { if (xb_ld(&bar[XB_TMO])) break; if (sp > XB_SPIN_CAP) { atomicAdd(&bar[XB_TMO], 1u); break; } }
    }
    nloc = mine > 0u ? mine : 1u; nx = cnt > 0u ? cnt : 1u;
}

__device__ __forceinline__ void xcd_barrier(const XcdBarrier& b) {
    asm volatile("s_waitcnt vmcnt(0)" ::: "memory");
    __syncthreads();
    if (threadIdx.x == 0) {
        unsigned* bar = b.bar;
        __builtin_amdgcn_s_waitcnt(0);
        unsigned nloc = b.st[0], nx = b.st[1];
        if (nloc == 0u) { xcd_barrier_complete(bar, b.x, nloc, nx); b.st[0] = nloc; b.st[1] = nx; }
        const unsigned old = xb_add(&bar[XB_XSUB(b.x)], 1u);
        const unsigned gen = old / nloc;
        if (old + 1u == (gen + 1u) * nloc) {
            __builtin_amdgcn_fence(__ATOMIC_RELEASE, "agent");
            asm volatile("s_waitcnt vmcnt(0)" ::: "memory");
            const unsigned og = xb_add(&bar[XB_TOP], 1u);
            const unsigned tg = og / nx;
            if (og + 1u == (tg + 1u) * nx) xb_add(&bar[XB_TOPGEN], 1u);
            else XB_SPIN(xb_ld(&bar[XB_TOPGEN]) == tg, bar);
            __builtin_amdgcn_fence(__ATOMIC_ACQUIRE, "agent");
            xb_add(&bar[XB_XGEN(b.x)], 1u);
            asm volatile("s_waitcnt vmcnt(0)" ::: "memory");
        } else {
            XB_SPIN(xb_ld(&bar[XB_XGEN(b.x)]) == gen, bar);
            __builtin_amdgcn_fence(__ATOMIC_ACQUIRE, "agent");
            asm volatile("s_waitcnt vmcnt(0)" ::: "memory");
        }
    }
    __syncthreads();
}

__device__ __forceinline__ unsigned off_b(unsigned row, unsigned ch) { return 256u * row + 16u * (ch ^ (((row & 3) << 2) | ((row >> 2) & 3))); }
__device__ __forceinline__ unsigned tr_read_addr_16(unsigned lane, unsigned c, unsigned t) { const unsigned g = lane >> 4, q = (lane & 15) >> 2, p = lane & 3; return off_b(8 * g + 4 * t + q, 2 * c + (p >> 1)) + 8 * (p & 1); }

struct NaSpec {
    static constexpr int NKS = 8;
    const bf16* zb; int h, r, c, start, kc0; const LAS float* rpb;
    __device__ __forceinline__ const bf16* q_ptr(int q) const { return zb + (size_t)(r * GRID_W + 16 * c + q) * DIN + OFF_QA + h * 128; }
    __device__ __forceinline__ const bf16* k_ptr(int ks, int idx) const { return zb + (size_t)((start + ks) * GRID_W + kc0 + idx) * DIN + OFF_KA + h * 128; }
    __device__ __forceinline__ const bf16* v_ptr(int ks, int idx) const { return zb + (size_t)((start + ks) * GRID_W + kc0 + idx) * DIN + OFF_VA + h * 128; }
    __device__ __forceinline__ float fix(float s, int ks, int idx, int q) const {
        const int kcol = kc0 + idx, qcol = 16 * c + q; int qcs = qcol - 8; qcs = qcs < 0 ? 0 : (qcs > 48 ? 48 : qcs);
        int dc = kcol - qcol + 15; dc = dc < 0 ? 0 : (dc > 30 ? 30 : dc);
        const float bias = rpb[(start + ks - r + 7) * 31 + dc];
        return (kcol >= qcs && kcol < qcs + 16) ? s * ATT_SCALE + bias : -INFINITY;
    }
};
struct DilSpec {
    static constexpr int NKS = 5;
    const bf16* zb; int hd, d, res, pq0, L; float slope_d;
    __device__ __forceinline__ size_t tok(int p) const { p = p < 0 ? 0 : (p > L - 1 ? L - 1 : p); return (size_t)(p * d + res); }
    __device__ __forceinline__ const bf16* q_ptr(int q) const { return zb + tok(pq0 + q) * DIN + OFF_QB + hd * 128; }
    __device__ __forceinline__ const bf16* k_ptr(int ks, int idx) const { return zb + tok(pq0 - 64 + 32 * ks + idx) * DIN + OFF_KB + hd * 128; }
    __device__ __forceinline__ const bf16* v_ptr(int ks, int idx) const { return zb + tok(pq0 - 64 + 32 * ks + idx) * DIN + OFF_VB + hd * 128; }
    __device__ __forceinline__ float fix(float s, int ks, int idx, int q) const {
        const int rel = -64 + 32 * ks + idx - q, pk = pq0 - 64 + 32 * ks + idx; const int ar = rel < 0 ? -rel : rel;
        return (ar <= 64 && pk >= 0 && pk < L) ? s * ATT_SCALE - slope_d * (float)ar : -INFINITY;
    }
};
template <class SP>
__device__ __forceinline__ void attn_wave(const SP& sp, LAS unsigned char* vlds, int lane, f32x4 (&o)[8], float& lse) {
    constexpr int NKS = SP::NKS;
    const int q = lane & 15, g = lane >> 4;
    f32x4 s[NKS][2];
    {
        bf16x8 qf[4];
        const bf16* qrow = sp.q_ptr(q) + 8 * g;
#pragma unroll
        for (int dk = 0; dk < 4; ++dk) qf[dk] = *(const bf16x8*)(qrow + 32 * dk);
        const int ki = 8 * (q >> 2) + (q & 3);
        bf16x8 kf[2][4];
#pragma unroll
        for (int blk = 0; blk < 2; ++blk) { const bf16* krow = sp.k_ptr(0, ki + 4 * blk) + 8 * g;
#pragma unroll
            for (int dk = 0; dk < 4; ++dk) kf[blk][dk] = *(const bf16x8*)(krow + 32 * dk); }
#pragma unroll
        for (int ks = 0; ks < NKS; ++ks) {
            bf16x8 kn[2][4];
            if (ks + 1 < NKS) {
#pragma unroll
                for (int blk = 0; blk < 2; ++blk) { const bf16* krow = sp.k_ptr(ks + 1, ki + 4 * blk) + 8 * g;
#pragma unroll
                    for (int dk = 0; dk < 4; ++dk) kn[blk][dk] = *(const bf16x8*)(krow + 32 * dk); }
            }
            __builtin_amdgcn_sched_barrier(0);
#pragma unroll
            for (int blk = 0; blk < 2; ++blk) {
                f32x4 acc = {0.f, 0.f, 0.f, 0.f};
#pragma unroll
                for (int dk = 0; dk < 4; ++dk) acc = __builtin_amdgcn_mfma_f32_16x16x32_bf16(kf[blk][dk], qf[dk], acc, 0, 0, 0);
                s[ks][blk] = acc;
            }
            __builtin_amdgcn_sched_barrier(0);
            if (ks + 1 < NKS) {
#pragma unroll
                for (int blk = 0; blk < 2; ++blk)
#pragma unroll
                    for (int dk = 0; dk < 4; ++dk) kf[blk][dk] = kn[blk][dk];
            }
        }
    }
    const int vrow = lane >> 4;
#define ATT_STAGE_V(ks_, bufoff_) do { _Pragma("unroll") for (int i_ = 0; i_ < 8; ++i_) { const unsigned row_ = 4u * i_ + vrow; const unsigned ch_ = (lane & 15u) ^ (((row_ & 3u) << 2) | ((row_ >> 2) & 3u)); \
        __builtin_amdgcn_global_load_lds((const unsigned*)(sp.v_ptr(ks_, (int)row_) + 8 * ch_), (LAS unsigned*)(vlds + (bufoff_) + i_ * 1024), 16, 0, 0); } } while (0)
    ATT_STAGE_V(0, 0);
    float mx = -INFINITY;
#pragma unroll
    for (int ks = 0; ks < NKS; ++ks)
#pragma unroll
        for (int blk = 0; blk < 2; ++blk)
#pragma unroll
            for (int r = 0; r < 4; ++r) { const float v = sp.fix(s[ks][blk][r], ks, 8 * g + 4 * blk + r, q); s[ks][blk][r] = v; mx = fmaxf(mx, v); if (blk == 1 && r == 3) __builtin_amdgcn_sched_barrier(0); }
    mx = fmaxf(mx, __shfl_xor(mx, 16)); mx = fmaxf(mx, __shfl_xor(mx, 32));
    float sum = 0.f;
#pragma unroll
    for (int ks = 0; ks < NKS; ++ks)
#pragma unroll
        for (int blk = 0; blk < 2; ++blk)
#pragma unroll
            for (int r = 0; r < 4; ++r) { const float p = __builtin_amdgcn_exp2f((s[ks][blk][r] - mx) * 1.4426950408889634f); s[ks][blk][r] = p; sum += p; }
    sum += __shfl_xor(sum, 16); sum += __shfl_xor(sum, 32);
    lse = mx + __logf(sum);
    const float inv = 1.0f / sum;
    __builtin_amdgcn_sched_barrier(0);
    u32x4 pw[NKS];
#pragma unroll
    for (int ks = 0; ks < NKS; ++ks) { pw[ks].x = pk2(s[ks][0][0] * inv, s[ks][0][1] * inv); pw[ks].y = pk2(s[ks][0][2] * inv, s[ks][0][3] * inv); pw[ks].z = pk2(s[ks][1][0] * inv, s[ks][1][1] * inv); pw[ks].w = pk2(s[ks][1][2] * inv, s[ks][1][3] * inv);
        asm volatile("" : "+v"(pw[ks].x), "+v"(pw[ks].y), "+v"(pw[ks].z), "+v"(pw[ks].w)); }
    __builtin_amdgcn_sched_barrier(0);
#pragma unroll
    for (int c = 0; c < 8; ++c) o[c] = (f32x4){0.f, 0.f, 0.f, 0.f};
    unsigned tra[2];
#pragma unroll
    for (int t = 0; t < 2; ++t) tra[t] = tr_read_addr_16(lane, 0, t);
#pragma unroll
    for (int ks = 0; ks < NKS; ++ks) {
        LAS unsigned char* buf = vlds + (ks & 1) * 8192;
        VM_WAIT();
        if (ks + 1 < NKS) ATT_STAGE_V(ks + 1, ((ks + 1) & 1) * 8192);
        const bf16x8 pf = __builtin_bit_cast(bf16x8, pw[ks]);
#pragma unroll
        for (int c = 0; c < 8; ++c) {
            const s16x4 t0 = __builtin_amdgcn_ds_read_tr16_b64_v4i16((LAS s16x4*)(buf + (tra[0] ^ (32u * c))));
            const s16x4 t1 = __builtin_amdgcn_ds_read_tr16_b64_v4i16((LAS s16x4*)(buf + (tra[1] ^ (32u * c))));
            const bf16x8 vf = __builtin_shufflevector(t0, t1, 0, 1, 2, 3, 4, 5, 6, 7);
            o[c] = __builtin_amdgcn_mfma_f32_16x16x32_bf16(vf, pf, o[c], 0, 0, 0);
        }
        __builtin_amdgcn_sched_barrier(0);
    }
#undef ATT_STAGE_V
}
__device__ __forceinline__ void p2_attention(const Args& a, LAS unsigned char* lds, int gw, int NGW, int wave, int lane) {
    unsigned char* ws = a.ws; const bf16* z = (const bf16*)(ws + WS_Z);
    LAS float* rpb = (LAS float*)(lds + MISC_OFF);
    for (int i = threadIdx.x; i < NA_HEADS * 465; i += NTHREADS) rpb[i] = a.in[IN_RPB][i];
    __syncthreads();
    LAS unsigned char* vlds = lds + wave * 16384;
    constexpr int N_NA = BATCH * NA_HEADS * GRID_ROWS * 4, N_DIL = DIL_HEADS * BATCH * 64 * 8;
    for (int it = gw; it < N_NA + N_DIL; it += NGW) {
        f32x4 o[8]; float lse;
        asm volatile("" : "+v"(lane));
        const int q = lane & 15, g = lane >> 4;
        if (it < N_NA) {
            const int c = it & 3, r = (it >> 2) & 127, h = (it >> 9) & 7, b = it >> 12;
            NaSpec sp; sp.zb = z + (size_t)b * SEQ * DIN; sp.h = h; sp.r = r; sp.c = c; int st = r - 4; st = st < 0 ? 0 : (st > GRID_ROWS - 8 ? GRID_ROWS - 8 : st); sp.start = st;
            int kc = 16 * c - 8; kc = kc < 0 ? 0 : (kc > 32 ? 32 : kc); sp.kc0 = kc; sp.rpb = rpb + h * 465;
            attn_wave(sp, vlds, lane, o, lse);
            bf16* orow = (bf16*)(ws + WS_NA) + (size_t)(b * SEQ + r * GRID_W + 16 * c + q) * 1024 + h * 128 + 4 * g;
#pragma unroll
            for (int cc = 0; cc < 8; ++cc) { u32x2 w; w.x = pk2(o[cc][0], o[cc][1]); w.y = pk2(o[cc][2], o[cc][3]); *(u32x2*)(orow + 16 * cc) = w; }
        } else {
            const int j = it - N_NA; const int sub = j & 7, blk = (j >> 3) & 63, b = (j >> 9) & 1, hd = j >> 10;
            const int grp = hd >> 2, slot = hd & 3, d = grp == 0 ? 1 : (grp == 1 ? 4 : 16), L = SEQ / d, nb = L / 128;
            DilSpec sp; sp.zb = z + (size_t)b * SEQ * DIN; sp.hd = hd; sp.d = d; sp.res = blk / nb; sp.pq0 = (blk % nb) * 128 + 16 * sub; sp.L = L;
            sp.slope_d = exp2f(-8.0f * (float)(hd + 1) / 12.0f) * (float)d;
            attn_wave(sp, vlds, lane, o, lse);
            const size_t row = (size_t)b * SEQ + (size_t)(sp.pq0 + q) * d + sp.res;
            bf16* orow = (bf16*)(ws + WS_DILG) + ((size_t)grp * MTOK + row) * 512 + slot * 128 + 4 * g;
#pragma unroll
            for (int cc = 0; cc < 8; ++cc) { u32x2 w; w.x = pk2(o[cc][0], o[cc][1]); w.y = pk2(o[cc][2], o[cc][3]); *(u32x2*)(orow + 16 * cc) = w; }
            if (g == 0) ((float*)(ws + WS_LSE))[((size_t)grp * MTOK + row) * 4 + slot] = lse;
        }
    }
}
__device__ __forceinline__ void p3_combine(const Args& a, int gtid, int NT) {
    unsigned char* ws = a.ws; const float* lse = (const float*)(ws + WS_LSE); const bf16* og = (const bf16*)(ws + WS_DILG); bf16* out = (bf16*)(ws + WS_DILO);
    for (int i = gtid; i < MTOK * 64; i += NT) {
        const int row = i >> 6, ch = i & 63, slot = ch >> 4;
        const float l0 = lse[((size_t)0 * MTOK + row) * 4 + slot], l1 = lse[((size_t)1 * MTOK + row) * 4 + slot], l2 = lse[((size_t)2 * MTOK + row) * 4 + slot];
        const float mx = fmaxf(l0, fmaxf(l1, l2)); float w0 = __expf(l0 - mx), w1 = __expf(l1 - mx), w2 = __expf(l2 - mx); const float inv = 1.0f / (w0 + w1 + w2); w0 *= inv; w1 *= inv; w2 *= inv;
        const u32x4 a0 = *(const u32x4*)(og + ((size_t)0 * MTOK + row) * 512 + 8 * ch), a1 = *(const u32x4*)(og + ((size_t)1 * MTOK + row) * 512 + 8 * ch), a2 = *(const u32x4*)(og + ((size_t)2 * MTOK + row) * 512 + 8 * ch);
        u32x4 r;
        r.x = pk2(w0 * bfl(a0.x) + w1 * bfl(a1.x) + w2 * bfl(a2.x), w0 * bfh(a0.x) + w1 * bfh(a1.x) + w2 * bfh(a2.x));
        r.y = pk2(w0 * bfl(a0.y) + w1 * bfl(a1.y) + w2 * bfl(a2.y), w0 * bfh(a0.y) + w1 * bfh(a1.y) + w2 * bfh(a2.y));
        r.z = pk2(w0 * bfl(a0.z) + w1 * bfl(a1.z) + w2 * bfl(a2.z), w0 * bfh(a0.z) + w1 * bfh(a1.z) + w2 * bfh(a2.z));
        r.w = pk2(w0 * bfl(a0.w) + w1 * bfl(a1.w) + w2 * bfl(a2.w), w0 * bfh(a0.w) + w1 * bfh(a1.w) + w2 * bfh(a2.w));
        *(u32x4*)(out + (size_t)row * 512 + 8 * ch) = r;
    }
}

__device__ __forceinline__ void p6_ln1_router(const Args& a, LAS unsigned char* lds, int wave, int lane) {
    unsigned char* ws = a.ws; const float* Y = a.out; bf16* HI = (bf16*)(ws + WS_ACT); bf16* LO = (bf16*)(ws + WS_LO); float* st = (float*)(ws + WS_STATS1);
    const bf16* WH = (const bf16*)(ws + WS_WRH); const bf16* WL = (const bf16*)(ws + WS_WRL);
    LAS float* P = (LAS float*)lds;
    const float* g1 = a.in[IN_LN1G]; const float* b1 = a.in[IN_LN1B];
    for (int rg = blockIdx.x; rg < MTOK / 64; rg += gridDim.x) {
#pragma unroll 1
        for (int i = 0; i < 8; ++i) {
            const int m = rg * 64 + wave * 8 + i;
            const float* yr = Y + (size_t)m * DM + 4 * lane; f32x4 v[8]; float s = 0.f;
#pragma unroll
            for (int j = 0; j < 8; ++j) { v[j] = *(const f32x4*)(yr + 256 * j); s += (v[j].x + v[j].y) + (v[j].z + v[j].w); }
            const float mean = wave_sum(s) * (1.f / DM); float s2 = 0.f;
#pragma unroll
            for (int j = 0; j < 8; ++j) { v[j] = v[j] - mean; s2 += (v[j].x * v[j].x + v[j].y * v[j].y) + (v[j].z * v[j].z + v[j].w * v[j].w); }
            const float rstd = 1.0f / sqrtf(wave_sum(s2) * (1.f / DM) + LN_EPS);
            if (lane == 0) { st[2 * m] = mean; st[2 * m + 1] = rstd; }
            bf16* hrow = HI + (size_t)m * DM + 4 * lane; bf16* lrow = LO + (size_t)m * DM + 4 * lane;
#pragma unroll
            for (int j = 0; j < 8; ++j) { const f32x4 gv = *(const f32x4*)(g1 + 256 * j + 4 * lane), bv = *(const f32x4*)(b1 + 256 * j + 4 * lane); const f32x4 y = v[j] * rstd * gv + bv;
                u32x2 h; h.x = pk2(y.x, y.y); h.y = pk2(y.z, y.w);
                u32x2 l; l.x = pk2(y.x - bfl(h.x), y.y - bfh(h.x)); l.y = pk2(y.z - bfl(h.y), y.w - bfh(h.y));
                *(u32x2*)(hrow + 256 * j) = h; *(u32x2*)(lrow + 256 * j) = l; }
        }
        VM_WAIT(); __syncthreads();
        {
            const int rb = wave & 3, kh = wave >> 2, fr = lane & 15, fq = lane >> 4;
            const size_t arow = (size_t)(rg * 64 + rb * 16 + fr) * DM + kh * 1024 + 8 * fq;
            f32x4 acc[5];
#pragma unroll
            for (int cb = 0; cb < 5; ++cb) acc[cb] = (f32x4){0.f, 0.f, 0.f, 0.f};
#pragma unroll 2
            for (int s = 0; s < 32; ++s) {
                const bf16x8 ah = *(const bf16x8*)(HI + arow + 32 * s), al = *(const bf16x8*)(LO + arow + 32 * s);
#pragma unroll
                for (int cb = 0; cb < 5; ++cb) { const size_t brow = (size_t)(16 * cb + fr) * DM + kh * 1024 + 8 * fq + 32 * s;
                    const bf16x8 bh = *(const bf16x8*)(WH + brow), bl = *(const bf16x8*)(WL + brow);
                    acc[cb] = __builtin_amdgcn_mfma_f32_16x16x32_bf16(ah, bh, acc[cb], 0, 0, 0);
                    acc[cb] = __builtin_amdgcn_mfma_f32_16x16x32_bf16(ah, bl, acc[cb], 0, 0, 0);
                    acc[cb] = __builtin_amdgcn_mfma_f32_16x16x32_bf16(al, bh, acc[cb], 0, 0, 0); }
            }
#pragma unroll
            for (int cb = 0; cb < 5; ++cb)
#pragma unroll
                for (int r = 0; r < 4; ++r) P[((kh * 4 + rb) * 16 + 4 * fq + r) * NRW + 16 * cb + fr] = acc[cb][r];
        }
        __syncthreads();
        if (threadIdx.x < 64) {
            const int t = threadIdx.x, m = rg * 64 + t; const LAS float* p0 = P + (size_t)t * NRW; const LAS float* p1 = P + (size_t)(64 + t) * NRW;
            float gl[8]; int gs = 0; float gm = -INFINITY;
#pragma unroll
            for (int n = 0; n < 8; ++n) { gl[n] = p0[n] + p1[n] + a.in[IN_BRG][n]; if (gl[n] > gm) { gm = gl[n]; gs = n; } }
            float gsum = 0.f;
#pragma unroll
            for (int n = 0; n < 8; ++n) gsum += __expf(gl[n] - gm);
            const float gprob = 1.0f / gsum;
            float v0 = -INFINITY, v1 = -INFINITY; int i0 = 0, i1 = 0;
#pragma unroll
            for (int n = 0; n < 8; ++n) { const float e = p0[8 + gs * 8 + n] + p1[8 + gs * 8 + n] + a.in[IN_BRE][gs * 8 + n];
                if (e > v0) { v1 = v0; i1 = i0; v0 = e; i0 = n; } else if (e > v1) { v1 = e; i1 = n; } }
            const float e1 = __expf(v1 - v0), w0 = gprob / (1.0f + e1), w1 = gprob * e1 / (1.0f + e1);
            const int x0 = gs * 8 + i0, x1 = gs * 8 + i1;
            unsigned* cnt = (unsigned*)(ws + WS_CTL);
            const unsigned q0 = atomicAdd(cnt + x0, 1u), q1 = atomicAdd(cnt + x1, 1u);
            int* te = (int*)(ws + WS_TOKE); float* tw = (float*)(ws + WS_TOKW); int* tp = (int*)(ws + WS_TOKP);
            te[2 * m] = x0; te[2 * m + 1] = x1; tw[2 * m] = w0; tw[2 * m + 1] = w1; tp[2 * m] = (int)q0; tp[2 * m + 1] = (int)q1;
        }
        __syncthreads();
    }
}
__device__ __forceinline__ void p7_permute(const Args& a, LAS unsigned char* lds, int gw, int NGW, int lane) {
    unsigned char* ws = a.ws; const unsigned* cnt = (const unsigned*)(ws + WS_CTL);
    LAS int* pstart = (LAS int*)lds; LAS int* pcnt = pstart + 64; LAS int* rcnt = pstart + 128;
    int* tile = (int*)(ws + WS_TILE);
    if (threadIdx.x == 0) {
        int pos = 0, nt = 0;
        for (int e = 0; e < NEXP; ++e) { const int c = (int)cnt[e], pc = (c + 255) & ~255; pstart[e] = pos; rcnt[e] = c; pcnt[e] = pc;
            if (blockIdx.x == 0) for (int j = 0; j < pc / 256; ++j) tile[1 + nt + j] = e;
            nt += pc / 256; pos += pc; }
        if (blockIdx.x == 0) tile[0] = nt;
    }
    __syncthreads();
    const bf16* H = (const bf16*)(ws + WS_ACT); bf16* XS = (bf16*)(ws + WS_XS);
    const int* te = (const int*)(ws + WS_TOKE); const int* tp = (const int*)(ws + WS_TOKP); int* ts = (int*)(ws + WS_TOKS);
    for (int m = gw; m < MTOK; m += NGW) {
        const u32x4* src = (const u32x4*)(H + (size_t)m * DM) + lane; u32x4 v[4];
#pragma unroll
        for (int j = 0; j < 4; ++j) v[j] = src[64 * j];
#pragma unroll
        for (int k = 0; k < 2; ++k) { const int slot = pstart[te[2 * m + k]] + tp[2 * m + k]; if (lane == 0) ts[2 * m + k] = slot;
            u32x4* dst = (u32x4*)(XS + (size_t)slot * DM) + lane;
#pragma unroll
            for (int j = 0; j < 4; ++j) dst[64 * j] = v[j]; }
    }
    { const int e = gw & 63; const int base = pstart[e] + rcnt[e], npad = pcnt[e] - rcnt[e];
      for (int j = gw >> 6; j < npad; j += (NGW >> 6)) { u32x4* dst = (u32x4*)(XS + (size_t)(base + j) * DM) + lane;
#pragma unroll
          for (int q = 0; q < 4; ++q) dst[64 * q] = (u32x4){0u, 0u, 0u, 0u}; } }
}
__device__ __forceinline__ void p10_final(const Args& a, int gw, int NGW, int lane) {
    unsigned char* ws = a.ws; float* Y = a.out; const float* st = (const float*)(ws + WS_STATS1); const bf16* YS = (const bf16*)(ws + WS_YS);
    const int* ts = (const int*)(ws + WS_TOKS); const float* tw = (const float*)(ws + WS_TOKW);
    const float* g1 = a.in[IN_LN1G]; const float* b1 = a.in[IN_LN1B]; const float* g2 = a.in[IN_LN2G]; const float* b2 = a.in[IN_LN2B];
    for (int m = gw; m < MTOK; m += NGW) {
        float* yr = Y + (size_t)m * DM + 4 * lane; const float mu = st[2 * m], rs = st[2 * m + 1];
        const int s0 = ts[2 * m], s1 = ts[2 * m + 1]; const float w0 = tw[2 * m], w1 = tw[2 * m + 1];
        const bf16* e0 = YS + (size_t)s0 * DM + 4 * lane; const bf16* e1 = YS + (size_t)s1 * DM + 4 * lane;
        f32x4 v[8]; float s = 0.f;
#pragma unroll
        for (int j = 0; j < 8; ++j) { const f32x4 y = *(const f32x4*)(yr + 256 * j); const f32x4 gv = *(const f32x4*)(g1 + 256 * j + 4 * lane), bv = *(const f32x4*)(b1 + 256 * j + 4 * lane);
            const u32x2 c0 = *(const u32x2*)(e0 + 256 * j), c1 = *(const u32x2*)(e1 + 256 * j);
            f32x4 f; f.x = w0 * bfl(c0.x) + w1 * bfl(c1.x); f.y = w0 * bfh(c0.x) + w1 * bfh(c1.x); f.z = w0 * bfl(c0.y) + w1 * bfl(c1.y); f.w = w0 * bfh(c0.y) + w1 * bfh(c1.y);
            v[j] = ((y - mu) * rs * gv + bv) * DN_ALPHA + f; s += (v[j].x + v[j].y) + (v[j].z + v[j].w); }
        const float mean = wave_sum(s) * (1.f / DM); float s2 = 0.f;
#pragma unroll
        for (int j = 0; j < 8; ++j) { v[j] = v[j] - mean; s2 += (v[j].x * v[j].x + v[j].y * v[j].y) + (v[j].z * v[j].z + v[j].w * v[j].w); }
        const float rstd = 1.0f / sqrtf(wave_sum(s2) * (1.f / DM) + LN_EPS);
#pragma unroll
        for (int j = 0; j < 8; ++j) { const f32x4 gv = *(const f32x4*)(g2 + 256 * j + 4 * lane), bv = *(const f32x4*)(b2 + 256 * j + 4 * lane); *(f32x4*)(yr + 256 * j) = v[j] * rstd * gv + bv; }
    }
}

constexpr int N_PHASES = 11;
__global__ void __launch_bounds__(NTHREADS, 2) mk_fwd(Args args) {
    extern __shared__ __attribute__((aligned(16))) unsigned char lds_raw[];
    LAS unsigned char* lds = (LAS unsigned char*)lds_raw;
    const int tid = threadIdx.x, lane = tid & 63, wave = __builtin_amdgcn_readfirstlane(tid >> 6);
    const int G = gridDim.x, gw = blockIdx.x * NWAVES + wave, NGW = G * NWAVES;
    unsigned char* ws = args.ws;
    const int lo = args.ph_lo, hi = args.ph_hi;
#ifndef PHASE_MASK
#define PHASE_MASK 0x7ff
#endif
#define IN(k) (((PHASE_MASK >> (k)) & 1) && lo <= (k) && (k) < hi)
#if MK_N_LAUNCHES == 1
    cg::grid_group grid = cg::this_grid();
    { volatile LAS unsigned* st = (volatile LAS unsigned*)(lds + XB_LDS_OFF); if (tid < 2) st[tid] = 0u; }
    __syncthreads();
    const XcdBarrier bar = xcd_barrier_post((unsigned*)(ws + WS_BAR), (volatile LAS unsigned*)(lds + XB_LDS_OFF));
#define SEAM(k) do { if (IN(k) && IN((k) + 1)) { if (CG_SEAM_MASK >> (k) & 1) grid.sync(); else xcd_barrier(bar); } } while (0)
#else
#define SEAM(k) do { } while (0)
#endif
    if (IN(0)) p0_prologue(args, lds, gw, NGW, wave, lane);
    SEAM(0);
    if (IN(1)) { pg8::Gemm g{(const bf16*)(ws + WS_ACT), (const bf16*)(ws + WS_WIN), MTOK, DIN, DM}; pg8::StaticOrder S; S.init(MTOK, DIN, G, (int)blockIdx.x);
        pg8::EpiZ E{(bf16*)(ws + WS_Z), DIN, args.in[IN_BIN], OFF_GA / 256};
        pg8::gemm_phase<pg8::EpiZ, pg8::StaticOrder, true, true>(lds, g, S, E); }
    SEAM(1);
    if (IN(2)) p2_attention(args, lds, gw, NGW, wave, lane);
    SEAM(2);
    if (IN(3)) p3_combine(args, blockIdx.x * NTHREADS + tid, G * NTHREADS);
    SEAM(3);
    if (IN(4)) {
        { pg8::Gemm g{(const bf16*)(ws + WS_DILO), (const bf16*)(ws + WS_WB), MTOK, DM, 512}; pg8::StaticOrder S; S.init(MTOK, DM, G, (int)blockIdx.x);
          pg8::EpiGate<0> E{(bf16*)args.out, nullptr, (const bf16*)(ws + WS_Z) + OFF_GB, DIN};
          pg8::gemm_phase<pg8::EpiGate<0>, pg8::StaticOrder, true, true>(lds, g, S, E); }
        __syncthreads();
        { pg8::Gemm g{(const bf16*)(ws + WS_NA), (const bf16*)(ws + WS_WA), MTOK, DM, 1024}; pg8::StaticOrder S; S.init(MTOK, DM, G, (int)blockIdx.x);
          pg8::EpiGate<1> E{(bf16*)(ws + WS_ACT), (const bf16*)args.out, (const bf16*)(ws + WS_Z) + OFF_GA, DIN};
          pg8::gemm_phase<pg8::EpiGate<1>, pg8::StaticOrder, true, true>(lds, g, S, E); }
    }
    SEAM(4);
    if (IN(5)) { pg8::Gemm g{(const bf16*)(ws + WS_ACT), (const bf16*)(ws + WS_WO), MTOK, DM, DM}; pg8::StaticOrder S; S.init(MTOK, DM, G, (int)blockIdx.x);
        pg8::EpiY1 E{args.out, args.in[IN_X], (const float*)(ws + WS_STATS0), args.in[IN_LN0G], args.in[IN_LN0B], args.in[IN_BO], DN_ALPHA};
        pg8::gemm_phase<pg8::EpiY1, pg8::StaticOrder, true, true>(lds, g, S, E); }
    SEAM(5);
    if (IN(6)) p6_ln1_router(args, lds, wave, lane);
    SEAM(6);
    if (IN(7)) p7_permute(args, lds, gw, NGW, lane);
    SEAM(7);
    if (IN(8)) { const int* tile = (const int*)(ws + WS_TILE);
        pg8::Gemm g{(const bf16*)(ws + WS_XS), (const bf16*)(ws + WS_WUP), PMAX, NEXP * 1024, DM}; pg8::MoeOrder S{tile + 1, tile[0], 4, G, (int)blockIdx.x};
        pg8::EpiSwiGLU E{(bf16*)(ws + WS_HID)};
        pg8::gemm_phase<pg8::EpiSwiGLU, pg8::MoeOrder, true, true>(lds, g, S, E); }
    SEAM(8);
    if (IN(9)) { const int* tile = (const int*)(ws + WS_TILE);
        pg8::Gemm g{(const bf16*)(ws + WS_HID), (const bf16*)(ws + WS_WDN), PMAX, NEXP * 2048, DEXP}; pg8::MoeOrder S{tile + 1, tile[0], 8, G, (int)blockIdx.x};
        pg8::EpiYs E{(bf16*)(ws + WS_YS), DM, 7};
        pg8::gemm_phase<pg8::EpiYs, pg8::MoeOrder, true, true>(lds, g, S, E); }
    SEAM(9);
    if (IN(10)) p10_final(args, gw, NGW, lane);
#undef IN
#undef SEAM
}

extern "C" void kernel_launch(void* const* d_in, const int* in_sizes, int n_in, void* d_out, int out_size, void* d_ws, size_t ws_size, hipStream_t stream) {
    static int grid = 0;
    if (grid == 0) {
        if (n_in != 21 || in_sizes[0] != MTOK * DM || out_size != MTOK * DM || ws_size < WS_END) { fprintf(stderr, "kernel_launch: unexpected shapes (n_in %d, in0 %d, out %d, ws %zu < %zu)\n", n_in, n_in > 0 ? in_sizes[0] : -1, out_size, ws_size, (size_t)WS_END); grid = -1; return; }
        int dev = 0, cus = 0, per_cu = 0;
        if (hipGetDevice(&dev) != hipSuccess || hipDeviceGetAttribute(&cus, hipDeviceAttributeMultiprocessorCount, dev) != hipSuccess) { fprintf(stderr, "kernel_launch: device query failed\n"); grid = -1; return; }
        if (hipFuncSetAttribute((const void*)mk_fwd, hipFuncAttributeMaxDynamicSharedMemorySize, LDS_BYTES) != hipSuccess) { fprintf(stderr, "kernel_launch: hipFuncSetAttribute failed\n"); grid = -1; return; }
        if (hipOccupancyMaxActiveBlocksPerMultiprocessor(&per_cu, (const void*)mk_fwd, NTHREADS, LDS_BYTES) != hipSuccess || per_cu < 1) { fprintf(stderr, "kernel_launch: occupancy query says %d blocks per CU\n", per_cu); (void)hipGetLastError(); per_cu = 1; }
        grid = cus * 1;
        fprintf(stderr, "kernel_launch: %d CUs, occupancy %d per CU, grid %d\n", cus, per_cu, grid);
    }
    if (grid < 0) return;
    if (hipMemsetAsync((char*)d_ws + WS_CTL, 0, CTL_ZERO_BYTES, stream) != hipSuccess) { fprintf(stderr, "kernel_launch: memset failed\n"); return; }
    Args a{};
    for (int i = 0; i < 21; ++i) a.in[i] = (const float*)d_in[i];
    a.out = (float*)d_out; a.ws = (unsigned char*)d_ws;
#if MK_N_LAUNCHES == 1
    a.ph_lo = 0; a.ph_hi = N_PHASES;
    void* kargs[] = {&a};
    hipError_t e = hipLaunchCooperativeKernel((const void*)mk_fwd, dim3(grid), dim3(NTHREADS), kargs, LDS_BYTES, stream);
    if (e != hipSuccess) fprintf(stderr, "kernel_launch: cooperative launch failed: %s (grid %d)\n", hipGetErrorString(e), grid);
#else
    for (int p = 0; p < N_PHASES; ++p) { a.ph_lo = p; a.ph_hi = p + 1; hipLaunchKernelGGL(mk_fwd, dim3(grid), dim3(NTHREADS), LDS_BYTES, stream, a);
        const hipError_t le = hipPeekAtLastError(); if (le != hipSuccess) { fprintf(stderr, "kernel_launch: launch %d failed: %s\n", p, hipGetErrorName(le)); break; } }
#endif
}
```

```cpp
#include <hip/hip_runtime.h>
#include <hip/hip_cooperative_groups.h>
#include <cstdio>
#include <cstdint>
namespace pg8 {
#define PG8_LAS __attribute__((address_space(3)))
typedef unsigned short bf16_t;
typedef short bf16x8 __attribute__((ext_vector_type(8)));
typedef float f32x4 __attribute__((ext_vector_type(4)));
typedef unsigned u32x4 __attribute__((ext_vector_type(4)));
constexpr int BM = 256, BK = 64, HALF = 128, HTB = HALF * BK * 2  , STAGE_BYTES = 8 * HTB, NXCD = 8, WGM = 8;

__host__ __device__ __forceinline__ int lds_byte(int r, int c) { const int st = (r >> 4) * 2 + (c >> 5), rr = r & 15, cc = c & 31, ob = rr * 64 + cc * 2; return st * 1024 + (ob ^ (((ob >> 9) & 1) << 5)); }
__host__ __device__ __forceinline__ void stage_rc(int b, int& R, int& C) { const int st = b / 1024, sb = b % 1024, swz = sb ^ (((sb >> 9) & 1) << 5); R = (st >> 1) * 16 + swz / 64; C = (st & 1) * 32 + (swz % 64) / 2; }
__host__ __device__ __forceinline__ int perm32(int rho) { const int n = rho >> 4, i = rho & 15; return 8 * (i >> 2) + 4 * n + (i & 3); }

struct Unit { int pm, pn; };
struct Gemm { const bf16_t* A; const bf16_t* Bt; int M, N, K; };

struct StaticOrder {
    int nM, nN, nwg, G, c;
    __host__ __device__ void init(int M, int N, int G_, int c_) { nM = M / BM; nN = N / BM; nwg = nM * nN; G = G_; c = c_; }
    __host__ __device__ bool next(int i, Unit& u) const {
        const long L = (long)i * G + c; if (L >= nwg) return false;
        int wgid = (int)L; { const int q = nwg / NXCD, r = nwg % NXCD, xcd = wgid % NXCD, off = wgid / NXCD; wgid = (xcd < r ? xcd * (q + 1) : r * (q + 1) + (xcd - r) * q) + off; }
        const int nig = WGM * nN, gid = wgid / nig, fm = gid * WGM, gsz = (nM - fm) < WGM ? (nM - fm) : WGM;
        u.pm = fm + ((wgid % nig) % gsz); u.pn = (wgid % nig) / gsz; return true;
    }
    __device__ __forceinline__ void a_ready(const Unit&) const {}
    __device__ __forceinline__ void done(const Unit&) const {}
};
__device__ __forceinline__ unsigned cvt_pk_bf16(float lo, float hi) { unsigned r; asm volatile("v_cvt_pk_bf16_f32 %0, %1, %2" : "=v"(r) : "v"(lo), "v"(hi)); return r; }
typedef float f32x2 __attribute__((ext_vector_type(2)));
__device__ __forceinline__ float sigm(float x) { return __builtin_amdgcn_rcpf(1.0f + __builtin_amdgcn_exp2f(-1.4426950408889634f * x)); }
__device__ __forceinline__ float bf_lo(unsigned w) { return __uint_as_float(w << 16); }
__device__ __forceinline__ float bf_hi(unsigned w) { return __uint_as_float(w & 0xffff0000u); }
struct EpiZ {
    static constexpr bool PERM = true, AFTER_DRAIN = false; static constexpr int MID_T = 0;
    bf16_t* O; int ldc; const float* bias; int sig_pn;
    __device__ __forceinline__ void operator()(const f32x4 (&acc)[2][2][4][2], const Unit& u, int wr, int wc, int fr, int fq) const {
        const int row0 = u.pm * BM + wr * 64 + fr, col0 = u.pn * BM + wc * 32 + 8 * fq; const bool sg = u.pn >= sig_pn;
        f32x4 bv[2][2];
#pragma unroll
        for (int bj = 0; bj < 2; ++bj)
#pragma unroll
            for (int n = 0; n < 2; ++n) bv[bj][n] = *(const f32x4*)(bias + col0 + bj * HALF + 4 * n);
#pragma unroll
        for (int ai = 0; ai < 2; ++ai)
#pragma unroll
            for (int m = 0; m < 4; ++m) { bf16_t* rowp = O + (size_t)(row0 + ai * HALF + m * 16) * ldc + col0;
#pragma unroll
                for (int bj = 0; bj < 2; ++bj) { f32x4 v0 = acc[ai][bj][m][0] + bv[bj][0], v1 = acc[ai][bj][m][1] + bv[bj][1];
                    if (sg) {
#pragma unroll
                        for (int j = 0; j < 4; ++j) { v0[j] = sigm(v0[j]); v1[j] = sigm(v1[j]); } }
                    u32x4 w; w.x = cvt_pk_bf16(v0[0], v0[1]); w.y = cvt_pk_bf16(v0[2], v0[3]); w.z = cvt_pk_bf16(v1[0], v1[1]); w.w = cvt_pk_bf16(v1[2], v1[3]);
                    *(u32x4*)(rowp + bj * HALF) = w; } }
    }
};
struct EpiMix {
    static constexpr bool PERM = true, AFTER_DRAIN = false; static constexpr int MID_T = 8;
    bf16_t* O; const bf16_t* ga; const bf16_t* gb; int ldg;
    __device__ __forceinline__ void mid(f32x4 (&acc)[2][2][4][2], const Unit& u, int wr, int wc, int fr, int fq) const {
        int row0 = u.pm * BM + wr * 64 + fr; const int col0 = u.pn * BM + wc * 32 + 8 * fq;
        asm volatile("" : "+v"(row0));
#pragma unroll
        for (int ai = 0; ai < 2; ++ai)
#pragma unroll
            for (int m = 0; m < 4; ++m) { const size_t r = (size_t)(row0 + ai * HALF + m * 16);
#pragma unroll
                for (int bj = 0; bj < 2; ++bj) {
                    const u32x4 a = *(const u32x4*)(ga + r * ldg + col0 + bj * HALF), b = *(const u32x4*)(gb + r * ldg + col0 + bj * HALF);
                    f32x4& v0 = acc[ai][bj][m][0]; f32x4& v1 = acc[ai][bj][m][1];
                    v0[0] *= bf_lo(b.x) * __builtin_amdgcn_rcpf(bf_lo(a.x)); v0[1] *= bf_hi(b.x) * __builtin_amdgcn_rcpf(bf_hi(a.x)); v0[2] *= bf_lo(b.y) * __builtin_amdgcn_rcpf(bf_lo(a.y)); v0[3] *= bf_hi(b.y) * __builtin_amdgcn_rcpf(bf_hi(a.y));
                    v1[0] *= bf_lo(b.z) * __builtin_amdgcn_rcpf(bf_lo(a.z)); v1[1] *= bf_hi(b.z) * __builtin_amdgcn_rcpf(bf_hi(a.z)); v1[2] *= bf_lo(b.w) * __builtin_amdgcn_rcpf(bf_lo(a.w)); v1[3] *= bf_hi(b.w) * __builtin_amdgcn_rcpf(bf_hi(a.w)); }
                asm volatile("" ::: "memory"); }
    }
    __device__ __forceinline__ void operator()(const f32x4 (&acc)[2][2][4][2], const Unit& u, int wr, int wc, int fr, int fq) const {
        const int row0 = u.pm * BM + wr * 64 + fr, col0 = u.pn * BM + wc * 32 + 8 * fq;
#pragma unroll
        for (int ai = 0; ai < 2; ++ai)
#pragma unroll
            for (int m = 0; m < 4; ++m) { const size_t r = (size_t)(row0 + ai * HALF + m * 16);
#pragma unroll
                for (int bj = 0; bj < 2; ++bj) {
                    const u32x4 a = *(const u32x4*)(ga + r * ldg + col0 + bj * HALF);
                    const f32x4 v0 = acc[ai][bj][m][0], v1 = acc[ai][bj][m][1];
                    u32x4 w; w.x = cvt_pk_bf16(v0[0] * bf_lo(a.x), v0[1] * bf_hi(a.x)); w.y = cvt_pk_bf16(v0[2] * bf_lo(a.y), v0[3] * bf_hi(a.y));
                    w.z = cvt_pk_bf16(v1[0] * bf_lo(a.z), v1[1] * bf_hi(a.z)); w.w = cvt_pk_bf16(v1[2] * bf_lo(a.w), v1[3] * bf_hi(a.w));
                    *(u32x4*)(O + r * 2048 + col0 + bj * HALF) = w; } }
    }
};
struct EpiY1 {
    static constexpr bool PERM = false, AFTER_DRAIN = false; static constexpr int MID_T = 0;
    float* Y; const float* X; const float* stats; const float* g0; const float* b0; const float* bo; float alpha;
    __device__ __forceinline__ void operator()(const f32x4 (&acc)[2][2][4][2], const Unit& u, int wr, int wc, int fr, int fq) const {
        const int row0 = u.pm * BM + wr * 64 + fr, col0 = u.pn * BM + wc * 32 + 4 * fq;
        f32x4 ag[2][2], cb[2][2];
#pragma unroll
        for (int bj = 0; bj < 2; ++bj)
#pragma unroll
            for (int n = 0; n < 2; ++n) { const int c = col0 + bj * HALF + n * 16; ag[bj][n] = *(const f32x4*)(g0 + c) * alpha; cb[bj][n] = *(const f32x4*)(b0 + c) * alpha + *(const f32x4*)(bo + c); }
#pragma unroll
        for (int ai = 0; ai < 2; ++ai)
#pragma unroll
            for (int m = 0; m < 4; ++m) { const size_t r = (size_t)(row0 + ai * HALF + m * 16); const float mu = stats[2 * r], rs = stats[2 * r + 1];
#pragma unroll
                for (int bj = 0; bj < 2; ++bj)
#pragma unroll
                    for (int n = 0; n < 2; ++n) { const size_t o = r * 2048 + col0 + bj * HALF + n * 16; const f32x4 xv = *(const f32x4*)(X + o);
                        *(f32x4*)(Y + o) = (xv - mu) * rs * ag[bj][n] + cb[bj][n] + acc[ai][bj][m][n]; }
                asm volatile("" ::: "memory"); }
    }
};
struct EpiSwiGLU {
    static constexpr bool PERM = true, AFTER_DRAIN = false; static constexpr int MID_T = 0;
    bf16_t* H;
    __device__ __forceinline__ void operator()(const f32x4 (&acc)[2][2][4][2], const Unit& u, int wr, int wc, int fr, int fq) const {
        const int row0 = u.pm * BM + wr * 64 + fr, col0 = (u.pn & 3) * 128 + wc * 32 + 8 * fq;
#pragma unroll
        for (int ai = 0; ai < 2; ++ai)
#pragma unroll
            for (int m = 0; m < 4; ++m) { f32x4 v0, v1;
#pragma unroll
                for (int j = 0; j < 4; ++j) { const float a = acc[ai][0][m][0][j], b = acc[ai][0][m][1][j]; v0[j] = a * sigm(a) * acc[ai][1][m][0][j]; v1[j] = b * sigm(b) * acc[ai][1][m][1][j]; }
                u32x4 w; w.x = cvt_pk_bf16(v0[0], v0[1]); w.y = cvt_pk_bf16(v0[2], v0[3]); w.z = cvt_pk_bf16(v1[0], v1[1]); w.w = cvt_pk_bf16(v1[2], v1[3]);
                *(u32x4*)(H + (size_t)(row0 + ai * HALF + m * 16) * 512 + col0) = w; }
    }
};
struct EpiYs {
    static constexpr bool PERM = true, AFTER_DRAIN = false; static constexpr int MID_T = 0;
    bf16_t* O; int ldc; int pn_mask;
    __device__ __forceinline__ void operator()(const f32x4 (&acc)[2][2][4][2], const Unit& u, int wr, int wc, int fr, int fq) const {
        const int row0 = u.pm * BM + wr * 64 + fr, col0 = (u.pn & pn_mask) * BM + wc * 32 + 8 * fq;
#pragma unroll
        for (int ai = 0; ai < 2; ++ai)
#pragma unroll
            for (int m = 0; m < 4; ++m) { bf16_t* rowp = O + (size_t)(row0 + ai * HALF + m * 16) * ldc + col0;
#pragma unroll
                for (int bj = 0; bj < 2; ++bj) { const f32x4 v0 = acc[ai][bj][m][0], v1 = acc[ai][bj][m][1];
                    u32x4 w; w.x = cvt_pk_bf16(v0[0], v0[1]); w.y = cvt_pk_bf16(v0[2], v0[3]); w.z = cvt_pk_bf16(v1[0], v1[1]); w.w = cvt_pk_bf16(v1[2], v1[3]);
                    *(u32x4*)(rowp + bj * HALF) = w; } }
    }
};
struct MoeOrder {
    const int* tile_e; int ntiles, nper, G, c;
    __device__ __forceinline__ bool next(int i, Unit& u) const {
        const long L = (long)i * G + c; if (L >= (long)ntiles * nper) return false;
        const int j = (int)(L / nper), t = (int)(L % nper); u.pm = j; u.pn = tile_e[j] * nper + t; return true;
    }
    __device__ __forceinline__ void a_ready(const Unit&) const {}
    __device__ __forceinline__ void done(const Unit&) const {}
};
template <class Epi, class Sched, bool ALIGN_EPI = false, bool SP2 = false>
__device__ __forceinline__ void gemm_phase(PG8_LAS unsigned char* lds, const Gemm g, const Sched& S, const Epi& E) {
    const int tid = threadIdx.x, wid = __builtin_amdgcn_readfirstlane(tid >> 6), lane = tid & 63, wr = wid >> 2, wc = wid & 3, fr = lane & 15, fq = lane >> 4;
    const int K = g.K, nt = K / BK;
    unsigned voffA[2], voffB[2];
#pragma unroll
    for (int i = 0; i < 2; ++i) { int R, C; stage_rc(tid * 16 + i * 8192, R, C); const int Rb = Epi::PERM ? ((R & ~31) + perm32(R & 31)) : R;
        voffA[i] = (unsigned)(R * K + C) * 2u; voffB[i] = (unsigned)(Rb * K + C) * 2u; }
    const size_t kstep = (size_t)(BK * 2);
    const size_t hstep = (size_t)HALF * K * 2;
    const size_t tstep = 2 * hstep;
    const unsigned ldsw = (unsigned)wid * 1024u;
    const int aoff = lds_byte(wr * 64 + fr, fq * 8), boff = lds_byte(wc * 32 + fr, fq * 8);
#define PG8_SA(b, h) (((b) * 2 + (h)) * HTB)
#define PG8_SB(b, h) ((4 + (b) * 2 + (h)) * HTB)
#define PG8_STAGE(bufoff, gbase, voff) do { _Pragma("unroll") for (int _i = 0; _i < 2; ++_i) \
        __builtin_amdgcn_global_load_lds((const unsigned*)((const char*)(gbase) + (voff)[_i]), (PG8_LAS unsigned*)(lds + (bufoff) + ldsw + _i * 8192), 16, 0, 0); } while (0)
#define PG8_LDA(dst, b, h) do { _Pragma("unroll") for (int m = 0; m < 4; ++m) _Pragma("unroll") for (int k = 0; k < 2; ++k) dst[m][k] = *(const PG8_LAS bf16x8*)(lds + PG8_SA(b, h) + aoff + m * 2048 + k * 1024); } while (0)
#define PG8_LDB(dst, b, h) do { _Pragma("unroll") for (int n = 0; n < 2; ++n) _Pragma("unroll") for (int k = 0; k < 2; ++k) dst[n][k] = *(const PG8_LAS bf16x8*)(lds + PG8_SB(b, h) + boff + n * 2048 + k * 1024); } while (0)
#define PG8_MMA(ai, bj, At, Bt) do { __builtin_amdgcn_s_setprio(1); _Pragma("unroll") for (int m = 0; m < 4; ++m) _Pragma("unroll") for (int n = 0; n < 2; ++n) _Pragma("unroll") for (int k = 0; k < 2; ++k) \
        acc[ai][bj][m][n] = __builtin_amdgcn_mfma_f32_16x16x32_bf16(Bt[n][k], At[m][k], acc[ai][bj][m][n], 0, 0, 0); __builtin_amdgcn_s_setprio(0); } while (0)
#define PG8_WAIT_V(n) asm volatile("s_waitcnt vmcnt(" #n ")" ::: "memory")
#define PG8_WAIT_L(n) asm volatile("s_waitcnt lgkmcnt(" #n ")" ::: "memory")
#define PG8_BAR __builtin_amdgcn_s_barrier()
#define PG8_SCHED __builtin_amdgcn_sched_barrier(0)
    Unit cur, nxt; int ui = 0;
    if (!S.next(0, cur)) return;
    f32x4 acc[2][2][4][2];
#pragma unroll
    for (int a = 0; a < 2; ++a)
#pragma unroll
        for (int b = 0; b < 2; ++b)
#pragma unroll
            for (int m = 0; m < 4; ++m)
#pragma unroll
                for (int n = 0; n < 2; ++n) acc[a][b][m][n] = (f32x4){0.f, 0.f, 0.f, 0.f};
    bf16x8 At[4][2], B0[2][2], B1[2][2];
    const char* cA = (const char*)g.A + (size_t)cur.pm * tstep; const char* cB = (const char*)g.Bt + (size_t)cur.pn * tstep;
    S.a_ready(cur);
    if constexpr (SP2) {
        PG8_STAGE(PG8_SB(0, 0), cB, voffB); PG8_STAGE(PG8_SB(0, 1), cB + hstep, voffB); PG8_STAGE(PG8_SA(0, 0), cA, voffA); PG8_STAGE(PG8_SA(0, 1), cA + hstep, voffA);
        if (wr == 1) PG8_BAR;
        PG8_WAIT_V(2); PG8_BAR;
        PG8_STAGE(PG8_SB(1, 0), cB + kstep, voffB); PG8_STAGE(PG8_SA(1, 0), cA + kstep, voffA); PG8_STAGE(PG8_SB(1, 1), cB + hstep + kstep, voffB);
        PG8_WAIT_V(6); PG8_BAR;
    } else {
        PG8_STAGE(PG8_SB(0, 0), cB, voffB); PG8_STAGE(PG8_SA(0, 0), cA, voffA); PG8_STAGE(PG8_SB(0, 1), cB + hstep, voffB); PG8_STAGE(PG8_SA(0, 1), cA + hstep, voffA);
        if (wr == 1) PG8_BAR;
        PG8_WAIT_V(4); PG8_BAR;
        PG8_STAGE(PG8_SB(1, 0), cB + kstep, voffB); PG8_STAGE(PG8_SA(1, 0), cA + kstep, voffA); PG8_STAGE(PG8_SB(1, 1), cB + hstep + kstep, voffB);
        PG8_WAIT_V(6); PG8_BAR;
    }
    for (;;) {
        const bool has_next = S.next(ui + 1, nxt);
        const char* nA = has_next ? (const char*)g.A + (size_t)nxt.pm * tstep : cA; const char* nB = has_next ? (const char*)g.Bt + (size_t)nxt.pn * tstep : cB;
        for (int t = 0; t < nt; t += 2) {
            const bool last = (t == nt - 2);
            const char* a1 = cA + (size_t)(t + 1) * kstep;
            const char* a2 = last ? nA : cA + (size_t)(t + 2) * kstep; const char* b2 = last ? nB : cB + (size_t)(t + 2) * kstep;
            const char* a3 = a2 + kstep; const char* b3 = b2 + kstep;
            if (last && has_next) S.a_ready(nxt);
            if constexpr (Epi::MID_T > 0) { if (t == Epi::MID_T) E.mid(acc, cur, wr, wc, fr, fq); }
            if constexpr (SP2) {
            PG8_LDB(B0, 0, 0); PG8_LDB(B1, 0, 1); PG8_SCHED; PG8_LDA(At, 0, 0); PG8_STAGE(PG8_SA(1, 1), a1 + hstep, voffA);
            PG8_WAIT_V(8); PG8_WAIT_L(0); PG8_BAR; PG8_MMA(0, 0, At, B0); PG8_MMA(0, 1, At, B1); PG8_BAR; PG8_SCHED;
            PG8_LDA(At, 0, 1); PG8_STAGE(PG8_SB(0, 0), b2, voffB); PG8_STAGE(PG8_SB(0, 1), b2 + hstep, voffB); PG8_STAGE(PG8_SA(0, 0), a2, voffA);
            PG8_WAIT_V(8); PG8_WAIT_L(0); PG8_BAR; PG8_MMA(1, 0, At, B0); PG8_MMA(1, 1, At, B1); PG8_BAR; PG8_SCHED;
            PG8_LDB(B0, 1, 0); PG8_LDB(B1, 1, 1); PG8_SCHED; PG8_LDA(At, 1, 0); PG8_STAGE(PG8_SA(0, 1), a2 + hstep, voffA);
            PG8_WAIT_V(8); PG8_WAIT_L(0); PG8_BAR; PG8_MMA(0, 0, At, B0); PG8_MMA(0, 1, At, B1); PG8_BAR; PG8_SCHED;
            PG8_LDA(At, 1, 1); PG8_STAGE(PG8_SB(1, 0), b3, voffB); PG8_STAGE(PG8_SB(1, 1), b3 + hstep, voffB); PG8_STAGE(PG8_SA(1, 0), a3, voffA);
            PG8_WAIT_V(8); PG8_WAIT_L(0); PG8_BAR; PG8_MMA(1, 0, At, B0); PG8_MMA(1, 1, At, B1); PG8_BAR; PG8_SCHED;
            } else {
            PG8_LDB(B0, 0, 0); PG8_SCHED; PG8_LDA(At, 0, 0); PG8_STAGE(PG8_SA(1, 1), a1 + hstep, voffA);
            PG8_WAIT_L(8); PG8_BAR; PG8_WAIT_L(0); PG8_MMA(0, 0, At, B0); PG8_BAR; PG8_SCHED;
            PG8_LDB(B1, 0, 1); PG8_STAGE(PG8_SB(0, 0), b2, voffB);
            PG8_BAR; PG8_WAIT_L(0); PG8_MMA(0, 1, At, B1); PG8_BAR;
            PG8_LDA(At, 0, 1); PG8_STAGE(PG8_SA(0, 0), a2, voffA);
            PG8_BAR; PG8_WAIT_L(0); PG8_MMA(1, 0, At, B0); PG8_BAR; PG8_SCHED;
            PG8_STAGE(PG8_SB(0, 1), b2 + hstep, voffB);
            PG8_WAIT_V(6); PG8_BAR; PG8_MMA(1, 1, At, B1); PG8_BAR;
            PG8_LDB(B0, 1, 0); PG8_SCHED; PG8_LDA(At, 1, 0); PG8_STAGE(PG8_SA(0, 1), a2 + hstep, voffA);
            PG8_WAIT_L(8); PG8_BAR; PG8_WAIT_L(0); PG8_MMA(0, 0, At, B0); PG8_BAR; PG8_SCHED;
            PG8_LDB(B1, 1, 1); PG8_STAGE(PG8_SB(1, 0), b3, voffB);
            PG8_BAR; PG8_WAIT_L(0); PG8_MMA(0, 1, At, B1); PG8_BAR;
            PG8_LDA(At, 1, 1); PG8_STAGE(PG8_SA(1, 0), a3, voffA);
            PG8_BAR; PG8_WAIT_L(0); PG8_MMA(1, 0, At, B0); PG8_BAR; PG8_SCHED;
            PG8_STAGE(PG8_SB(1, 1), b3 + hstep, voffB);
            PG8_WAIT_V(6); PG8_BAR; PG8_MMA(1, 1, At, B1); PG8_BAR;
            }
        }
        if constexpr (ALIGN_EPI) { if (wr == 0) PG8_BAR; }
        if constexpr (!Epi::AFTER_DRAIN) { E(acc, cur, wr, wc, fr, fq); S.done(cur); }
        if (!has_next) break;
#pragma unroll
        for (int a = 0; a < 2; ++a)
#pragma unroll
            for (int b = 0; b < 2; ++b)
#pragma unroll
                for (int m = 0; m < 4; ++m)
#pragma unroll
                    for (int n = 0; n < 2; ++n) acc[a][b][m][n] = (f32x4){0.f, 0.f, 0.f, 0.f};
        cur = nxt; cA = nA; cB = nB; ++ui;
        if constexpr (ALIGN_EPI) { if (wr == 1) PG8_BAR; }
    }
    PG8_WAIT_V(0);
    if constexpr (!ALIGN_EPI) { if (wr == 0) PG8_BAR; }
    PG8_BAR;
    if constexpr (Epi::AFTER_DRAIN) { E.fused(acc, cur, wr, wc, fr, fq, lds, wid, lane); S.done(cur); }
#undef PG8_SA
#undef PG8_SB
#undef PG8_STAGE
#undef PG8_LDA
#undef PG8_LDB
#undef PG8_MMA
#undef PG8_WAIT_V
#undef PG8_WAIT_L
#undef PG8_BAR
#undef PG8_SCHED
}
}

#ifndef MK_N_LAUNCHES
#define MK_N_LAUNCHES 1
#endif
namespace cg = cooperative_groups;
#define GAS __attribute__((address_space(1)))
#define LAS __attribute__((address_space(3)))
typedef unsigned short bf16;
typedef unsigned u32x4 __attribute__((ext_vector_type(4)));
typedef unsigned u32x2 __attribute__((ext_vector_type(2)));
typedef float f32x4 __attribute__((ext_vector_type(4)));
typedef float f32x2 __attribute__((ext_vector_type(2)));
typedef short bf16x8 __attribute__((ext_vector_type(8)));
typedef short s16x4 __attribute__((ext_vector_type(4)));
typedef __bf16 bf16v2 __attribute__((ext_vector_type(2)));

constexpr int NWAVES = 8, NTHREADS = 512;
constexpr int BATCH = 2, SEQ = 8192, DM = 2048, MTOK = BATCH * SEQ;
constexpr int DIN = 11776, OFF_QA = 0, OFF_KA = 1024, OFF_VA = 2048, OFF_QB = 3072, OFF_KB = 4608, OFF_VB = 6144, OFF_GA = 7680, OFF_GB = 9728;
constexpr int GRID_W = 64, GRID_ROWS = SEQ / GRID_W, NA_HEADS = 8, DIL_HEADS = 12;
constexpr int NEXP = 64, DEXP = 512, PMAX = 49152, MAXTILES = PMAX / 256;
constexpr float LN_EPS = 1e-5f, DN_ALPHA = 1.189207115002721f, ATT_SCALE = 0.08838834764831845f;
constexpr int NRW = 80;
#ifndef MOE_HELPER_ITEMS
#define MOE_HELPER_ITEMS 3584
#endif
constexpr size_t MiB = 1u << 20, KiB = 1u << 10;
constexpr size_t WS_CTL = 0, WS_BAR = 16384, CTL_ZERO_BYTES = 65536;
constexpr size_t WS_STATS0 = 1 * MiB, WS_STATS1 = 1 * MiB + 128 * KiB, WS_TOKE = 1 * MiB + 256 * KiB, WS_TOKW = 1 * MiB + 384 * KiB, WS_TOKP = 1 * MiB + 512 * KiB, WS_TOKS = 1 * MiB + 640 * KiB, WS_TILE = 1 * MiB + 768 * KiB;
constexpr size_t WS_LSE = 2 * MiB;
constexpr size_t WS_WRH = 3 * MiB, WS_WRL = 3 * MiB + 512 * KiB;
constexpr size_t WS_WIN = 4 * MiB, WS_WAB = 50 * MiB, WS_WO = 56 * MiB;
constexpr size_t WS_ACT = 64 * MiB;
constexpr size_t WS_ATT = 128 * MiB, WS_DILG = 176 * MiB;
constexpr int ATT_LD = 1536;
constexpr size_t WS_Z = 224 * MiB;
constexpr size_t WS_WUP = 592 * MiB, WS_WDN = 848 * MiB, WS_END = 976 * MiB;
constexpr size_t WS_XS = 224 * MiB, WS_HID = 416 * MiB, WS_YS = 224 * MiB, WS_LO = 464 * MiB;
static_assert(WS_WIN + (size_t)DIN * DM * 2 <= WS_WAB && WS_ATT + (size_t)MTOK * ATT_LD * 2 <= WS_DILG && WS_DILG + (size_t)3 * MTOK * 512 * 2 <= WS_Z && WS_Z + (size_t)MTOK * DIN * 2 <= WS_WUP && WS_XS + (size_t)PMAX * DM * 2 <= WS_HID && WS_HID + (size_t)PMAX * DEXP * 2 <= WS_LO && WS_LO + (size_t)MTOK * DM * 2 <= WS_WUP, "ws map");
constexpr int RING_BYTES = 131072, RPB_OFF = 147456, XB_LDS_OFF = 147456 + 15360, LDS_BYTES = 163840;
#ifndef CG_SEAM_MASK
#define CG_SEAM_MASK 1
#endif

__device__ __forceinline__ unsigned pk2(float lo, float hi) { f32x2 v = {lo, hi}; bf16v2 b = __builtin_convertvector(v, bf16v2); return __builtin_bit_cast(unsigned, b); }
__device__ __forceinline__ float bfl(unsigned w) { return __uint_as_float(w << 16); }
__device__ __forceinline__ float bfh(unsigned w) { return __uint_as_float(w & 0xffff0000u); }
__device__ __forceinline__ float wave_sum(float v) {
#pragma unroll
    for (int o = 1; o < 64; o <<= 1) v += __shfl_xor(v, o);
    return v;
}
#define LDS_WAIT() asm volatile("s_waitcnt lgkmcnt(0)" ::: "memory")
#define VM_WAIT() asm volatile("s_waitcnt vmcnt(0)" ::: "memory")

struct Args { const float* in[21]; float* out; unsigned char* ws; int ph_lo, ph_hi; };
enum { IN_X = 0, IN_LN0G, IN_LN0B, IN_WIN, IN_BIN, IN_RPB, IN_WPA, IN_WPB, IN_WO, IN_BO, IN_LN1G, IN_LN1B, IN_WRG, IN_BRG, IN_WRE, IN_BRE, IN_WG, IN_WU, IN_WD, IN_LN2G, IN_LN2B };

__device__ __forceinline__ unsigned xv_(unsigned row) { return ((row & 3u) << 2) | ((row >> 2) & 3u); }
__device__ __forceinline__ void p0_transpose_item(const float* W, int N, int K, bf16* WT, long dst_row0, int k0, int n0, LAS float* scr, int lane, int kdst = 0) {
#pragma unroll 8
    for (int i = 0; i < 32; ++i) { const int kk = 2 * i + (lane >> 5); scr[kk * 33 + (lane & 31)] = W[(size_t)(k0 + kk) * N + n0 + (lane & 31)]; }
    LDS_WAIT();
    const int c = lane & 7;
#pragma unroll
    for (int j = 0; j < 4; ++j) { const int n = (lane >> 3) + 8 * j; const LAS float* s = scr + (8 * c) * 33 + n;
        u32x4 o; o.x = pk2(s[0 * 33], s[1 * 33]); o.y = pk2(s[2 * 33], s[3 * 33]); o.z = pk2(s[4 * 33], s[5 * 33]); o.w = pk2(s[6 * 33], s[7 * 33]);
        *(u32x4*)(WT + (size_t)(dst_row0 + n) * K + kdst + k0 + 8 * c) = o; }
    LDS_WAIT();
}
__device__ __forceinline__ void p0_prologue(const Args& a, LAS unsigned char* lds, int gw, int NGW, int wave, int lane) {
    LAS float* scr = (LAS float*)(lds + wave * 16384);
    unsigned char* ws = a.ws;
    constexpr int I0 = 32 * 368, I1 = 16 * 64, I2 = 8 * 64, I3 = 32 * 64, I4 = NEXP * 32 * 16, I5 = I4, I6 = NEXP * 8 * 64;
    constexpr int NITEMS = I0 + I1 + I2 + I3 + I4 + I5 + I6;
    for (int it = gw; it < NITEMS; it += NGW) {
        int r = it;
        if (r < I0) { const int kb = r / 368, nb = r % 368; p0_transpose_item(a.in[IN_WIN], DIN, DM, (bf16*)(ws + WS_WIN), 32 * nb, 64 * kb, 32 * nb, scr, lane); continue; } r -= I0;
        if (r < I1) { const int kb = r / 64, nb = r % 64; p0_transpose_item(a.in[IN_WPA], DM, ATT_LD, (bf16*)(ws + WS_WAB), 32 * nb, 64 * kb, 32 * nb, scr, lane, 512); continue; } r -= I1;
        if (r < I2) { const int kb = r / 64, nb = r % 64; p0_transpose_item(a.in[IN_WPB], DM, ATT_LD, (bf16*)(ws + WS_WAB), 32 * nb, 64 * kb, 32 * nb, scr, lane, 0); continue; } r -= I2;
        if (r < I3) { const int kb = r / 64, nb = r % 64; p0_transpose_item(a.in[IN_WO], DM, DM, (bf16*)(ws + WS_WO), 32 * nb, 64 * kb, 32 * nb, scr, lane); continue; } r -= I3;
        if (r < I4 + I5) { const int mat = r >= I4; if (mat) r -= I4; const int e = r / 512, q = r % 512, kb = q / 16, nb = q % 16, n0 = 32 * nb;
            const float* W = (mat ? a.in[IN_WU] : a.in[IN_WG]) + (size_t)e * DM * DEXP;
            p0_transpose_item(W, DEXP, DM, (bf16*)(ws + WS_WUP), (long)e * 1024 + (n0 >> 7) * 256 + mat * 128 + (n0 & 127), 64 * kb, n0, scr, lane); continue; } r -= I4 + I5;
        { const int e = r / 512, q = r % 512, kb = q / 64, nb = q % 64;
            p0_transpose_item(a.in[IN_WD] + (size_t)e * DEXP * DM, DM, DEXP, (bf16*)(ws + WS_WDN), (long)e * 2048 + 32 * nb, 64 * kb, 32 * nb, scr, lane); }
    }
    { bf16* wh = (bf16*)(ws + WS_WRH); bf16* wl = (bf16*)(ws + WS_WRL);
      for (int i = gw * 64 + lane; i < NRW * DM; i += NGW * 64) { const int n = i / DM, k = i % DM;
          const float v = n < 8 ? a.in[IN_WRG][(size_t)k * 8 + n] : (n < 72 ? a.in[IN_WRE][(size_t)k * 64 + (n - 8)] : 0.f);
          const unsigned h = pk2(v, 0.f) & 0xffffu; const float r = v - __uint_as_float(h << 16);
          wh[i] = (bf16)h; wl[i] = (bf16)(pk2(r, 0.f) & 0xffffu); } }
    { const float* g = a.in[IN_LN0G]; const float* bb = a.in[IN_LN0B]; float* st = (float*)(ws + WS_STATS0); bf16* H = (bf16*)(ws + WS_ACT);
      f32x4 gv[8], bv[8];
#pragma unroll
      for (int j = 0; j < 8; ++j) { gv[j] = *(const f32x4*)(g + 256 * j + 4 * lane); bv[j] = *(const f32x4*)(bb + 256 * j + 4 * lane); }
      for (int m = gw; m < MTOK; m += NGW) {
          const float* xr = a.in[IN_X] + (size_t)m * DM + 4 * lane; f32x4 v[8]; float s = 0.f;
#pragma unroll
          for (int j = 0; j < 8; ++j) { v[j] = *(const f32x4*)(xr + 256 * j); s += (v[j].x + v[j].y) + (v[j].z + v[j].w); }
          const float mean = wave_sum(s) * (1.f / DM); float s2 = 0.f;
#pragma unroll
          for (int j = 0; j < 8; ++j) { v[j] = v[j] - mean; s2 += (v[j].x * v[j].x + v[j].y * v[j].y) + (v[j].z * v[j].z + v[j].w * v[j].w); }
          const float rstd = 1.0f / sqrtf(wave_sum(s2) * (1.f / DM) + LN_EPS);
          if (lane == 0) { st[2 * m] = mean; st[2 * m + 1] = rstd; }
          bf16* orow = H + (size_t)m * DM + 4 * lane;
#pragma unroll
          for (int j = 0; j < 8; ++j) { const f32x4 y = v[j] * rstd * gv[j] + bv[j]; u32x2 w; w.x = pk2(y.x, y.y); w.y = pk2(y.z, y.w); *(u32x2*)(orow + 256 * j) = w; }
      } }
}
#define XB_TMO      128
#define XB_XCNT(j)  (256  + 64 * (j))
#define XB_XSUB(j)  (1280 + 64 * (j))
#define XB_XGEN(j)  (2304 + 64 * (j))
#define XB_TOP      3328
#define XB_TOPGEN   3392
#define XCD_BAR_WORDS 3456
#define XB_SPIN_CAP (1u << 18)

__device__ __forceinline__ unsigned xb_ld(unsigned* p)              { return __hip_atomic_load(p, __ATOMIC_RELAXED, __HIP_MEMORY_SCOPE_AGENT); }
__device__ __forceinline__ unsigned xb_add(unsigned* p, unsigned v) { return __hip_atomic_fetch_add(p, v, __ATOMIC_RELAXED, __HIP_MEMORY_SCOPE_AGENT); }
__device__ __forceinline__ unsigned xb_xcc_id() { return (unsigned)__builtin_amdgcn_s_getreg((3 << 11) | 20) & 0xFu; }
#define XB_SPIN(cond, bar) do { unsigned _sp = 0; while (cond) { __builtin_amdgcn_s_sleep(1); \
    if ((++_sp & 255u) == 0u) { if (xb_ld(&(bar)[XB_TMO])) break; if (_sp > XB_SPIN_CAP) { atomicAdd(&(bar)[XB_TMO], 1u); break; } } } } while (0)

struct XcdBarrier {
    unsigned* bar; unsigned x;
    volatile LAS unsigned* st;
};

__device__ __forceinline__ XcdBarrier xcd_barrier_post(unsigned* bar, volatile LAS unsigned* st) {
    XcdBarrier b; b.bar = bar; b.x = xb_xcc_id(); b.st = st;
    if (threadIdx.x == 0) (void)xb_add(&bar[XB_XCNT(b.x)], 1u);
    return b;
}
__device__ __forceinline__ void xcd_barrier_complete(unsigned* bar, unsigned x, unsigned& nloc, unsigned& nx) {
    const unsigned G = gridDim.x * gridDim.y * gridDim.z;
    unsigned sum, cnt, mine, sp = 0u;
    for (;;) {
        sum = 0u; cnt = 0u; mine = 0u;
#pragma unroll
        for (unsigned j = 0; j < 16; ++j) { const unsigned c = xb_ld(&bar[XB_XCNT(j)]); sum += c; cnt += (c > 0u) ? 1u : 0u; mine = (j == x) ? c : mine; }
        if (sum == G) break;
        __builtin_amdgcn_s_sleep(1);
        if ((++sp & 255u) == 0u) { if (xb_ld(&bar[XB_TMO])) break; if (sp > XB_SPIN_CAP) { atomicAdd(&bar[XB_TMO], 1u); break; } }
    }
    nloc = mine > 0u ? mine : 1u; nx = cnt > 0u ? cnt : 1u;
}

__device__ __forceinline__ void xcd_barrier(const XcdBarrier& b) {
    asm volatile("s_waitcnt vmcnt(0)" ::: "memory");
    __syncthreads();
    if (threadIdx.x == 0) {
        unsigned* bar = b.bar;
        __builtin_amdgcn_s_waitcnt(0);
        unsigned nloc = b.st[0], nx = b.st[1];
        if (nloc == 0u) { xcd_barrier_complete(bar, b.x, nloc, nx); b.st[0] = nloc; b.st[1] = nx; }
        const unsigned old = xb_add(&bar[XB_XSUB(b.x)], 1u);
        const unsigned gen = old / nloc;
        if (old + 1u == (gen + 1u) * nloc) {
            __builtin_amdgcn_fence(__ATOMIC_RELEASE, "agent");
            asm volatile("s_waitcnt vmcnt(0)" ::: "memory");
            const unsigned og = xb_add(&bar[XB_TOP], 1u);
            const unsigned tg = og / nx;
            if (og + 1u == (tg + 1u) * nx) xb_add(&bar[XB_TOPGEN], 1u);
            else XB_SPIN(xb_ld(&bar[XB_TOPGEN]) == tg, bar);
            __builtin_amdgcn_fence(__ATOMIC_ACQUIRE, "agent");
            xb_add(&bar[XB_XGEN(b.x)], 1u);
            asm volatile("s_waitcnt vmcnt(0)" ::: "memory");
        } else {
            XB_SPIN(xb_ld(&bar[XB_XGEN(b.x)]) == gen, bar);
            __builtin_amdgcn_fence(__ATOMIC_ACQUIRE, "agent");
            asm volatile("s_waitcnt vmcnt(0)" ::: "memory");
        }
    }
    __syncthreads();
}

__device__ __forceinline__ unsigned xk_(unsigned row) { return (row & 3u) | (((row >> 3) & 3u) << 2); }
constexpr int ATT_RING = 147456;
constexpr int DIL_V_OFF = 69632;

struct NaFix { int c, r, start, kc0; const LAS float* rpb;
    __device__ __forceinline__ float operator()(float s, int ks, int idx, int q) const {
        const int kcol = kc0 + idx, qcol = 16 * c + q; int qcs = qcol - 8; qcs = qcs < 0 ? 0 : (qcs > 48 ? 48 : qcs);
        int dc = kcol - qcol + 15; dc = dc < 0 ? 0 : (dc > 30 ? 30 : dc);
        const float bias = rpb[(start + ks - r + 7) * 31 + dc];
        return (kcol >= qcs && kcol < qcs + 16) ? s * ATT_SCALE + bias : -INFINITY; } };
struct DilFix { int pq0, L; float slope_d;
    __device__ __forceinline__ float operator()(float s, int ks, int idx, int q) const {
        const int rel = -64 + 32 * ks + idx - q, pk = pq0 - 64 + 32 * ks + idx; const int ar = rel < 0 ? -rel : rel;
        return (ar <= 64 && pk >= 0 && pk < L) ? s * ATT_SCALE - slope_d * (float)ar : -INFINITY; } };

template <int NKS, int KSTRIDE>
__device__ __forceinline__ void att_qk(const LAS unsigned char* kimg, int kbase, const bf16* qrow, int lane, f32x4 (&s)[NKS][2]) {
    const int q = lane & 15, g = lane >> 4;
    bf16x8 qf[4];
#pragma unroll
    for (int dk = 0; dk < 4; ++dk) qf[dk] = *(const bf16x8*)(qrow + 8 * g + 32 * dk);
    const unsigned row0 = (unsigned)(kbase + 8 * (q >> 2) + (q & 3));
    const unsigned b0 = 256u * row0 + 16u * ((unsigned)g ^ xk_(row0));
#pragma unroll
    for (int ks = 0; ks < NKS; ++ks)
#pragma unroll
        for (int blk = 0; blk < 2; ++blk) {
            const unsigned b = b0 + 256u * (unsigned)(ks * KSTRIDE + 4 * blk);
            f32x4 acc = {0.f, 0.f, 0.f, 0.f};
#pragma unroll
            for (int dk = 0; dk < 4; ++dk) { const bf16x8 kf = *(const LAS bf16x8*)(kimg + (b ^ (64u * dk))); acc = __builtin_amdgcn_mfma_f32_16x16x32_bf16(kf, qf[dk], acc, 0, 0, 0); }
            s[ks][blk] = acc;
        }
}
template <int NKS, class FIX>
__device__ __forceinline__ void att_softmax(const FIX& fix, int lane, f32x4 (&s)[NKS][2], u32x4 (&pw)[NKS], float& lse) {
    const int q = lane & 15, g = lane >> 4;
    float mx = -INFINITY;
#pragma unroll
    for (int ks = 0; ks < NKS; ++ks)
#pragma unroll
        for (int blk = 0; blk < 2; ++blk)
#pragma unroll
            for (int r = 0; r < 4; ++r) { const float v = fix(s[ks][blk][r], ks, 8 * g + 4 * blk + r, q); s[ks][blk][r] = v; mx = fmaxf(mx, v); }
    mx = fmaxf(mx, __shfl_xor(mx, 16)); mx = fmaxf(mx, __shfl_xor(mx, 32));
    float sum = 0.f;
#pragma unroll
    for (int ks = 0; ks < NKS; ++ks)
#pragma unroll
        for (int blk = 0; blk < 2; ++blk)
#pragma unroll
            for (int r = 0; r < 4; ++r) { const float p = __builtin_amdgcn_exp2f((s[ks][blk][r] - mx) * 1.4426950408889634f); s[ks][blk][r] = p; sum += p; }
    sum += __shfl_xor(sum, 16); sum += __shfl_xor(sum, 32);
    lse = mx + __logf(sum);
    const float inv = 1.0f / sum;
#pragma unroll
    for (int ks = 0; ks < NKS; ++ks) { pw[ks].x = pk2(s[ks][0][0] * inv, s[ks][0][1] * inv); pw[ks].y = pk2(s[ks][0][2] * inv, s[ks][0][3] * inv); pw[ks].z = pk2(s[ks][1][0] * inv, s[ks][1][1] * inv); pw[ks].w = pk2(s[ks][1][2] * inv, s[ks][1][3] * inv);
        asm volatile("" : "+v"(pw[ks].x), "+v"(pw[ks].y), "+v"(pw[ks].z), "+v"(pw[ks].w)); }
}
template <int NKS, int KSTRIDE>
__device__ __forceinline__ void att_pv(const LAS unsigned char* vimg, int vbase, int lane, const u32x4 (&pw)[NKS], f32x4 (&o)[8]) {
    const unsigned g = lane >> 4, qq = (lane & 15) >> 2, p = lane & 3;
    unsigned tra[2];
#pragma unroll
    for (int t = 0; t < 2; ++t) { const unsigned row = (unsigned)vbase + 8u * g + 4u * t + qq; tra[t] = 256u * row + 16u * (xv_(row) ^ (p >> 1)) + 8u * (p & 1); }
#pragma unroll
    for (int c = 0; c < 8; ++c) o[c] = (f32x4){0.f, 0.f, 0.f, 0.f};
#pragma unroll
    for (int ks = 0; ks < NKS; ++ks) {
        const bf16x8 pf = __builtin_bit_cast(bf16x8, pw[ks]);
#pragma unroll
        for (int c = 0; c < 8; ++c) {
            const s16x4 t0 = __builtin_amdgcn_ds_read_tr16_b64_v4i16((LAS s16x4*)(vimg + ((tra[0] + 256u * (unsigned)(ks * KSTRIDE)) ^ (32u * c))));
            const s16x4 t1 = __builtin_amdgcn_ds_read_tr16_b64_v4i16((LAS s16x4*)(vimg + ((tra[1] + 256u * (unsigned)(ks * KSTRIDE)) ^ (32u * c))));
            const bf16x8 vf = __builtin_shufflevector(t0, t1, 0, 1, 2, 3, 4, 5, 6, 7);
            o[c] = __builtin_amdgcn_mfma_f32_16x16x32_bf16(vf, pf, o[c], 0, 0, 0);
        }
    }
}
#define ATT_GLDS(src_, dst_) __builtin_amdgcn_global_load_lds((const unsigned*)(src_), (LAS unsigned*)(dst_), 16, 0, 0)
__device__ __forceinline__ void p2_attention(const Args& a, LAS unsigned char* lds, int wave, int lane) {
    unsigned char* ws = a.ws; const bf16* z = (const bf16*)(ws + WS_Z);
    LAS float* rpb = (LAS float*)(lds + RPB_OFF);
    for (int i = threadIdx.x; i < NA_HEADS * 465; i += NTHREADS) rpb[i] = a.in[IN_RPB][i];
    __syncthreads();
    const int G = gridDim.x, bx = blockIdx.x, vcu = (G % 8 == 0) ? (bx % 8) * (G / 8) + bx / 8 : bx;
    constexpr int N_NA = BATCH * NA_HEADS * (GRID_ROWS / 2), N_DIL = DIL_HEADS * BATCH * 64;
    for (int it = vcu; it < N_NA + N_DIL; it += G) {
        asm volatile("" : "+v"(lane));
        const int q = lane & 15, g = lane >> 4, vrow = lane >> 4, slot = lane & 15;
        f32x4 o[8]; float lse;
        if (it < N_NA) {
            const int rp = it & 63, h = (it >> 6) & 7, b = it >> 9, r0 = 2 * rp;
            int st0 = r0 - 4; st0 = st0 < 0 ? 0 : (st0 > GRID_ROWS - 8 ? GRID_ROWS - 8 : st0);
            const bf16* zb = z + (size_t)b * SEQ * DIN;
            const int c = wave & 3, r = r0 + (wave >> 2); int st = r - 4; st = st < 0 ? 0 : (st > GRID_ROWS - 8 ? GRID_ROWS - 8 : st);
            int kc = 16 * c - 8; kc = kc < 0 ? 0 : (kc > 32 ? 32 : kc);
            const int base = (st - st0) * 64 + kc;
#pragma unroll 2
            for (int pc = wave; pc < 144; pc += 8) { const unsigned row = 4u * pc + vrow; int kr = st0 + (int)(row >> 6); kr = kr > GRID_ROWS - 1 ? GRID_ROWS - 1 : kr;
                ATT_GLDS(zb + (size_t)(kr * GRID_W + (int)(row & 63)) * DIN + OFF_KA + h * 128 + 8 * (slot ^ xk_(row)), lds + pc * 1024); }
            const bf16* qrow = zb + (size_t)(r * GRID_W + 16 * c + q) * DIN + OFF_QA + h * 128;
            f32x4 s[8][2]; u32x4 pw[8];
            VM_WAIT(); __syncthreads();
            att_qk<8, 64>(lds, base, qrow, lane, s);
            __syncthreads();
#pragma unroll 2
            for (int pc = wave; pc < 144; pc += 8) { const unsigned row = 4u * pc + vrow; int kr = st0 + (int)(row >> 6); kr = kr > GRID_ROWS - 1 ? GRID_ROWS - 1 : kr;
                ATT_GLDS(zb + (size_t)(kr * GRID_W + (int)(row & 63)) * DIN + OFF_VA + h * 128 + 8 * (slot ^ xv_(row)), lds + pc * 1024); }
            NaFix fx; fx.c = c; fx.r = r; fx.start = st; fx.kc0 = kc; fx.rpb = rpb + h * 465;
            att_softmax<8>(fx, lane, s, pw, lse);
            VM_WAIT(); __syncthreads();
            att_pv<8, 64>(lds, base, lane, pw, o);
            bf16* orow = (bf16*)(ws + WS_ATT) + (size_t)(b * SEQ + r * GRID_W + 16 * c + q) * ATT_LD + 512 + h * 128 + 4 * g;
#pragma unroll
            for (int cc = 0; cc < 8; ++cc) { u32x2 w; w.x = pk2(o[cc][0], o[cc][1]); w.y = pk2(o[cc][2], o[cc][3]); *(u32x2*)(orow + 16 * cc) = w; }
            __syncthreads();
        } else {
            const int j = it - N_NA, blk = j & 63, b = (j >> 6) & 1, hd = j >> 7;
            const int grp = hd >> 2, hslot = hd & 3, d = grp == 0 ? 1 : (grp == 1 ? 4 : 16), L = SEQ / d, nb = L / 128, res = blk / nb, n = blk % nb;
            const bf16* zb = z + (size_t)b * SEQ * DIN;
            const int p0 = n * 128 - 64;
#pragma unroll 2
            for (int pc = wave; pc < 68; pc += 8) { const unsigned row = 4u * pc + vrow; int p = p0 + (int)row; p = p < 0 ? 0 : (p > L - 1 ? L - 1 : p);
                ATT_GLDS(zb + (size_t)(p * d + res) * DIN + OFF_KB + hd * 128 + 8 * (slot ^ xk_(row)), lds + pc * 1024); }
#pragma unroll 2
            for (int pc = wave; pc < 68; pc += 8) { const unsigned row = 4u * pc + vrow; int p = p0 + (int)row; p = p < 0 ? 0 : (p > L - 1 ? L - 1 : p);
                ATT_GLDS(zb + (size_t)(p * d + res) * DIN + OFF_VB + hd * 128 + 8 * (slot ^ xv_(row)), lds + DIL_V_OFF + pc * 1024); }
            const int pq0 = n * 128 + 16 * wave;
            const bf16* qrow = zb + (size_t)((pq0 + q) * d + res) * DIN + OFF_QB + hd * 128;
            f32x4 s[5][2]; u32x4 pw[5];
            VM_WAIT(); __syncthreads();
            att_qk<5, 32>(lds, 16 * wave, qrow, lane, s);
            DilFix fx; fx.pq0 = pq0; fx.L = L; fx.slope_d = exp2f(-8.0f * (float)(hd + 1) / 12.0f) * (float)d;
            att_softmax<5>(fx, lane, s, pw, lse);
            att_pv<5, 32>(lds + DIL_V_OFF, 16 * wave, lane, pw, o);
            const size_t row = (size_t)b * SEQ + (size_t)(pq0 + q) * d + res;
            bf16* orow = (bf16*)(ws + WS_DILG) + ((size_t)grp * MTOK + row) * 512 + hslot * 128 + 4 * g;
#pragma unroll
            for (int cc = 0; cc < 8; ++cc) { u32x2 w; w.x = pk2(o[cc][0], o[cc][1]); w.y = pk2(o[cc][2], o[cc][3]); *(u32x2*)(orow + 16 * cc) = w; }
            if (g == 0) ((float*)(ws + WS_LSE))[((size_t)grp * MTOK + row) * 4 + hslot] = lse;
            __syncthreads();
        }
    }
}
__device__ __forceinline__ void p3_combine(const Args& a, int gtid, int NT) {
    unsigned char* ws = a.ws; const float* lse = (const float*)(ws + WS_LSE); const bf16* og = (const bf16*)(ws + WS_DILG); bf16* out = (bf16*)(ws + WS_ATT);
    for (int i = gtid; i < MTOK * 64; i += NT) {
        const int row = i >> 6, ch = i & 63, slot = ch >> 4;
        const float l0 = lse[((size_t)0 * MTOK + row) * 4 + slot], l1 = lse[((size_t)1 * MTOK + row) * 4 + slot], l2 = lse[((size_t)2 * MTOK + row) * 4 + slot];
        const float mx = fmaxf(l0, fmaxf(l1, l2)); float w0 = __expf(l0 - mx), w1 = __expf(l1 - mx), w2 = __expf(l2 - mx); const float inv = 1.0f / (w0 + w1 + w2); w0 *= inv; w1 *= inv; w2 *= inv;
        const u32x4 a0 = *(const u32x4*)(og + ((size_t)0 * MTOK + row) * 512 + 8 * ch), a1 = *(const u32x4*)(og + ((size_t)1 * MTOK + row) * 512 + 8 * ch), a2 = *(const u32x4*)(og + ((size_t)2 * MTOK + row) * 512 + 8 * ch);
        u32x4 r;
        r.x = pk2(w0 * bfl(a0.x) + w1 * bfl(a1.x) + w2 * bfl(a2.x), w0 * bfh(a0.x) + w1 * bfh(a1.x) + w2 * bfh(a2.x));
        r.y = pk2(w0 * bfl(a0.y) + w1 * bfl(a1.y) + w2 * bfl(a2.y), w0 * bfh(a0.y) + w1 * bfh(a1.y) + w2 * bfh(a2.y));
        r.z = pk2(w0 * bfl(a0.z) + w1 * bfl(a1.z) + w2 * bfl(a2.z), w0 * bfh(a0.z) + w1 * bfh(a1.z) + w2 * bfh(a2.z));
        r.w = pk2(w0 * bfl(a0.w) + w1 * bfl(a1.w) + w2 * bfl(a2.w), w0 * bfh(a0.w) + w1 * bfh(a1.w) + w2 * bfh(a2.w));
        *(u32x4*)(out + (size_t)row * ATT_LD + 8 * ch) = r;
    }
}

__device__ __forceinline__ void p6_ln1_router(const Args& a, LAS unsigned char* lds, int wave, int lane) {
    unsigned char* ws = a.ws; const float* Y = a.out; bf16* HI = (bf16*)(ws + WS_ACT); bf16* LO = (bf16*)(ws + WS_LO); float* st = (float*)(ws + WS_STATS1);
    const bf16* WH = (const bf16*)(ws + WS_WRH); const bf16* WL = (const bf16*)(ws + WS_WRL);
    LAS float* P = (LAS float*)lds;
    const float* g1 = a.in[IN_LN1G]; const float* b1 = a.in[IN_LN1B];
    for (int rg = blockIdx.x; rg < MTOK / 64; rg += gridDim.x) {
#pragma unroll 1
        for (int i = 0; i < 8; ++i) {
            const int m = rg * 64 + wave * 8 + i;
            const float* yr = Y + (size_t)m * DM + 4 * lane; f32x4 v[8]; float s = 0.f;
#pragma unroll
            for (int j = 0; j < 8; ++j) { v[j] = *(const f32x4*)(yr + 256 * j); s += (v[j].x + v[j].y) + (v[j].z + v[j].w); }
            const float mean = wave_sum(s) * (1.f / DM); float s2 = 0.f;
#pragma unroll
            for (int j = 0; j < 8; ++j) { v[j] = v[j] - mean; s2 += (v[j].x * v[j].x + v[j].y * v[j].y) + (v[j].z * v[j].z + v[j].w * v[j].w); }
            const float rstd = 1.0f / sqrtf(wave_sum(s2) * (1.f / DM) + LN_EPS);
            if (lane == 0) { st[2 * m] = mean; st[2 * m + 1] = rstd; }
            bf16* hrow = HI + (size_t)m * DM + 4 * lane; bf16* lrow = LO + (size_t)m * DM + 4 * lane;
#pragma unroll
            for (int j = 0; j < 8; ++j) { const f32x4 gv = *(const f32x4*)(g1 + 256 * j + 4 * lane), bv = *(const f32x4*)(b1 + 256 * j + 4 * lane); const f32x4 y = v[j] * rstd * gv + bv;
                u32x2 h; h.x = pk2(y.x, y.y); h.y = pk2(y.z, y.w);
                u32x2 l; l.x = pk2(y.x - bfl(h.x), y.y - bfh(h.x)); l.y = pk2(y.z - bfl(h.y), y.w - bfh(h.y));
                *(u32x2*)(hrow + 256 * j) = h; *(u32x2*)(lrow + 256 * j) = l; }
        }
        VM_WAIT(); __syncthreads();
        {
            const int rb = wave & 3, kh = wave >> 2, fr = lane & 15, fq = lane >> 4;
            const size_t arow = (size_t)(rg * 64 + rb * 16 + fr) * DM + kh * 1024 + 8 * fq;
            f32x4 acc[5];
#pragma unroll
            for (int cb = 0; cb < 5; ++cb) acc[cb] = (f32x4){0.f, 0.f, 0.f, 0.f};
#pragma unroll 2
            for (int s = 0; s < 32; ++s) {
                const bf16x8 ah = *(const bf16x8*)(HI + arow + 32 * s), al = *(const bf16x8*)(LO + arow + 32 * s);
#pragma unroll
                for (int cb = 0; cb < 5; ++cb) { const size_t brow = (size_t)(16 * cb + fr) * DM + kh * 1024 + 8 * fq + 32 * s;
                    const bf16x8 bh = *(const bf16x8*)(WH + brow), bl = *(const bf16x8*)(WL + brow);
                    acc[cb] = __builtin_amdgcn_mfma_f32_16x16x32_bf16(ah, bh, acc[cb], 0, 0, 0);
                    acc[cb] = __builtin_amdgcn_mfma_f32_16x16x32_bf16(ah, bl, acc[cb], 0, 0, 0);
                    acc[cb] = __builtin_amdgcn_mfma_f32_16x16x32_bf16(al, bh, acc[cb], 0, 0, 0); }
            }
#pragma unroll
            for (int cb = 0; cb < 5; ++cb)
#pragma unroll
                for (int r = 0; r < 4; ++r) P[((kh * 4 + rb) * 16 + 4 * fq + r) * NRW + 16 * cb + fr] = acc[cb][r];
        }
        __syncthreads();
        if (threadIdx.x < 64) {
            const int t = threadIdx.x, m = rg * 64 + t; const LAS float* p0 = P + (size_t)t * NRW; const LAS float* p1 = P + (size_t)(64 + t) * NRW;
            float gl[8]; int gs = 0; float gm = -INFINITY;
#pragma unroll
            for (int n = 0; n < 8; ++n) { gl[n] = p0[n] + p1[n] + a.in[IN_BRG][n]; if (gl[n] > gm) { gm = gl[n]; gs = n; } }
            float gsum = 0.f;
#pragma unroll
            for (int n = 0; n < 8; ++n) gsum += __expf(gl[n] - gm);
            const float gprob = 1.0f / gsum;
            float v0 = -INFINITY, v1 = -INFINITY; int i0 = 0, i1 = 0;
#pragma unroll
            for (int n = 0; n < 8; ++n) { const float e = p0[8 + gs * 8 + n] + p1[8 + gs * 8 + n] + a.in[IN_BRE][gs * 8 + n];
                if (e > v0) { v1 = v0; i1 = i0; v0 = e; i0 = n; } else if (e > v1) { v1 = e; i1 = n; } }
            const float e1 = __expf(v1 - v0), w0 = gprob / (1.0f + e1), w1 = gprob * e1 / (1.0f + e1);
            const int x0 = gs * 8 + i0, x1 = gs * 8 + i1;
            unsigned* cnt = (unsigned*)(ws + WS_CTL);
            const unsigned q0 = atomicAdd(cnt + x0, 1u), q1 = atomicAdd(cnt + x1, 1u);
            int* te = (int*)(ws + WS_TOKE); float* tw = (float*)(ws + WS_TOKW); int* tp = (int*)(ws + WS_TOKP);
            te[2 * m] = x0; te[2 * m + 1] = x1; tw[2 * m] = w0; tw[2 * m + 1] = w1; tp[2 * m] = (int)q0; tp[2 * m + 1] = (int)q1;
        }
        __syncthreads();
    }
}
__device__ __forceinline__ void p7_permute(const Args& a, LAS unsigned char* lds, int gw, int NGW, int lane) {
    unsigned char* ws = a.ws; const unsigned* cnt = (const unsigned*)(ws + WS_CTL);
    LAS int* pstart = (LAS int*)lds; LAS int* pcnt = pstart + 64; LAS int* rcnt = pstart + 128;
    int* tile = (int*)(ws + WS_TILE);
    if (threadIdx.x == 0) {
        int pos = 0, nt = 0;
        for (int e = 0; e < NEXP; ++e) { const int c = (int)cnt[e], pc = (c + 255) & ~255; pstart[e] = pos; rcnt[e] = c; pcnt[e] = pc;
            if (blockIdx.x == 0) for (int j = 0; j < pc / 256; ++j) tile[1 + nt + j] = e;
            nt += pc / 256; pos += pc; }
        if (blockIdx.x == 0) tile[0] = nt;
    }
    __syncthreads();
    const bf16* H = (const bf16*)(ws + WS_ACT); bf16* XS = (bf16*)(ws + WS_XS);
    const int* te = (const int*)(ws + WS_TOKE); const int* tp = (const int*)(ws + WS_TOKP); int* ts = (int*)(ws + WS_TOKS);
    for (int m = gw; m < MTOK; m += NGW) {
        const u32x4* src = (const u32x4*)(H + (size_t)m * DM) + lane; u32x4 v[4];
#pragma unroll
        for (int j = 0; j < 4; ++j) v[j] = src[64 * j];
#pragma unroll
        for (int k = 0; k < 2; ++k) { const int slot = pstart[te[2 * m + k]] + tp[2 * m + k]; if (lane == 0) ts[2 * m + k] = slot;
            u32x4* dst = (u32x4*)(XS + (size_t)slot * DM) + lane;
#pragma unroll
            for (int j = 0; j < 4; ++j) dst[64 * j] = v[j]; }
    }
    { const int e = gw & 63; const int base = pstart[e] + rcnt[e], npad = pcnt[e] - rcnt[e];
      for (int j = gw >> 6; j < npad; j += (NGW >> 6)) { u32x4* dst = (u32x4*)(XS + (size_t)(base + j) * DM) + lane;
#pragma unroll
          for (int q = 0; q < 4; ++q) dst[64 * q] = (u32x4){0u, 0u, 0u, 0u}; } }
}
__device__ __forceinline__ void p10_final(const Args& a, int gw, int NGW, int lane) {
    unsigned char* ws = a.ws; float* Y = a.out; const float* st = (const float*)(ws + WS_STATS1); const bf16* YS = (const bf16*)(ws + WS_YS);
    const int* ts = (const int*)(ws + WS_TOKS); const float* tw = (const float*)(ws + WS_TOKW);
    const float* g1 = a.in[IN_LN1G]; const float* b1 = a.in[IN_LN1B]; const float* g2 = a.in[IN_LN2G]; const float* b2 = a.in[IN_LN2B];
    for (int m = gw; m < MTOK; m += NGW) {
        float* yr = Y + (size_t)m * DM + 4 * lane; const float mu = st[2 * m], rs = st[2 * m + 1];
        const int s0 = ts[2 * m], s1 = ts[2 * m + 1]; const float w0 = tw[2 * m], w1 = tw[2 * m + 1];
        const bf16* e0 = YS + (size_t)s0 * DM + 4 * lane; const bf16* e1 = YS + (size_t)s1 * DM + 4 * lane;
        f32x4 v[8]; float s = 0.f;
#pragma unroll
        for (int j = 0; j < 8; ++j) { const f32x4 y = *(const f32x4*)(yr + 256 * j); const f32x4 gv = *(const f32x4*)(g1 + 256 * j + 4 * lane), bv = *(const f32x4*)(b1 + 256 * j + 4 * lane);
            const u32x2 c0 = *(const u32x2*)(e0 + 256 * j), c1 = *(const u32x2*)(e1 + 256 * j);
            f32x4 f; f.x = w0 * bfl(c0.x) + w1 * bfl(c1.x); f.y = w0 * bfh(c0.x) + w1 * bfh(c1.x); f.z = w0 * bfl(c0.y) + w1 * bfl(c1.y); f.w = w0 * bfh(c0.y) + w1 * bfh(c1.y);
            v[j] = ((y - mu) * rs * gv + bv) * DN_ALPHA + f; s += (v[j].x + v[j].y) + (v[j].z + v[j].w); }
        const float mean = wave_sum(s) * (1.f / DM); float s2 = 0.f;
#pragma unroll
        for (int j = 0; j < 8; ++j) { v[j] = v[j] - mean; s2 += (v[j].x * v[j].x + v[j].y * v[j].y) + (v[j].z * v[j].z + v[j].w * v[j].w); }
        const float rstd = 1.0f / sqrtf(wave_sum(s2) * (1.f / DM) + LN_EPS);
#pragma unroll
        for (int j = 0; j < 8; ++j) { const f32x4 gv = *(const f32x4*)(g2 + 256 * j + 4 * lane), bv = *(const f32x4*)(b2 + 256 * j + 4 * lane); *(f32x4*)(yr + 256 * j) = v[j] * rstd * gv + bv; }
    }
}

__device__ __forceinline__ int fresh_lane() { int l = (int)(threadIdx.x & 63u); asm volatile("" : "+v"(l)); return l; }
constexpr int N_PHASES = 11;
#ifndef HELPER_ROWS
#define HELPER_ROWS 1
#endif
__global__ void __launch_bounds__(NTHREADS, 2) mk_fwd(Args args) {
    extern __shared__ __attribute__((aligned(16))) unsigned char lds_raw[];
    LAS unsigned char* lds = (LAS unsigned char*)lds_raw;
    const int tid = threadIdx.x, wave = __builtin_amdgcn_readfirstlane(tid >> 6);
#define lane fresh_lane()
    const int G = gridDim.x, gw = blockIdx.x * NWAVES + wave, NGW = G * NWAVES;
    unsigned char* ws = args.ws;
    const int lo = args.ph_lo, hi = args.ph_hi;
#ifndef PHASE_MASK
#define PHASE_MASK 0x7ff
#endif
#define IN(k) (((PHASE_MASK >> (k)) & 1) && lo <= (k) && (k) < hi)
#ifndef DOUBLE_PHASE
#define DOUBLE_PHASE 0
#endif
#define REP(k) for (int rep_ = 0; rep_ < (((DOUBLE_PHASE >> (k)) & 1) ? 2 : 1); ++rep_)
#if MK_N_LAUNCHES == 1
    cg::grid_group grid = cg::this_grid();
    { volatile LAS unsigned* st = (volatile LAS unsigned*)(lds + XB_LDS_OFF); if (tid < 2) st[tid] = 0u; }
    __syncthreads();
    const XcdBarrier bar = xcd_barrier_post((unsigned*)(ws + WS_BAR), (volatile LAS unsigned*)(lds + XB_LDS_OFF));
#define SEAM(k) do { if (IN(k) && IN((k) + 1)) { if (CG_SEAM_MASK >> (k) & 1) grid.sync(); else xcd_barrier(bar); } } while (0)
#else
#define SEAM(k) do { } while (0)
#endif
    if (IN(0)) REP(0) p0_prologue(args, lds, gw, NGW, wave, lane);
    SEAM(0);
    if (IN(1)) REP(1) { pg8::Gemm g{(const bf16*)(ws + WS_ACT), (const bf16*)(ws + WS_WIN), MTOK, DIN, DM}; pg8::StaticOrder S; S.init(MTOK, DIN, G, (int)blockIdx.x);
        pg8::EpiZ E{(bf16*)(ws + WS_Z), DIN, args.in[IN_BIN], OFF_GA / 256};
        pg8::gemm_phase<pg8::EpiZ, pg8::StaticOrder, true, true>(lds, g, S, E); }
    SEAM(1);
    if (IN(2)) REP(2) p2_attention(args, lds, wave, lane);
    SEAM(2);
    if (IN(3)) REP(3) p3_combine(args, blockIdx.x * NTHREADS + tid, G * NTHREADS);
    SEAM(3);
    if (IN(4)) REP(4) { pg8::Gemm g{(const bf16*)(ws + WS_ATT), (const bf16*)(ws + WS_WAB), MTOK, DM, ATT_LD}; pg8::StaticOrder S; S.init(MTOK, DM, G, (int)blockIdx.x);
        pg8::EpiMix E{(bf16*)(ws + WS_ACT), (const bf16*)(ws + WS_Z) + OFF_GA, (const bf16*)(ws + WS_Z) + OFF_GB, DIN};
        pg8::gemm_phase<pg8::EpiMix, pg8::StaticOrder, true, true>(lds, g, S, E); }
    SEAM(4);
    if (IN(5)) REP(5) { pg8::Gemm g{(const bf16*)(ws + WS_ACT), (const bf16*)(ws + WS_WO), MTOK, DM, DM}; pg8::StaticOrder S; S.init(MTOK, DM, G, (int)blockIdx.x);
        pg8::EpiY1 E{args.out, args.in[IN_X], (const float*)(ws + WS_STATS0), args.in[IN_LN0G], args.in[IN_LN0B], args.in[IN_BO], DN_ALPHA};
        pg8::gemm_phase<pg8::EpiY1, pg8::StaticOrder, true, true>(lds, g, S, E); }
    SEAM(5);
    if (IN(6)) REP(6) p6_ln1_router(args, lds, wave, lane);
    SEAM(6);
    if (IN(7)) REP(7) p7_permute(args, lds, gw, NGW, lane);
    SEAM(7);
    if (IN(8)) REP(8) { const int* tile = (const int*)(ws + WS_TILE);
        pg8::Gemm g{(const bf16*)(ws + WS_XS), (const bf16*)(ws + WS_WUP), PMAX, NEXP * 1024, DM}; pg8::MoeOrder S{tile + 1, tile[0], 4, G, (int)blockIdx.x};
        pg8::EpiSwiGLU E{(bf16*)(ws + WS_HID)};
        pg8::gemm_phase<pg8::EpiSwiGLU, pg8::MoeOrder, true, true>(lds, g, S, E); }
    SEAM(8);
    if (IN(9)) REP(9) { const int* tile = (const int*)(ws + WS_TILE);
        pg8::Gemm g{(const bf16*)(ws + WS_HID), (const bf16*)(ws + WS_WDN), PMAX, NEXP * 2048, DEXP}; pg8::MoeOrder S{tile + 1, tile[0], 8, G, (int)blockIdx.x};
        pg8::EpiYs E{(bf16*)(ws + WS_YS), DM, 7};
        pg8::gemm_phase<pg8::EpiYs, pg8::MoeOrder, true, true>(lds, g, S, E); }
    SEAM(9);
    if (IN(10)) REP(10) p10_final(args, gw, NGW, lane);
#undef lane
#undef IN
#undef SEAM
}

extern "C" void kernel_launch(void* const* d_in, const int* in_sizes, int n_in, void* d_out, int out_size, void* d_ws, size_t ws_size, hipStream_t stream) {
    static int grid = 0;
    if (grid == 0) {
        if (n_in != 21 || in_sizes[0] != MTOK * DM || out_size != MTOK * DM || ws_size < WS_END) { fprintf(stderr, "kernel_launch: unexpected shapes (n_in %d, in0 %d, out %d, ws %zu < %zu)\n", n_in, n_in > 0 ? in_sizes[0] : -1, out_size, ws_size, (size_t)WS_END); grid = -1; return; }
        int dev = 0, cus = 0, per_cu = 0;
        if (hipGetDevice(&dev) != hipSuccess || hipDeviceGetAttribute(&cus, hipDeviceAttributeMultiprocessorCount, dev) != hipSuccess) { fprintf(stderr, "kernel_launch: device query failed\n"); grid = -1; return; }
        if (hipFuncSetAttribute((const void*)mk_fwd, hipFuncAttributeMaxDynamicSharedMemorySize, LDS_BYTES) != hipSuccess) { fprintf(stderr, "kernel_launch: hipFuncSetAttribute failed\n"); grid = -1; return; }
        if (hipOccupancyMaxActiveBlocksPerMultiprocessor(&per_cu, (const void*)mk_fwd, NTHREADS, LDS_BYTES) != hipSuccess || per_cu < 1) { fprintf(stderr, "kernel_launch: occupancy query says %d blocks per CU\n", per_cu); (void)hipGetLastError(); per_cu = 1; }
        grid = cus * 1;
        fprintf(stderr, "kernel_launch: %d CUs, occupancy %d per CU, grid %d\n", cus, per_cu, grid);
    }
    if (grid < 0) return;
    if (hipMemsetAsync((char*)d_ws + WS_CTL, 0, CTL_ZERO_BYTES, stream) != hipSuccess) { fprintf(stderr, "kernel_launch: memset failed\n"); return; }
    Args a{};
    for (int i = 0; i < 21; ++i) a.in[i] = (const float*)d_in[i];
    a.out = (float*)d_out; a.ws = (unsigned char*)d_ws;
#if MK_N_LAUNCHES == 1
    a.ph_lo = 0; a.ph_hi = N_PHASES;
    void* kargs[] = {&a};
    hipError_t e = hipLaunchCooperativeKernel((const void*)mk_fwd, dim3(grid), dim3(NTHREADS), kargs, LDS_BYTES, stream);
    if (e != hipSuccess) fprintf(stderr, "kernel_launch: cooperative launch failed: %s (grid %d)\n", hipGetErrorString(e), grid);
#else
    for (int p = 0; p < N_PHASES; ++p) { a.ph_lo = p; a.ph_hi = p + 1; hipLaunchKernelGGL(mk_fwd, dim3(grid), dim3(NTHREADS), LDS_BYTES, stream, a);
        const hipError_t le = hipPeekAtLastError(); if (le != hipSuccess) { fprintf(stderr, "kernel_launch: launch %d failed: %s\n", p, hipGetErrorName(le)); break; } }
#endif
}
```

```cpp
#include <hip/hip_runtime.h>
#include <hip/hip_cooperative_groups.h>
#include <cstdio>
#include <cstdint>
namespace pg8 {
#define PG8_LAS __attribute__((address_space(3)))
typedef unsigned short bf16_t;
typedef short bf16x8 __attribute__((ext_vector_type(8)));
typedef float f32x4 __attribute__((ext_vector_type(4)));
typedef unsigned u32x4 __attribute__((ext_vector_type(4)));
constexpr int BM = 256, BK = 64, HALF = 128, HTB = HALF * BK * 2  , STAGE_BYTES = 8 * HTB, NXCD = 8, WGM = 8;

__host__ __device__ __forceinline__ int lds_byte(int r, int c) { const int st = (r >> 4) * 2 + (c >> 5), rr = r & 15, cc = c & 31, ob = rr * 64 + cc * 2; return st * 1024 + (ob ^ (((ob >> 9) & 1) << 5)); }
__host__ __device__ __forceinline__ void stage_rc(int b, int& R, int& C) { const int st = b / 1024, sb = b % 1024, swz = sb ^ (((sb >> 9) & 1) << 5); R = (st >> 1) * 16 + swz / 64; C = (st & 1) * 32 + (swz % 64) / 2; }
__host__ __device__ __forceinline__ int perm32(int rho) { const int n = rho >> 4, i = rho & 15; return 8 * (i >> 2) + 4 * n + (i & 3); }

struct Unit { int pm, pn; };
struct Gemm { const bf16_t* A; const bf16_t* Bt; int M, N, K; };

struct StaticOrder {
    int nM, nN, nwg, G, c;
    __host__ __device__ void init(int M, int N, int G_, int c_) { nM = M / BM; nN = N / BM; nwg = nM * nN; G = G_; c = c_; }
    __host__ __device__ bool next(int i, Unit& u) const {
        const long L = (long)i * G + c; if (L >= nwg) return false;
        int wgid = (int)L; { const int q = nwg / NXCD, r = nwg % NXCD, xcd = wgid % NXCD, off = wgid / NXCD; wgid = (xcd < r ? xcd * (q + 1) : r * (q + 1) + (xcd - r) * q) + off; }
        const int nig = WGM * nN, gid = wgid / nig, fm = gid * WGM, gsz = (nM - fm) < WGM ? (nM - fm) : WGM;
        u.pm = fm + ((wgid % nig) % gsz); u.pn = (wgid % nig) / gsz; return true;
    }
    __device__ __forceinline__ void a_ready(const Unit&) const {}
    __device__ __forceinline__ void done(const Unit&) const {}
};
__device__ __forceinline__ unsigned cvt_pk_bf16(float lo, float hi) { unsigned r; asm volatile("v_cvt_pk_bf16_f32 %0, %1, %2" : "=v"(r) : "v"(lo), "v"(hi)); return r; }
typedef float f32x2 __attribute__((ext_vector_type(2)));
__device__ __forceinline__ float sigm(float x) { return __builtin_amdgcn_rcpf(1.0f + __builtin_amdgcn_exp2f(-1.4426950408889634f * x)); }
__device__ __forceinline__ float bf_lo(unsigned w) { return __uint_as_float(w << 16); }
__device__ __forceinline__ float bf_hi(unsigned w) { return __uint_as_float(w & 0xffff0000u); }
struct EpiZ {
    static constexpr bool PERM = true, AFTER_DRAIN = false; static constexpr int MID_T = 0;
    bf16_t* O; int ldc; const float* bias; int sig_pn;
    __device__ __forceinline__ void operator()(const f32x4 (&acc)[2][2][4][2], const Unit& u, int wr, int wc, int fr, int fq) const {
        const int row0 = u.pm * BM + wr * 64 + fr, col0 = u.pn * BM + wc * 32 + 8 * fq; const bool sg = u.pn >= sig_pn;
        f32x4 bv[2][2];
#pragma unroll
        for (int bj = 0; bj < 2; ++bj)
#pragma unroll
            for (int n = 0; n < 2; ++n) bv[bj][n] = *(const f32x4*)(bias + col0 + bj * HALF + 4 * n);
#pragma unroll
        for (int ai = 0; ai < 2; ++ai)
#pragma unroll
            for (int m = 0; m < 4; ++m) { bf16_t* rowp = O + (size_t)(row0 + ai * HALF + m * 16) * ldc + col0;
#pragma unroll
                for (int bj = 0; bj < 2; ++bj) { f32x4 v0 = acc[ai][bj][m][0] + bv[bj][0], v1 = acc[ai][bj][m][1] + bv[bj][1];
                    if (sg) {
#pragma unroll
                        for (int j = 0; j < 4; ++j) { v0[j] = sigm(v0[j]); v1[j] = sigm(v1[j]); } }
                    u32x4 w; w.x = cvt_pk_bf16(v0[0], v0[1]); w.y = cvt_pk_bf16(v0[2], v0[3]); w.z = cvt_pk_bf16(v1[0], v1[1]); w.w = cvt_pk_bf16(v1[2], v1[3]);
                    *(u32x4*)(rowp + bj * HALF) = w; } }
    }
};
struct EpiMix {
    static constexpr bool PERM = true, AFTER_DRAIN = false; static constexpr int MID_T = 8;
    bf16_t* O; const bf16_t* ga; const bf16_t* gb; int ldg;
    __device__ __forceinline__ void mid(f32x4 (&acc)[2][2][4][2], const Unit& u, int wr, int wc, int fr, int fq) const {
        int row0 = u.pm * BM + wr * 64 + fr; const int col0 = u.pn * BM + wc * 32 + 8 * fq;
        asm volatile("" : "+v"(row0));
#pragma unroll
        for (int ai = 0; ai < 2; ++ai)
#pragma unroll
            for (int m = 0; m < 4; ++m) { const size_t r = (size_t)(row0 + ai * HALF + m * 16);
#pragma unroll
                for (int bj = 0; bj < 2; ++bj) {
                    const u32x4 a = *(const u32x4*)(ga + r * ldg + col0 + bj * HALF), b = *(const u32x4*)(gb + r * ldg + col0 + bj * HALF);
                    f32x4& v0 = acc[ai][bj][m][0]; f32x4& v1 = acc[ai][bj][m][1];
                    v0[0] *= bf_lo(b.x) * __builtin_amdgcn_rcpf(bf_lo(a.x)); v0[1] *= bf_hi(b.x) * __builtin_amdgcn_rcpf(bf_hi(a.x)); v0[2] *= bf_lo(b.y) * __builtin_amdgcn_rcpf(bf_lo(a.y)); v0[3] *= bf_hi(b.y) * __builtin_amdgcn_rcpf(bf_hi(a.y));
                    v1[0] *= bf_lo(b.z) * __builtin_amdgcn_rcpf(bf_lo(a.z)); v1[1] *= bf_hi(b.z) * __builtin_amdgcn_rcpf(bf_hi(a.z)); v1[2] *= bf_lo(b.w) * __builtin_amdgcn_rcpf(bf_lo(a.w)); v1[3] *= bf_hi(b.w) * __builtin_amdgcn_rcpf(bf_hi(a.w)); }
                asm volatile("" ::: "memory"); }
    }
    __device__ __forceinline__ void operator()(const f32x4 (&acc)[2][2][4][2], const Unit& u, int wr, int wc, int fr, int fq) const {
        const int row0 = u.pm * BM + wr * 64 + fr, col0 = u.pn * BM + wc * 32 + 8 * fq;
#pragma unroll
        for (int ai = 0; ai < 2; ++ai)
#pragma unroll
            for (int m = 0; m < 4; ++m) { const size_t r = (size_t)(row0 + ai * HALF + m * 16);
#pragma unroll
                for (int bj = 0; bj < 2; ++bj) {
                    const u32x4 a = *(const u32x4*)(ga + r * ldg + col0 + bj * HALF);
                    const f32x4 v0 = acc[ai][bj][m][0], v1 = acc[ai][bj][m][1];
                    u32x4 w; w.x = cvt_pk_bf16(v0[0] * bf_lo(a.x), v0[1] * bf_hi(a.x)); w.y = cvt_pk_bf16(v0[2] * bf_lo(a.y), v0[3] * bf_hi(a.y));
                    w.z = cvt_pk_bf16(v1[0] * bf_lo(a.z), v1[1] * bf_hi(a.z)); w.w = cvt_pk_bf16(v1[2] * bf_lo(a.w), v1[3] * bf_hi(a.w));
                    *(u32x4*)(O + r * 2048 + col0 + bj * HALF) = w; } }
    }
};
struct EpiY1 {
    static constexpr bool PERM = false, AFTER_DRAIN = false; static constexpr int MID_T = 0;
    float* Y; const float* X; const float* stats; const float* g0; const float* b0; const float* bo; float alpha;
    __device__ __forceinline__ void operator()(const f32x4 (&acc)[2][2][4][2], const Unit& u, int wr, int wc, int fr, int fq) const {
        const int row0 = u.pm * BM + wr * 64 + fr, col0 = u.pn * BM + wc * 32 + 4 * fq;
        f32x4 ag[2][2], cb[2][2];
#pragma unroll
        for (int bj = 0; bj < 2; ++bj)
#pragma unroll
            for (int n = 0; n < 2; ++n) { const int c = col0 + bj * HALF + n * 16; ag[bj][n] = *(const f32x4*)(g0 + c) * alpha; cb[bj][n] = *(const f32x4*)(b0 + c) * alpha + *(const f32x4*)(bo + c); }
#pragma unroll
        for (int ai = 0; ai < 2; ++ai)
#pragma unroll
            for (int m = 0; m < 4; ++m) { const size_t r = (size_t)(row0 + ai * HALF + m * 16); const float mu = stats[2 * r], rs = stats[2 * r + 1];
#pragma unroll
                for (int bj = 0; bj < 2; ++bj)
#pragma unroll
                    for (int n = 0; n < 2; ++n) { const size_t o = r * 2048 + col0 + bj * HALF + n * 16; const f32x4 xv = *(const f32x4*)(X + o);
                        *(f32x4*)(Y + o) = (xv - mu) * rs * ag[bj][n] + cb[bj][n] + acc[ai][bj][m][n]; }
                asm volatile("" ::: "memory"); }
    }
};
struct EpiSwiGLU {
    static constexpr bool PERM = true, AFTER_DRAIN = false; static constexpr int MID_T = 0;
    bf16_t* H;
    __device__ __forceinline__ void operator()(const f32x4 (&acc)[2][2][4][2], const Unit& u, int wr, int wc, int fr, int fq) const {
        const int row0 = u.pm * BM + wr * 64 + fr, col0 = (u.pn & 3) * 128 + wc * 32 + 8 * fq;
#pragma unroll
        for (int ai = 0; ai < 2; ++ai)
#pragma unroll
            for (int m = 0; m < 4; ++m) { f32x4 v0, v1;
#pragma unroll
                for (int j = 0; j < 4; ++j) { const float a = acc[ai][0][m][0][j], b = acc[ai][0][m][1][j]; v0[j] = a * sigm(a) * acc[ai][1][m][0][j]; v1[j] = b * sigm(b) * acc[ai][1][m][1][j]; }
                u32x4 w; w.x = cvt_pk_bf16(v0[0], v0[1]); w.y = cvt_pk_bf16(v0[2], v0[3]); w.z = cvt_pk_bf16(v1[0], v1[1]); w.w = cvt_pk_bf16(v1[2], v1[3]);
                *(u32x4*)(H + (size_t)(row0 + ai * HALF + m * 16) * 512 + col0) = w; }
    }
};
struct EpiYs {
    static constexpr bool PERM = true, AFTER_DRAIN = false; static constexpr int MID_T = 0;
    bf16_t* O; int ldc; int pn_mask;
    __device__ __forceinline__ void operator()(const f32x4 (&acc)[2][2][4][2], const Unit& u, int wr, int wc, int fr, int fq) const {
        const int row0 = u.pm * BM + wr * 64 + fr, col0 = (u.pn & pn_mask) * BM + wc * 32 + 8 * fq;
#pragma unroll
        for (int ai = 0; ai < 2; ++ai)
#pragma unroll
            for (int m = 0; m < 4; ++m) { bf16_t* rowp = O + (size_t)(row0 + ai * HALF + m * 16) * ldc + col0;
#pragma unroll
                for (int bj = 0; bj < 2; ++bj) { const f32x4 v0 = acc[ai][bj][m][0], v1 = acc[ai][bj][m][1];
                    u32x4 w; w.x = cvt_pk_bf16(v0[0], v0[1]); w.y = cvt_pk_bf16(v0[2], v0[3]); w.z = cvt_pk_bf16(v1[0], v1[1]); w.w = cvt_pk_bf16(v1[2], v1[3]);
                    *(u32x4*)(rowp + bj * HALF) = w; } }
    }
};
struct MoeOrder {
    const int* tile_e; int ntiles, nper, G, c;
    __device__ __forceinline__ bool next(int i, Unit& u) const {
        const long L = (long)i * G + c; if (L >= (long)ntiles * nper) return false;
        const int j = (int)(L / nper), t = (int)(L % nper); u.pm = j; u.pn = tile_e[j] * nper + t; return true;
    }
    __device__ __forceinline__ void a_ready(const Unit&) const {}
    __device__ __forceinline__ void done(const Unit&) const {}
};
template <class Epi, class Sched, bool ALIGN_EPI = false, bool SP2 = false>
__device__ __forceinline__ void gemm_phase(PG8_LAS unsigned char* lds, const Gemm g, const Sched& S, const Epi& E) {
    const int tid = threadIdx.x, wid = __builtin_amdgcn_readfirstlane(tid >> 6), lane = tid & 63, wr = wid >> 2, wc = wid & 3, fr = lane & 15, fq = lane >> 4;
    const int K = g.K, nt = K / BK;
    unsigned voffA[2], voffB[2];
#pragma unroll
    for (int i = 0; i < 2; ++i) { int R, C; stage_rc(tid * 16 + i * 8192, R, C); const int Rb = Epi::PERM ? ((R & ~31) + perm32(R & 31)) : R;
        voffA[i] = (unsigned)(R * K + C) * 2u; voffB[i] = (unsigned)(Rb * K + C) * 2u; }
    const size_t kstep = (size_t)(BK * 2);
    const size_t hstep = (size_t)HALF * K * 2;
    const size_t tstep = 2 * hstep;
    const unsigned ldsw = (unsigned)wid * 1024u;
    const int aoff = lds_byte(wr * 64 + fr, fq * 8), boff = lds_byte(wc * 32 + fr, fq * 8);
#define PG8_SA(b, h) (((b) * 2 + (h)) * HTB)
#define PG8_SB(b, h) ((4 + (b) * 2 + (h)) * HTB)
#define PG8_STAGE(bufoff, gbase, voff) do { _Pragma("unroll") for (int _i = 0; _i < 2; ++_i) \
        __builtin_amdgcn_global_load_lds((const unsigned*)((const char*)(gbase) + (voff)[_i]), (PG8_LAS unsigned*)(lds + (bufoff) + ldsw + _i * 8192), 16, 0, 0); } while (0)
#define PG8_LDA(dst, b, h) do { _Pragma("unroll") for (int m = 0; m < 4; ++m) _Pragma("unroll") for (int k = 0; k < 2; ++k) dst[m][k] = *(const PG8_LAS bf16x8*)(lds + PG8_SA(b, h) + aoff + m * 2048 + k * 1024); } while (0)
#define PG8_LDB(dst, b, h) do { _Pragma("unroll") for (int n = 0; n < 2; ++n) _Pragma("unroll") for (int k = 0; k < 2; ++k) dst[n][k] = *(const PG8_LAS bf16x8*)(lds + PG8_SB(b, h) + boff + n * 2048 + k * 1024); } while (0)
#define PG8_MMA(ai, bj, At, Bt) do { __builtin_amdgcn_s_setprio(1); _Pragma("unroll") for (int m = 0; m < 4; ++m) _Pragma("unroll") for (int n = 0; n < 2; ++n) _Pragma("unroll") for (int k = 0; k < 2; ++k) \
        acc[ai][bj][m][n] = __builtin_amdgcn_mfma_f32_16x16x32_bf16(Bt[n][k], At[m][k], acc[ai][bj][m][n], 0, 0, 0); __builtin_amdgcn_s_setprio(0); } while (0)
#define PG8_WAIT_V(n) asm volatile("s_waitcnt vmcnt(" #n ")" ::: "memory")
#define PG8_WAIT_L(n) asm volatile("s_waitcnt lgkmcnt(" #n ")" ::: "memory")
#define PG8_BAR __builtin_amdgcn_s_barrier()
#define PG8_SCHED __builtin_amdgcn_sched_barrier(0)
    Unit cur, nxt; int ui = 0;
    if (!S.next(0, cur)) return;
    f32x4 acc[2][2][4][2];
#pragma unroll
    for (int a = 0; a < 2; ++a)
#pragma unroll
        for (int b = 0; b < 2; ++b)
#pragma unroll
            for (int m = 0; m < 4; ++m)
#pragma unroll
                for (int n = 0; n < 2; ++n) acc[a][b][m][n] = (f32x4){0.f, 0.f, 0.f, 0.f};
    bf16x8 At[4][2], B0[2][2], B1[2][2];
    const char* cA = (const char*)g.A + (size_t)cur.pm * tstep; const char* cB = (const char*)g.Bt + (size_t)cur.pn * tstep;
    S.a_ready(cur);
    if constexpr (SP2) {
        PG8_STAGE(PG8_SB(0, 0), cB, voffB); PG8_STAGE(PG8_SB(0, 1), cB + hstep, voffB); PG8_STAGE(PG8_SA(0, 0), cA, voffA); PG8_STAGE(PG8_SA(0, 1), cA + hstep, voffA);
        if (wr == 1) PG8_BAR;
        PG8_WAIT_V(2); PG8_BAR;
        PG8_STAGE(PG8_SB(1, 0), cB + kstep, voffB); PG8_STAGE(PG8_SA(1, 0), cA + kstep, voffA); PG8_STAGE(PG8_SB(1, 1), cB + hstep + kstep, voffB);
        PG8_WAIT_V(6); PG8_BAR;
    } else {
        PG8_STAGE(PG8_SB(0, 0), cB, voffB); PG8_STAGE(PG8_SA(0, 0), cA, voffA); PG8_STAGE(PG8_SB(0, 1), cB + hstep, voffB); PG8_STAGE(PG8_SA(0, 1), cA + hstep, voffA);
        if (wr == 1) PG8_BAR;
        PG8_WAIT_V(4); PG8_BAR;
        PG8_STAGE(PG8_SB(1, 0), cB + kstep, voffB); PG8_STAGE(PG8_SA(1, 0), cA + kstep, voffA); PG8_STAGE(PG8_SB(1, 1), cB + hstep + kstep, voffB);
        PG8_WAIT_V(6); PG8_BAR;
    }
    for (;;) {
        const bool has_next = S.next(ui + 1, nxt);
        const char* nA = has_next ? (const char*)g.A + (size_t)nxt.pm * tstep : cA; const char* nB = has_next ? (const char*)g.Bt + (size_t)nxt.pn * tstep : cB;
        for (int t = 0; t < nt; t += 2) {
            const bool last = (t == nt - 2);
            const char* a1 = cA + (size_t)(t + 1) * kstep;
            const char* a2 = last ? nA : cA + (size_t)(t + 2) * kstep; const char* b2 = last ? nB : cB + (size_t)(t + 2) * kstep;
            const char* a3 = a2 + kstep; const char* b3 = b2 + kstep;
            if (last && has_next) S.a_ready(nxt);
            if constexpr (Epi::MID_T > 0) { if (t == Epi::MID_T) E.mid(acc, cur, wr, wc, fr, fq); }
            if constexpr (SP2) {
            PG8_LDB(B0, 0, 0); PG8_LDB(B1, 0, 1); PG8_SCHED; PG8_LDA(At, 0, 0); PG8_STAGE(PG8_SA(1, 1), a1 + hstep, voffA);
            PG8_WAIT_V(8); PG8_WAIT_L(0); PG8_BAR; PG8_MMA(0, 0, At, B0); PG8_MMA(0, 1, At, B1); PG8_BAR; PG8_SCHED;
            PG8_LDA(At, 0, 1); PG8_STAGE(PG8_SB(0, 0), b2, voffB); PG8_STAGE(PG8_SB(0, 1), b2 + hstep, voffB); PG8_STAGE(PG8_SA(0, 0), a2, voffA);
            PG8_WAIT_V(8); PG8_WAIT_L(0); PG8_BAR; PG8_MMA(1, 0, At, B0); PG8_MMA(1, 1, At, B1); PG8_BAR; PG8_SCHED;
            PG8_LDB(B0, 1, 0); PG8_LDB(B1, 1, 1); PG8_SCHED; PG8_LDA(At, 1, 0); PG8_STAGE(PG8_SA(0, 1), a2 + hstep, voffA);
            PG8_WAIT_V(8); PG8_WAIT_L(0); PG8_BAR; PG8_MMA(0, 0, At, B0); PG8_MMA(0, 1, At, B1); PG8_BAR; PG8_SCHED;
            PG8_LDA(At, 1, 1); PG8_STAGE(PG8_SB(1, 0), b3, voffB); PG8_STAGE(PG8_SB(1, 1), b3 + hstep, voffB); PG8_STAGE(PG8_SA(1, 0), a3, voffA);
            PG8_WAIT_V(8); PG8_WAIT_L(0); PG8_BAR; PG8_MMA(1, 0, At, B0); PG8_MMA(1, 1, At, B1); PG8_BAR; PG8_SCHED;
            } else {
            PG8_LDB(B0, 0, 0); PG8_SCHED; PG8_LDA(At, 0, 0); PG8_STAGE(PG8_SA(1, 1), a1 + hstep, voffA);
            PG8_WAIT_L(8); PG8_BAR; PG8_WAIT_L(0); PG8_MMA(0, 0, At, B0); PG8_BAR; PG8_SCHED;
            PG8_LDB(B1, 0, 1); PG8_STAGE(PG8_SB(0, 0), b2, voffB);
            PG8_BAR; PG8_WAIT_L(0); PG8_MMA(0, 1, At, B1); PG8_BAR;
            PG8_LDA(At, 0, 1); PG8_STAGE(PG8_SA(0, 0), a2, voffA);
            PG8_BAR; PG8_WAIT_L(0); PG8_MMA(1, 0, At, B0); PG8_BAR; PG8_SCHED;
            PG8_STAGE(PG8_SB(0, 1), b2 + hstep, voffB);
            PG8_WAIT_V(6); PG8_BAR; PG8_MMA(1, 1, At, B1); PG8_BAR;
            PG8_LDB(B0, 1, 0); PG8_SCHED; PG8_LDA(At, 1, 0); PG8_STAGE(PG8_SA(0, 1), a2 + hstep, voffA);
            PG8_WAIT_L(8); PG8_BAR; PG8_WAIT_L(0); PG8_MMA(0, 0, At, B0); PG8_BAR; PG8_SCHED;
            PG8_LDB(B1, 1, 1); PG8_STAGE(PG8_SB(1, 0), b3, voffB);
            PG8_BAR; PG8_WAIT_L(0); PG8_MMA(0, 1, At, B1); PG8_BAR;
            PG8_LDA(At, 1, 1); PG8_STAGE(PG8_SA(1, 0), a3, voffA);
            PG8_BAR; PG8_WAIT_L(0); PG8_MMA(1, 0, At, B0); PG8_BAR; PG8_SCHED;
            PG8_STAGE(PG8_SB(1, 1), b3 + hstep, voffB);
            PG8_WAIT_V(6); PG8_BAR; PG8_MMA(1, 1, At, B1); PG8_BAR;
            }
        }
        if constexpr (ALIGN_EPI) { if (wr == 0) PG8_BAR; }
        if constexpr (!Epi::AFTER_DRAIN) { E(acc, cur, wr, wc, fr, fq); S.done(cur); }
        if (!has_next) break;
#pragma unroll
        for (int a = 0; a < 2; ++a)
#pragma unroll
            for (int b = 0; b < 2; ++b)
#pragma unroll
                for (int m = 0; m < 4; ++m)
#pragma unroll
                    for (int n = 0; n < 2; ++n) acc[a][b][m][n] = (f32x4){0.f, 0.f, 0.f, 0.f};
        cur = nxt; cA = nA; cB = nB; ++ui;
        if constexpr (ALIGN_EPI) { if (wr == 1) PG8_BAR; }
    }
    PG8_WAIT_V(0);
    if constexpr (!ALIGN_EPI) { if (wr == 0) PG8_BAR; }
    PG8_BAR;
    if constexpr (Epi::AFTER_DRAIN) { E.fused(acc, cur, wr, wc, fr, fq, lds, wid, lane); S.done(cur); }
#undef PG8_SA
#undef PG8_SB
#undef PG8_STAGE
#undef PG8_LDA
#undef PG8_LDB
#undef PG8_MMA
#undef PG8_WAIT_V
#undef PG8_WAIT_L
#undef PG8_BAR
#undef PG8_SCHED
}
}

#ifndef MK_N_LAUNCHES
#define MK_N_LAUNCHES 1
#endif
namespace cg = cooperative_groups;
#define GAS __attribute__((address_space(1)))
#define LAS __attribute__((address_space(3)))
typedef unsigned short bf16;
typedef unsigned u32x4 __attribute__((ext_vector_type(4)));
typedef unsigned u32x2 __attribute__((ext_vector_type(2)));
typedef float f32x4 __attribute__((ext_vector_type(4)));
typedef float f32x2 __attribute__((ext_vector_type(2)));
typedef short bf16x8 __attribute__((ext_vector_type(8)));
typedef short s16x4 __attribute__((ext_vector_type(4)));
typedef __bf16 bf16v2 __attribute__((ext_vector_type(2)));

constexpr int NWAVES = 8, NTHREADS = 512;
constexpr int BATCH = 2, SEQ = 8192, DM = 2048, MTOK = BATCH * SEQ;
constexpr int DIN = 11776, OFF_QA = 0, OFF_KA = 1024, OFF_VA = 2048, OFF_QB = 3072, OFF_KB = 4608, OFF_VB = 6144, OFF_GA = 7680, OFF_GB = 9728;
constexpr int GRID_W = 64, GRID_ROWS = SEQ / GRID_W, NA_HEADS = 8, DIL_HEADS = 12;
constexpr int NEXP = 64, DEXP = 512, PMAX = 49152, MAXTILES = PMAX / 256;
constexpr float LN_EPS = 1e-5f, DN_ALPHA = 1.189207115002721f, ATT_SCALE = 0.08838834764831845f;
constexpr int NRW = 80;
#ifndef MOE_HELPER_ITEMS
#define MOE_HELPER_ITEMS 3584
#endif
constexpr size_t MiB = 1u << 20, KiB = 1u << 10;
constexpr size_t WS_CTL = 0, WS_BAR = 16384, CTL_ZERO_BYTES = 65536;
constexpr size_t WS_STATS0 = 1 * MiB, WS_STATS1 = 1 * MiB + 128 * KiB, WS_TOKE = 1 * MiB + 256 * KiB, WS_TOKW = 1 * MiB + 384 * KiB, WS_TOKP = 1 * MiB + 512 * KiB, WS_TOKS = 1 * MiB + 640 * KiB, WS_TILE = 1 * MiB + 768 * KiB;
constexpr size_t WS_LSE = 2 * MiB;
constexpr size_t WS_WRH = 3 * MiB, WS_WRL = 3 * MiB + 512 * KiB;
constexpr size_t WS_WIN = 4 * MiB, WS_WAB = 50 * MiB, WS_WO = 56 * MiB;
constexpr size_t WS_ACT = 64 * MiB;
constexpr size_t WS_ATT = 128 * MiB, WS_DILG = 176 * MiB;
constexpr int ATT_LD = 1536;
constexpr size_t WS_Z = 224 * MiB;
constexpr size_t WS_WUP = 592 * MiB, WS_WDN = 848 * MiB, WS_END = 976 * MiB;
constexpr size_t WS_XS = 224 * MiB, WS_HID = 416 * MiB, WS_YS = 224 * MiB, WS_LO = 464 * MiB;
static_assert(WS_WIN + (size_t)DIN * DM * 2 <= WS_WAB && WS_ATT + (size_t)MTOK * ATT_LD * 2 <= WS_DILG && WS_DILG + (size_t)3 * MTOK * 512 * 2 <= WS_Z && WS_Z + (size_t)MTOK * DIN * 2 <= WS_WUP && WS_XS + (size_t)PMAX * DM * 2 <= WS_HID && WS_HID + (size_t)PMAX * DEXP * 2 <= WS_LO && WS_LO + (size_t)MTOK * DM * 2 <= WS_WUP, "ws map");
constexpr int RING_BYTES = 131072, RPB_OFF = 147456, XB_LDS_OFF = 147456 + 15360, LDS_BYTES = 163840;
#ifndef CG_SEAM_MASK
#define CG_SEAM_MASK 1
#endif

__device__ __forceinline__ unsigned pk2(float lo, float hi) { f32x2 v = {lo, hi}; bf16v2 b = __builtin_convertvector(v, bf16v2); return __builtin_bit_cast(unsigned, b); }
__device__ __forceinline__ float bfl(unsigned w) { return __uint_as_float(w << 16); }
__device__ __forceinline__ float bfh(unsigned w) { return __uint_as_float(w & 0xffff0000u); }
__device__ __forceinline__ float wave_sum(float v) {
#pragma unroll
    for (int o = 1; o < 64; o <<= 1) v += __shfl_xor(v, o);
    return v;
}
#define LDS_WAIT() asm volatile("s_waitcnt lgkmcnt(0)" ::: "memory")
#define VM_WAIT() asm volatile("s_waitcnt vmcnt(0)" ::: "memory")

struct Args { const float* in[21]; float* out; unsigned char* ws; int ph_lo, ph_hi; };
enum { IN_X = 0, IN_LN0G, IN_LN0B, IN_WIN, IN_BIN, IN_RPB, IN_WPA, IN_WPB, IN_WO, IN_BO, IN_LN1G, IN_LN1B, IN_WRG, IN_BRG, IN_WRE, IN_BRE, IN_WG, IN_WU, IN_WD, IN_LN2G, IN_LN2B };

__device__ __forceinline__ unsigned xv_(unsigned row) { return ((row & 3u) << 2) | ((row >> 2) & 3u); }
__device__ __forceinline__ void p0_transpose_item(const float* W, int N, int K, bf16* WT, long dst_row0, int k0, int n0, LAS float* scr, int lane, int kdst = 0) {
#pragma unroll 8
    for (int i = 0; i < 32; ++i) { const int kk = 2 * i + (lane >> 5); scr[kk * 33 + (lane & 31)] = W[(size_t)(k0 + kk) * N + n0 + (lane & 31)]; }
    LDS_WAIT();
    const int c = lane & 7;
#pragma unroll
    for (int j = 0; j < 4; ++j) { const int n = (lane >> 3) + 8 * j; const LAS float* s = scr + (8 * c) * 33 + n;
        u32x4 o; o.x = pk2(s[0 * 33], s[1 * 33]); o.y = pk2(s[2 * 33], s[3 * 33]); o.z = pk2(s[4 * 33], s[5 * 33]); o.w = pk2(s[6 * 33], s[7 * 33]);
        *(u32x4*)(WT + (size_t)(dst_row0 + n) * K + kdst + k0 + 8 * c) = o; }
    LDS_WAIT();
}
__device__ __forceinline__ void p0_prologue(const Args& a, LAS unsigned char* lds, int gw, int NGW, int wave, int lane) {
    LAS float* scr = (LAS float*)(lds + wave * 16384);
    unsigned char* ws = a.ws;
    constexpr int I0 = 32 * 368, I1 = 16 * 64, I2 = 8 * 64, I3 = 32 * 64, I4 = NEXP * 32 * 16, I5 = I4, I6 = NEXP * 8 * 64;
    constexpr int NITEMS = I0 + I1 + I2 + I3 + I4 + I5 + I6;
    for (int it = gw; it < NITEMS; it += NGW) {
        int r = it;
        if (r < I0) { const int kb = r / 368, nb = r % 368; p0_transpose_item(a.in[IN_WIN], DIN, DM, (bf16*)(ws + WS_WIN), 32 * nb, 64 * kb, 32 * nb, scr, lane); continue; } r -= I0;
        if (r < I1) { const int kb = r / 64, nb = r % 64; p0_transpose_item(a.in[IN_WPA], DM, ATT_LD, (bf16*)(ws + WS_WAB), 32 * nb, 64 * kb, 32 * nb, scr, lane, 512); continue; } r -= I1;
        if (r < I2) { const int kb = r / 64, nb = r % 64; p0_transpose_item(a.in[IN_WPB], DM, ATT_LD, (bf16*)(ws + WS_WAB), 32 * nb, 64 * kb, 32 * nb, scr, lane, 0); continue; } r -= I2;
        if (r < I3) { const int kb = r / 64, nb = r % 64; p0_transpose_item(a.in[IN_WO], DM, DM, (bf16*)(ws + WS_WO), 32 * nb, 64 * kb, 32 * nb, scr, lane); continue; } r -= I3;
        if (r < I4 + I5) { const int mat = r >= I4; if (mat) r -= I4; const int e = r / 512, q = r % 512, kb = q / 16, nb = q % 16, n0 = 32 * nb;
            const float* W = (mat ? a.in[IN_WU] : a.in[IN_WG]) + (size_t)e * DM * DEXP;
            p0_transpose_item(W, DEXP, DM, (bf16*)(ws + WS_WUP), (long)e * 1024 + (n0 >> 7) * 256 + mat * 128 + (n0 & 127), 64 * kb, n0, scr, lane); continue; } r -= I4 + I5;
        { const int e = r / 512, q = r % 512, kb = q / 64, nb = q % 64;
            p0_transpose_item(a.in[IN_WD] + (size_t)e * DEXP * DM, DM, DEXP, (bf16*)(ws + WS_WDN), (long)e * 2048 + 32 * nb, 64 * kb, 32 * nb, scr, lane); }
    }
    { bf16* wh = (bf16*)(ws + WS_WRH); bf16* wl = (bf16*)(ws + WS_WRL);
      for (int i = gw * 64 + lane; i < NRW * DM; i += NGW * 64) { const int n = i / DM, k = i % DM;
          const float v = n < 8 ? a.in[IN_WRG][(size_t)k * 8 + n] : (n < 72 ? a.in[IN_WRE][(size_t)k * 64 + (n - 8)] : 0.f);
          const unsigned h = pk2(v, 0.f) & 0xffffu; const float r = v - __uint_as_float(h << 16);
          wh[i] = (bf16)h; wl[i] = (bf16)(pk2(r, 0.f) & 0xffffu); } }
    { const float* g = a.in[IN_LN0G]; const float* bb = a.in[IN_LN0B]; float* st = (float*)(ws + WS_STATS0); bf16* H = (bf16*)(ws + WS_ACT);
      f32x4 gv[8], bv[8];
#pragma unroll
      for (int j = 0; j < 8; ++j) { gv[j] = *(const f32x4*)(g + 256 * j + 4 * lane); bv[j] = *(const f32x4*)(bb + 256 * j + 4 * lane); }
      for (int m = gw; m < MTOK; m += NGW) {
          const float* xr = a.in[IN_X] + (size_t)m * DM + 4 * lane; f32x4 v[8]; float s = 0.f;
#pragma unroll
          for (int j = 0; j < 8; ++j) { v[j] = *(const f32x4*)(xr + 256 * j); s += (v[j].x + v[j].y) + (v[j].z + v[j].w); }
          const float mean = wave_sum(s) * (1.f / DM); float s2 = 0.f;
#pragma unroll
          for (int j = 0; j < 8; ++j) { v[j] = v[j] - mean; s2 += (v[j].x * v[j].x + v[j].y * v[j].y) + (v[j].z * v[j].z + v[j].w * v[j].w); }
          const float rstd = 1.0f / sqrtf(wave_sum(s2) * (1.f / DM) + LN_EPS);
          if (lane == 0) { st[2 * m] = mean; st[2 * m + 1] = rstd; }
          bf16* orow = H + (size_t)m * DM + 4 * lane;
#pragma unroll
          for (int j = 0; j < 8; ++j) { const f32x4 y = v[j] * rstd * gv[j] + bv[j]; u32x2 w; w.x = pk2(y.x, y.y); w.y = pk2(y.z, y.w); *(u32x2*)(orow + 256 * j) = w; }
      } }
}
#define XB_TMO      128
#define XB_XCNT(j)  (256  + 64 * (j))
#define XB_XSUB(j)  (1280 + 64 * (j))
#define XB_XGEN(j)  (2304 + 64 * (j))
#define XB_TOP      3328
#define XB_TOPGEN   3392
#define XCD_BAR_WORDS 3456
#define XB_SPIN_CAP (1u << 18)

__device__ __forceinline__ unsigned xb_ld(unsigned* p)              { return __hip_atomic_load(p, __ATOMIC_RELAXED, __HIP_MEMORY_SCOPE_AGENT); }
__device__ __forceinline__ unsigned xb_add(unsigned* p, unsigned v) { return __hip_atomic_fetch_add(p, v, __ATOMIC_RELAXED, __HIP_MEMORY_SCOPE_AGENT); }
__device__ __forceinline__ unsigned xb_xcc_id() { return (unsigned)__builtin_amdgcn_s_getreg((3 << 11) | 20) & 0xFu; }
#define XB_SPIN(cond, bar) do { unsigned _sp = 0; while (cond) { __builtin_amdgcn_s_sleep(1); \
    if ((++_sp & 255u) == 0u) { if (xb_ld(&(bar)[XB_TMO])) break; if (_sp > XB_SPIN_CAP) { atomicAdd(&(bar)[XB_TMO], 1u); break; } } } } while (0)

struct XcdBarrier {
    unsigned* bar; unsigned x;
    volatile LAS unsigned* st;
};

__device__ __forceinline__ XcdBarrier xcd_barrier_post(unsigned* bar, volatile LAS unsigned* st) {
    XcdBarrier b; b.bar = bar; b.x = xb_xcc_id(); b.st = st;
    if (threadIdx.x == 0) (void)xb_add(&bar[XB_XCNT(b.x)], 1u);
    return b;
}
__device__ __forceinline__ void xcd_barrier_complete(unsigned* bar, unsigned x, unsigned& nloc, unsigned& nx) {
    const unsigned G = gridDim.x * gridDim.y * gridDim.z;
    unsigned sum, cnt, mine, sp = 0u;
    for (;;) {
        sum = 0u; cnt = 0u; mine = 0u;
#pragma unroll
        for (unsigned j = 0; j < 16; ++j) { const unsigned c = xb_ld(&bar[XB_XCNT(j)]); sum += c; cnt += (c > 0u) ? 1u : 0u; mine = (j == x) ? c : mine; }
        if (sum == G) break;
        __builtin_amdgcn_s_sleep(1);
        if ((++sp & 255u) == 0u) { if (xb_ld(&bar[XB_TMO])) break; if (sp > XB_SPIN_CAP) { atomicAdd(&bar[XB_TMO], 1u); break; } }
    }
    nloc = mine > 0u ? mine : 1u; nx = cnt > 0u ? cnt : 1u;
}

__device__ __forceinline__ void xcd_barrier(const XcdBarrier& b) {
    asm volatile("s_waitcnt vmcnt(0)" ::: "memory");
    __syncthreads();
    if (threadIdx.x == 0) {
        unsigned* bar = b.bar;
        __builtin_amdgcn_s_waitcnt(0);
        unsigned nloc = b.st[0], nx = b.st[1];
        if (nloc == 0u) { xcd_barrier_complete(bar, b.x, nloc, nx); b.st[0] = nloc; b.st[1] = nx; }
        const unsigned old = xb_add(&bar[XB_XSUB(b.x)], 1u);
        const unsigned gen = old / nloc;
        if (old + 1u == (gen + 1u) * nloc) {
            __builtin_amdgcn_fence(__ATOMIC_RELEASE, "agent");
            asm volatile("s_waitcnt vmcnt(0)" ::: "memory");
            const unsigned og = xb_add(&bar[XB_TOP], 1u);
            const unsigned tg = og / nx;
            if (og + 1u == (tg + 1u) * nx) xb_add(&bar[XB_TOPGEN], 1u);
            else XB_SPIN(xb_ld(&bar[XB_TOPGEN]) == tg, bar);
            __builtin_amdgcn_fence(__ATOMIC_ACQUIRE, "agent");
            xb_add(&bar[XB_XGEN(b.x)], 1u);
            asm volatile("s_waitcnt vmcnt(0)" ::: "memory");
        } else {
            XB_SPIN(xb_ld(&bar[XB_XGEN(b.x)]) == gen, bar);
            __builtin_amdgcn_fence(__ATOMIC_ACQUIRE, "agent");
            asm volatile("s_waitcnt vmcnt(0)" ::: "memory");
        }
    }
    __syncthreads();
}

__device__ __forceinline__ unsigned xk_(unsigned row) { return (row & 3u) | (((row >> 3) & 3u) << 2); }
constexpr int ATT_RING = 147456;
constexpr int DIL_V_OFF = 69632;

struct NaFix { int c, r, start, kc0; const LAS float* rpb;
    __device__ __forceinline__ float operator()(float s, int ks, int idx, int q) const {
        const int kcol = kc0 + idx, qcol = 16 * c + q; int qcs = qcol - 8; qcs = qcs < 0 ? 0 : (qcs > 48 ? 48 : qcs);
        int dc = kcol - qcol + 15; dc = dc < 0 ? 0 : (dc > 30 ? 30 : dc);
        const float bias = rpb[(start + ks - r + 7) * 31 + dc];
        return (kcol >= qcs && kcol < qcs + 16) ? s * ATT_SCALE + bias : -INFINITY; } };
struct DilFix { int pq0, L; float slope_d;
    __device__ __forceinline__ float operator()(float s, int ks, int idx, int q) const {
        const int rel = -64 + 32 * ks + idx - q, pk = pq0 - 64 + 32 * ks + idx; const int ar = rel < 0 ? -rel : rel;
        return (ar <= 64 && pk >= 0 && pk < L) ? s * ATT_SCALE - slope_d * (float)ar : -INFINITY; } };

template <int NKS, int KSTRIDE>
__device__ __forceinline__ void att_qk(const LAS unsigned char* kimg, int kbase, const bf16* qrow, int lane, f32x4 (&s)[NKS][2]) {
    const int q = lane & 15, g = lane >> 4;
    bf16x8 qf[4];
#pragma unroll
    for (int dk = 0; dk < 4; ++dk) qf[dk] = *(const bf16x8*)(qrow + 8 * g + 32 * dk);
    const unsigned row0 = (unsigned)(kbase + 8 * (q >> 2) + (q & 3));
    const unsigned b0 = 256u * row0 + 16u * ((unsigned)g ^ xk_(row0));
#pragma unroll
    for (int ks = 0; ks < NKS; ++ks)
#pragma unroll
        for (int blk = 0; blk < 2; ++blk) {
            const unsigned b = b0 + 256u * (unsigned)(ks * KSTRIDE + 4 * blk);
            f32x4 acc = {0.f, 0.f, 0.f, 0.f};
#pragma unroll
            for (int dk = 0; dk < 4; ++dk) { const bf16x8 kf = *(const LAS bf16x8*)(kimg + (b ^ (64u * dk))); acc = __builtin_amdgcn_mfma_f32_16x16x32_bf16(kf, qf[dk], acc, 0, 0, 0); }
            s[ks][blk] = acc;
        }
}
template <int NKS, class FIX>
__device__ __forceinline__ void att_softmax(const FIX& fix, int lane, f32x4 (&s)[NKS][2], u32x4 (&pw)[NKS], float& lse) {
    const int q = lane & 15, g = lane >> 4;
    float mx = -INFINITY;
#pragma unroll
    for (int ks = 0; ks < NKS; ++ks)
#pragma unroll
        for (int blk = 0; blk < 2; ++blk)
#pragma unroll
            for (int r = 0; r < 4; ++r) { const float v = fix(s[ks][blk][r], ks, 8 * g + 4 * blk + r, q); s[ks][blk][r] = v; mx = fmaxf(mx, v); }
    mx = fmaxf(mx, __shfl_xor(mx, 16)); mx = fmaxf(mx, __shfl_xor(mx, 32));
    float sum = 0.f;
#pragma unroll
    for (int ks = 0; ks < NKS; ++ks)
#pragma unroll
        for (int blk = 0; blk < 2; ++blk)
#pragma unroll
            for (int r = 0; r < 4; ++r) { const float p = __builtin_amdgcn_exp2f((s[ks][blk][r] - mx) * 1.4426950408889634f); s[ks][blk][r] = p; sum += p; }
    sum += __shfl_xor(sum, 16); sum += __shfl_xor(sum, 32);
    lse = mx + __logf(sum);
    const float inv = 1.0f / sum;
#pragma unroll
    for (int ks = 0; ks < NKS; ++ks) { pw[ks].x = pk2(s[ks][0][0] * inv, s[ks][0][1] * inv); pw[ks].y = pk2(s[ks][0][2] * inv, s[ks][0][3] * inv); pw[ks].z = pk2(s[ks][1][0] * inv, s[ks][1][1] * inv); pw[ks].w = pk2(s[ks][1][2] * inv, s[ks][1][3] * inv);
        asm volatile("" : "+v"(pw[ks].x), "+v"(pw[ks].y), "+v"(pw[ks].z), "+v"(pw[ks].w)); }
}
template <int NKS, int KSTRIDE>
__device__ __forceinline__ void att_pv(const LAS unsigned char* vimg, int vbase, int lane, const u32x4 (&pw)[NKS], f32x4 (&o)[8]) {
    const unsigned g = lane >> 4, qq = (lane & 15) >> 2, p = lane & 3;
    unsigned tra[2];
#pragma unroll
    for (int t = 0; t < 2; ++t) { const unsigned row = (unsigned)vbase + 8u * g + 4u * t + qq; tra[t] = 256u * row + 16u * (xv_(row) ^ (p >> 1)) + 8u * (p & 1); }
#pragma unroll
    for (int c = 0; c < 8; ++c) o[c] = (f32x4){0.f, 0.f, 0.f, 0.f};
#pragma unroll
    for (int ks = 0; ks < NKS; ++ks) {
        const bf16x8 pf = __builtin_bit_cast(bf16x8, pw[ks]);
#pragma unroll
        for (int c = 0; c < 8; ++c) {
            const s16x4 t0 = __builtin_amdgcn_ds_read_tr16_b64_v4i16((LAS s16x4*)(vimg + ((tra[0] + 256u * (unsigned)(ks * KSTRIDE)) ^ (32u * c))));
            const s16x4 t1 = __builtin_amdgcn_ds_read_tr16_b64_v4i16((LAS s16x4*)(vimg + ((tra[1] + 256u * (unsigned)(ks * KSTRIDE)) ^ (32u * c))));
            const bf16x8 vf = __builtin_shufflevector(t0, t1, 0, 1, 2, 3, 4, 5, 6, 7);
            o[c] = __builtin_amdgcn_mfma_f32_16x16x32_bf16(vf, pf, o[c], 0, 0, 0);
        }
    }
}
#define ATT_GLDS(src_, dst_) __builtin_amdgcn_global_load_lds((const unsigned*)(src_), (LAS unsigned*)(dst_), 16, 0, 0)
__device__ __forceinline__ void p2_attention(const Args& a, LAS unsigned char* lds, int wave, int lane) {
    unsigned char* ws = a.ws; const bf16* z = (const bf16*)(ws + WS_Z);
    LAS float* rpb = (LAS float*)(lds + RPB_OFF);
    for (int i = threadIdx.x; i < NA_HEADS * 465; i += NTHREADS) rpb[i] = a.in[IN_RPB][i];
    __syncthreads();
    const int G = gridDim.x, bx = blockIdx.x, vcu = (G % 8 == 0) ? (bx % 8) * (G / 8) + bx / 8 : bx;
    constexpr int N_NA = BATCH * NA_HEADS * (GRID_ROWS / 2), N_DIL = DIL_HEADS * BATCH * 64;
    for (int it = vcu; it < N_NA + N_DIL; it += G) {
        asm volatile("" : "+v"(lane));
        const int q = lane & 15, g = lane >> 4, vrow = lane >> 4, slot = lane & 15;
        f32x4 o[8]; float lse;
        if (it < N_NA) {
            const int rp = it & 63, h = (it >> 6) & 7, b = it >> 9, r0 = 2 * rp;
            int st0 = r0 - 4; st0 = st0 < 0 ? 0 : (st0 > GRID_ROWS - 8 ? GRID_ROWS - 8 : st0);
            const bf16* zb = z + (size_t)b * SEQ * DIN;
            const int c = wave & 3, r = r0 + (wave >> 2); int st = r - 4; st = st < 0 ? 0 : (st > GRID_ROWS - 8 ? GRID_ROWS - 8 : st);
            int kc = 16 * c - 8; kc = kc < 0 ? 0 : (kc > 32 ? 32 : kc);
            const int base = (st - st0) * 64 + kc;
#pragma unroll 2
            for (int pc = wave; pc < 144; pc += 8) { const unsigned row = 4u * pc + vrow; int kr = st0 + (int)(row >> 6); kr = kr > GRID_ROWS - 1 ? GRID_ROWS - 1 : kr;
                ATT_GLDS(zb + (size_t)(kr * GRID_W + (int)(row & 63)) * DIN + OFF_KA + h * 128 + 8 * (slot ^ xk_(row)), lds + pc * 1024); }
            const bf16* qrow = zb + (size_t)(r * GRID_W + 16 * c + q) * DIN + OFF_QA + h * 128;
            f32x4 s[8][2]; u32x4 pw[8];
            VM_WAIT(); __syncthreads();
            att_qk<8, 64>(lds, base, qrow, lane, s);
            __syncthreads();
#pragma unroll 2
            for (int pc = wave; pc < 144; pc += 8) { const unsigned row = 4u * pc + vrow; int kr = st0 + (int)(row >> 6); kr = kr > GRID_ROWS - 1 ? GRID_ROWS - 1 : kr;
                ATT_GLDS(zb + (size_t)(kr * GRID_W + (int)(row & 63)) * DIN + OFF_VA + h * 128 + 8 * (slot ^ xv_(row)), lds + pc * 1024); }
            NaFix fx; fx.c = c; fx.r = r; fx.start = st; fx.kc0 = kc; fx.rpb = rpb + h * 465;
            att_softmax<8>(fx, lane, s, pw, lse);
            VM_WAIT(); __syncthreads();
            att_pv<8, 64>(lds, base, lane, pw, o);
            bf16* orow = (bf16*)(ws + WS_ATT) + (size_t)(b * SEQ + r * GRID_W + 16 * c + q) * ATT_LD + 512 + h * 128 + 4 * g;
#pragma unroll
            for (int cc = 0; cc < 8; ++cc) { u32x2 w; w.x = pk2(o[cc][0], o[cc][1]); w.y = pk2(o[cc][2], o[cc][3]); *(u32x2*)(orow + 16 * cc) = w; }
            __syncthreads();
        } else {
            const int j = it - N_NA, blk = j & 63, b = (j >> 6) & 1, hd = j >> 7;
            const int grp = hd >> 2, hslot = hd & 3, d = grp == 0 ? 1 : (grp == 1 ? 4 : 16), L = SEQ / d, nb = L / 128, res = blk / nb, n = blk % nb;
            const bf16* zb = z + (size_t)b * SEQ * DIN;
            const int p0 = n * 128 - 64;
#pragma unroll 2
            for (int pc = wave; pc < 68; pc += 8) { const unsigned row = 4u * pc + vrow; int p = p0 + (int)row; p = p < 0 ? 0 : (p > L - 1 ? L - 1 : p);
                ATT_GLDS(zb + (size_t)(p * d + res) * DIN + OFF_KB + hd * 128 + 8 * (slot ^ xk_(row)), lds + pc * 1024); }
#pragma unroll 2
            for (int pc = wave; pc < 68; pc += 8) { const unsigned row = 4u * pc + vrow; int p = p0 + (int)row; p = p < 0 ? 0 : (p > L - 1 ? L - 1 : p);
                ATT_GLDS(zb + (size_t)(p * d + res) * DIN + OFF_VB + hd * 128 + 8 * (slot ^ xv_(row)), lds + DIL_V_OFF + pc * 1024); }
            const int pq0 = n * 128 + 16 * wave;
            const bf16* qrow = zb + (size_t)((pq0 + q) * d + res) * DIN + OFF_QB + hd * 128;
            f32x4 s[5][2]; u32x4 pw[5];
            VM_WAIT(); __syncthreads();
            att_qk<5, 32>(lds, 16 * wave, qrow, lane, s);
            DilFix fx; fx.pq0 = pq0; fx.L = L; fx.slope_d = exp2f(-8.0f * (float)(hd + 1) / 12.0f) * (float)d;
            att_softmax<5>(fx, lane, s, pw, lse);
            att_pv<5, 32>(lds + DIL_V_OFF, 16 * wave, lane, pw, o);
            const size_t row = (size_t)b * SEQ + (size_t)(pq0 + q) * d + res;
            bf16* orow = (bf16*)(ws + WS_DILG) + ((size_t)grp * MTOK + row) * 512 + hslot * 128 + 4 * g;
#pragma unroll
            for (int cc = 0; cc < 8; ++cc) { u32x2 w; w.x = pk2(o[cc][0], o[cc][1]); w.y = pk2(o[cc][2], o[cc][3]); *(u32x2*)(orow + 16 * cc) = w; }
            if (g == 0) ((float*)(ws + WS_LSE))[((size_t)grp * MTOK + row) * 4 + hslot] = lse;
            __syncthreads();
        }
    }
}
__device__ __forceinline__ void p3_combine(const Args& a, int gtid, int NT) {
    unsigned char* ws = a.ws; const float* lse = (const float*)(ws + WS_LSE); const bf16* og = (const bf16*)(ws + WS_DILG); bf16* out = (bf16*)(ws + WS_ATT);
    for (int i = gtid; i < MTOK * 64; i += NT) {
        const int row = i >> 6, ch = i & 63, slot = ch >> 4;
        const float l0 = lse[((size_t)0 * MTOK + row) * 4 + slot], l1 = lse[((size_t)1 * MTOK + row) * 4 + slot], l2 = lse[((size_t)2 * MTOK + row) * 4 + slot];
        const float mx = fmaxf(l0, fmaxf(l1, l2)); float w0 = __expf(l0 - mx), w1 = __expf(l1 - mx), w2 = __expf(l2 - mx); const float inv = 1.0f / (w0 + w1 + w2); w0 *= inv; w1 *= inv; w2 *= inv;
        const u32x4 a0 = *(const u32x4*)(og + ((size_t)0 * MTOK + row) * 512 + 8 * ch), a1 = *(const u32x4*)(og + ((size_t)1 * MTOK + row) * 512 + 8 * ch), a2 = *(const u32x4*)(og + ((size_t)2 * MTOK + row) * 512 + 8 * ch);
        u32x4 r;
        r.x = pk2(w0 * bfl(a0.x) + w1 * bfl(a1.x) + w2 * bfl(a2.x), w0 * bfh(a0.x) + w1 * bfh(a1.x) + w2 * bfh(a2.x));
        r.y = pk2(w0 * bfl(a0.y) + w1 * bfl(a1.y) + w2 * bfl(a2.y), w0 * bfh(a0.y) + w1 * bfh(a1.y) + w2 * bfh(a2.y));
        r.z = pk2(w0 * bfl(a0.z) + w1 * bfl(a1.z) + w2 * bfl(a2.z), w0 * bfh(a0.z) + w1 * bfh(a1.z) + w2 * bfh(a2.z));
        r.w = pk2(w0 * bfl(a0.w) + w1 * bfl(a1.w) + w2 * bfl(a2.w), w0 * bfh(a0.w) + w1 * bfh(a1.w) + w2 * bfh(a2.w));
        *(u32x4*)(out + (size_t)row * ATT_LD + 8 * ch) = r;
    }
}

__device__ __forceinline__ void p6_ln1_router(const Args& a, LAS unsigned char* lds, int wave, int lane, bool do_route = true) {
    unsigned char* ws = a.ws; const float* Y = a.out; bf16* HI = (bf16*)(ws + WS_ACT); bf16* LO = (bf16*)(ws + WS_LO); float* st = (float*)(ws + WS_STATS1);
    const bf16* WH = (const bf16*)(ws + WS_WRH); const bf16* WL = (const bf16*)(ws + WS_WRL);
    LAS float* P = (LAS float*)lds;
    LAS float* BIAS = P + 64 * NRW;
    const float* g1 = a.in[IN_LN1G]; const float* b1 = a.in[IN_LN1B];
    for (int rg = blockIdx.x; rg < MTOK / 64; rg += gridDim.x) {
        if (threadIdx.x < 8) BIAS[threadIdx.x] = a.in[IN_BRG][threadIdx.x]; else if (threadIdx.x < 72) BIAS[threadIdx.x] = a.in[IN_BRE][threadIdx.x - 8];
#pragma unroll 1
        for (int i4 = 0; i4 < 2; ++i4) {
            const int m0 = rg * 64 + wave * 8 + i4 * 4;
            f32x4 v[4][8]; float s[4];
#pragma unroll
            for (int r = 0; r < 4; ++r) { const float* yr = Y + (size_t)(m0 + r) * DM + 4 * lane;
#pragma unroll
                for (int j = 0; j < 8; ++j) v[r][j] = *(const f32x4*)(yr + 256 * j); }
#pragma unroll
            for (int r = 0; r < 4; ++r) { s[r] = 0.f;
#pragma unroll
                for (int j = 0; j < 8; ++j) s[r] += (v[r][j].x + v[r][j].y) + (v[r][j].z + v[r][j].w); }
#pragma unroll
            for (int o = 1; o < 64; o <<= 1) {
#pragma unroll
                for (int r = 0; r < 4; ++r) s[r] += __shfl_xor(s[r], o); }
            float mean[4], s2[4];
#pragma unroll
            for (int r = 0; r < 4; ++r) { mean[r] = s[r] * (1.f / DM); s2[r] = 0.f;
#pragma unroll
                for (int j = 0; j < 8; ++j) { v[r][j] = v[r][j] - mean[r]; s2[r] += (v[r][j].x * v[r][j].x + v[r][j].y * v[r][j].y) + (v[r][j].z * v[r][j].z + v[r][j].w * v[r][j].w); } }
#pragma unroll
            for (int o = 1; o < 64; o <<= 1) {
#pragma unroll
                for (int r = 0; r < 4; ++r) s2[r] += __shfl_xor(s2[r], o); }
#pragma unroll
            for (int r = 0; r < 4; ++r) { const int m = m0 + r; const float rstd = 1.0f / sqrtf(s2[r] * (1.f / DM) + LN_EPS);
                if (lane == 0) { st[2 * m] = mean[r]; st[2 * m + 1] = rstd; }
                bf16* hrow = HI + (size_t)m * DM + 4 * lane; bf16* lrow = LO + (size_t)m * DM + 4 * lane;
#pragma unroll
                for (int j = 0; j < 8; ++j) { const f32x4 gv = *(const f32x4*)(g1 + 256 * j + 4 * lane), bv = *(const f32x4*)(b1 + 256 * j + 4 * lane); const f32x4 y = v[r][j] * rstd * gv + bv;
                    u32x2 h; h.x = pk2(y.x, y.y); h.y = pk2(y.z, y.w);
                    u32x2 l; l.x = pk2(y.x - bfl(h.x), y.y - bfh(h.x)); l.y = pk2(y.z - bfl(h.y), y.w - bfh(h.y));
                    *(u32x2*)(hrow + 256 * j) = h; *(u32x2*)(lrow + 256 * j) = l; } }
        }
        VM_WAIT(); __syncthreads();
        {
            const int fr = lane & 15, fq = lane >> 4;
            const size_t aoff = (size_t)(rg * 64 + fr) * DM + wave * 256 + 8 * fq, boff = (size_t)fr * DM + wave * 256 + 8 * fq;
            f32x4 acc[4][5];
#pragma unroll
            for (int rb = 0; rb < 4; ++rb)
#pragma unroll
                for (int cb = 0; cb < 5; ++cb) acc[rb][cb] = (f32x4){0.f, 0.f, 0.f, 0.f};
#pragma unroll 2
            for (int s = 0; s < 8; ++s) {
                bf16x8 bh[5], bl[5];
#pragma unroll
                for (int cb = 0; cb < 5; ++cb) { bh[cb] = *(const bf16x8*)(WH + boff + (size_t)(16 * cb) * DM + 32 * s); bl[cb] = *(const bf16x8*)(WL + boff + (size_t)(16 * cb) * DM + 32 * s); }
#pragma unroll
                for (int rb = 0; rb < 4; ++rb) { const bf16x8 ah = *(const bf16x8*)(HI + aoff + (size_t)(16 * rb) * DM + 32 * s), al = *(const bf16x8*)(LO + aoff + (size_t)(16 * rb) * DM + 32 * s);
#pragma unroll
                    for (int cb = 0; cb < 5; ++cb) {
                        acc[rb][cb] = __builtin_amdgcn_mfma_f32_16x16x32_bf16(ah, bh[cb], acc[rb][cb], 0, 0, 0);
                        acc[rb][cb] = __builtin_amdgcn_mfma_f32_16x16x32_bf16(ah, bl[cb], acc[rb][cb], 0, 0, 0);
                        acc[rb][cb] = __builtin_amdgcn_mfma_f32_16x16x32_bf16(al, bh[cb], acc[rb][cb], 0, 0, 0); } }
            }
            LAS float* T = P + (wave >> 2) * (64 * NRW + 128);
#pragma unroll 1
            for (int k = 0; k < 4; ++k) {
                if ((wave & 3) == k) {
#pragma unroll
                    for (int rb = 0; rb < 4; ++rb)
#pragma unroll
                        for (int cb = 0; cb < 5; ++cb)
#pragma unroll
                            for (int r = 0; r < 4; ++r) { LAS float* p = &T[(16 * rb + 4 * fq + r) * NRW + 16 * cb + fr]; *p = (k == 0 ? 0.f : *p) + acc[rb][cb][r]; }
                }
                __syncthreads();
            }
        }
        if (threadIdx.x < 64 && do_route) {
            const int t = threadIdx.x, m = rg * 64 + t; const LAS float* p0 = P + (size_t)t * NRW; const LAS float* p1 = p0 + (64 * NRW + 128);
            float gl[8]; int gs = 0; float gm = -INFINITY;
#pragma unroll
            for (int n = 0; n < 8; ++n) { gl[n] = p0[n] + p1[n] + BIAS[n]; if (gl[n] > gm) { gm = gl[n]; gs = n; } }
            float gsum = 0.f;
#pragma unroll
            for (int n = 0; n < 8; ++n) gsum += __expf(gl[n] - gm);
            const float gprob = 1.0f / gsum;
            float v0 = -INFINITY, v1 = -INFINITY; int i0 = 0, i1 = 0;
#pragma unroll
            for (int n = 0; n < 8; ++n) { const float ev = p0[8 + gs * 8 + n] + p1[8 + gs * 8 + n] + BIAS[8 + gs * 8 + n];
                if (ev > v0) { v1 = v0; i1 = i0; v0 = ev; i0 = n; } else if (ev > v1) { v1 = ev; i1 = n; } }
            const float e1 = __expf(v1 - v0), w0 = gprob / (1.0f + e1), w1 = gprob * e1 / (1.0f + e1);
            const int x0 = gs * 8 + i0, x1 = gs * 8 + i1;
            unsigned* cnt = (unsigned*)(ws + WS_CTL);
            const unsigned q0 = atomicAdd(cnt + x0, 1u), q1 = atomicAdd(cnt + x1, 1u);
            int* te = (int*)(ws + WS_TOKE); float* tw = (float*)(ws + WS_TOKW); int* tp = (int*)(ws + WS_TOKP);
            te[2 * m] = x0; te[2 * m + 1] = x1; tw[2 * m] = w0; tw[2 * m + 1] = w1; tp[2 * m] = (int)q0; tp[2 * m + 1] = (int)q1;
        }
        __syncthreads();
    }
}
__device__ __forceinline__ void p7_permute(const Args& a, LAS unsigned char* lds, int gw, int NGW, int lane) {
    unsigned char* ws = a.ws; const unsigned* cnt = (const unsigned*)(ws + WS_CTL);
    LAS int* pstart = (LAS int*)lds; LAS int* pcnt = pstart + 64; LAS int* rcnt = pstart + 128;
    int* tile = (int*)(ws + WS_TILE);
    if (threadIdx.x < NEXP) rcnt[threadIdx.x] = (int)cnt[threadIdx.x];
    __syncthreads();
    if (threadIdx.x == 0) {
        int pos = 0, nt = 0;
        for (int e = 0; e < NEXP; ++e) { const int c = rcnt[e], pc = (c + 255) & ~255; pstart[e] = pos; pcnt[e] = pc;
            if (blockIdx.x == 0) for (int j = 0; j < pc / 256; ++j) tile[1 + nt + j] = e;
            nt += pc / 256; pos += pc; }
        if (blockIdx.x == 0) tile[0] = nt;
    }
    __syncthreads();
    const bf16* H = (const bf16*)(ws + WS_ACT); bf16* XS = (bf16*)(ws + WS_XS);
    const int* te = (const int*)(ws + WS_TOKE); const int* tp = (const int*)(ws + WS_TOKP); int* ts = (int*)(ws + WS_TOKS);
    for (int m = gw; m < MTOK; m += NGW) {
        const u32x4* src = (const u32x4*)(H + (size_t)m * DM) + lane; u32x4 v[4];
#pragma unroll
        for (int j = 0; j < 4; ++j) v[j] = src[64 * j];
#pragma unroll
        for (int k = 0; k < 2; ++k) { const int slot = pstart[te[2 * m + k]] + tp[2 * m + k]; if (lane == 0) ts[2 * m + k] = slot;
            u32x4* dst = (u32x4*)(XS + (size_t)slot * DM) + lane;
#pragma unroll
            for (int j = 0; j < 4; ++j) dst[64 * j] = v[j]; }
    }
    { const int e = gw & 63; const int base = pstart[e] + rcnt[e], npad = pcnt[e] - rcnt[e];
      for (int j = gw >> 6; j < npad; j += (NGW >> 6)) { u32x4* dst = (u32x4*)(XS + (size_t)(base + j) * DM) + lane;
#pragma unroll
          for (int q = 0; q < 4; ++q) dst[64 * q] = (u32x4){0u, 0u, 0u, 0u}; } }
}
__device__ __forceinline__ void p10_final(const Args& a, int gw, int NGW, int lane, float* dstbase) {
    unsigned char* ws = a.ws; float* Y = a.out; const float* st = (const float*)(ws + WS_STATS1); const bf16* YS = (const bf16*)(ws + WS_YS);
    const int* ts = (const int*)(ws + WS_TOKS); const float* tw = (const float*)(ws + WS_TOKW);
    const float* g1 = a.in[IN_LN1G]; const float* b1 = a.in[IN_LN1B]; const float* g2 = a.in[IN_LN2G]; const float* b2 = a.in[IN_LN2B];
    for (int m = gw; m < MTOK; m += NGW) {
        float* yr = Y + (size_t)m * DM + 4 * lane; const float mu = st[2 * m], rs = st[2 * m + 1];
        const int s0 = ts[2 * m], s1 = ts[2 * m + 1]; const float w0 = tw[2 * m], w1 = tw[2 * m + 1];
        const bf16* e0 = YS + (size_t)s0 * DM + 4 * lane; const bf16* e1 = YS + (size_t)s1 * DM + 4 * lane;
        f32x4 v[8]; float s = 0.f;
#pragma unroll
        for (int j = 0; j < 8; ++j) { const f32x4 y = *(const f32x4*)(yr + 256 * j); const f32x4 gv = *(const f32x4*)(g1 + 256 * j + 4 * lane), bv = *(const f32x4*)(b1 + 256 * j + 4 * lane);
            const u32x2 c0 = *(const u32x2*)(e0 + 256 * j), c1 = *(const u32x2*)(e1 + 256 * j);
            f32x4 f; f.x = w0 * bfl(c0.x) + w1 * bfl(c1.x); f.y = w0 * bfh(c0.x) + w1 * bfh(c1.x); f.z = w0 * bfl(c0.y) + w1 * bfl(c1.y); f.w = w0 * bfh(c0.y) + w1 * bfh(c1.y);
            v[j] = ((y - mu) * rs * gv + bv) * DN_ALPHA + f; s += (v[j].x + v[j].y) + (v[j].z + v[j].w); }
        const float mean = wave_sum(s) * (1.f / DM); float s2 = 0.f;
#pragma unroll
        for (int j = 0; j < 8; ++j) { v[j] = v[j] - mean; s2 += (v[j].x * v[j].x + v[j].y * v[j].y) + (v[j].z * v[j].z + v[j].w * v[j].w); }
        const float rstd = 1.0f / sqrtf(wave_sum(s2) * (1.f / DM) + LN_EPS);
#pragma unroll
        for (int j = 0; j < 8; ++j) { const f32x4 gv = *(const f32x4*)(g2 + 256 * j + 4 * lane), bv = *(const f32x4*)(b2 + 256 * j + 4 * lane); *(f32x4*)(dstbase + (size_t)m * DM + 4 * lane + 256 * j) = v[j] * rstd * gv + bv; }
    }
}

__device__ __forceinline__ int fresh_lane() { int l = (int)(threadIdx.x & 63u); asm volatile("" : "+v"(l)); return l; }
constexpr int N_PHASES = 11;
#ifndef HELPER_ROWS
#define HELPER_ROWS 1
#endif
__global__ void __launch_bounds__(NTHREADS, 2) mk_fwd(Args args) {
    extern __shared__ __attribute__((aligned(16))) unsigned char lds_raw[];
    LAS unsigned char* lds = (LAS unsigned char*)lds_raw;
    const int tid = threadIdx.x, wave = __builtin_amdgcn_readfirstlane(tid >> 6);
#define lane fresh_lane()
    const int G = gridDim.x, gw = blockIdx.x * NWAVES + wave, NGW = G * NWAVES;
    unsigned char* ws = args.ws;
    const int lo = args.ph_lo, hi = args.ph_hi;
#ifndef PHASE_MASK
#define PHASE_MASK 0x7ff
#endif
#define IN(k) (((PHASE_MASK >> (k)) & 1) && lo <= (k) && (k) < hi)
#ifndef DOUBLE_PHASE
#define DOUBLE_PHASE 0
#endif
#define REP(k) for (int rep_ = 0; rep_ < (((DOUBLE_PHASE >> (k)) & 1) ? 2 : 1); ++rep_)
#if MK_N_LAUNCHES == 1
    cg::grid_group grid = cg::this_grid();
    { volatile LAS unsigned* st = (volatile LAS unsigned*)(lds + XB_LDS_OFF); if (tid < 2) st[tid] = 0u; }
    __syncthreads();
    const XcdBarrier bar = xcd_barrier_post((unsigned*)(ws + WS_BAR), (volatile LAS unsigned*)(lds + XB_LDS_OFF));
#define SEAM(k) do { if (IN(k) && IN((k) + 1)) { if (CG_SEAM_MASK >> (k) & 1) grid.sync(); else xcd_barrier(bar); } } while (0)
#else
#define SEAM(k) do { } while (0)
#endif
    if (IN(0)) REP(0) p0_prologue(args, lds, gw, NGW, wave, lane);
    SEAM(0);
    if (IN(1)) REP(1) { pg8::Gemm g{(const bf16*)(ws + WS_ACT), (const bf16*)(ws + WS_WIN), MTOK, DIN, DM}; pg8::StaticOrder S; S.init(MTOK, DIN, G, (int)blockIdx.x);
        pg8::EpiZ E{(bf16*)(ws + WS_Z), DIN, args.in[IN_BIN], OFF_GA / 256};
        pg8::gemm_phase<pg8::EpiZ, pg8::StaticOrder, true, true>(lds, g, S, E); }
    SEAM(1);
    if (IN(2)) REP(2) p2_attention(args, lds, wave, lane);
    SEAM(2);
    if (IN(3)) REP(3) p3_combine(args, blockIdx.x * NTHREADS + tid, G * NTHREADS);
    SEAM(3);
    if (IN(4)) REP(4) { pg8::Gemm g{(const bf16*)(ws + WS_ATT), (const bf16*)(ws + WS_WAB), MTOK, DM, ATT_LD}; pg8::StaticOrder S; S.init(MTOK, DM, G, (int)blockIdx.x);
        pg8::EpiMix E{(bf16*)(ws + WS_ACT), (const bf16*)(ws + WS_Z) + OFF_GA, (const bf16*)(ws + WS_Z) + OFF_GB, DIN};
        pg8::gemm_phase<pg8::EpiMix, pg8::StaticOrder, true, true>(lds, g, S, E); }
    SEAM(4);
    if (IN(5)) REP(5) { pg8::Gemm g{(const bf16*)(ws + WS_ACT), (const bf16*)(ws + WS_WO), MTOK, DM, DM}; pg8::StaticOrder S; S.init(MTOK, DM, G, (int)blockIdx.x);
        pg8::EpiY1 E{args.out, args.in[IN_X], (const float*)(ws + WS_STATS0), args.in[IN_LN0G], args.in[IN_LN0B], args.in[IN_BO], DN_ALPHA};
        pg8::gemm_phase<pg8::EpiY1, pg8::StaticOrder, true, true>(lds, g, S, E); }
    SEAM(5);
    if (IN(6)) REP(6) p6_ln1_router(args, lds, wave, lane, rep_ == (((DOUBLE_PHASE >> 6) & 1) ? 1 : 0));
    SEAM(6);
    if (IN(7)) REP(7) p7_permute(args, lds, gw, NGW, lane);
    SEAM(7);
    if (IN(8)) REP(8) { const int* tile = (const int*)(ws + WS_TILE);
        pg8::Gemm g{(const bf16*)(ws + WS_XS), (const bf16*)(ws + WS_WUP), PMAX, NEXP * 1024, DM}; pg8::MoeOrder S{tile + 1, tile[0], 4, G, (int)blockIdx.x};
        pg8::EpiSwiGLU E{(bf16*)(ws + WS_HID)};
        pg8::gemm_phase<pg8::EpiSwiGLU, pg8::MoeOrder, true, true>(lds, g, S, E); }
    SEAM(8);
    if (IN(9)) REP(9) { const int* tile = (const int*)(ws + WS_TILE);
        pg8::Gemm g{(const bf16*)(ws + WS_HID), (const bf16*)(ws + WS_WDN), PMAX, NEXP * 2048, DEXP}; pg8::MoeOrder S{tile + 1, tile[0], 8, G, (int)blockIdx.x};
        pg8::EpiYs E{(bf16*)(ws + WS_YS), DM, 7};
        pg8::gemm_phase<pg8::EpiYs, pg8::MoeOrder, true, true>(lds, g, S, E); }
    SEAM(9);
    if (IN(10)) REP(10) p10_final(args, gw, NGW, lane, (((DOUBLE_PHASE >> 10) & 1) && rep_ == 0) ? (float*)(ws + WS_WUP) : args.out);
#undef lane
#undef IN
#undef SEAM
}

extern "C" void kernel_launch(void* const* d_in, const int* in_sizes, int n_in, void* d_out, int out_size, void* d_ws, size_t ws_size, hipStream_t stream) {
    static int grid = 0;
    if (grid == 0) {
        if (n_in != 21 || in_sizes[0] != MTOK * DM || out_size != MTOK * DM || ws_size < WS_END) { fprintf(stderr, "kernel_launch: unexpected shapes (n_in %d, in0 %d, out %d, ws %zu < %zu)\n", n_in, n_in > 0 ? in_sizes[0] : -1, out_size, ws_size, (size_t)WS_END); grid = -1; return; }
        int dev = 0, cus = 0, per_cu = 0;
        if (hipGetDevice(&dev) != hipSuccess || hipDeviceGetAttribute(&cus, hipDeviceAttributeMultiprocessorCount, dev) != hipSuccess) { fprintf(stderr, "kernel_launch: device query failed\n"); grid = -1; return; }
        if (hipFuncSetAttribute((const void*)mk_fwd, hipFuncAttributeMaxDynamicSharedMemorySize, LDS_BYTES) != hipSuccess) { fprintf(stderr, "kernel_launch: hipFuncSetAttribute failed\n"); grid = -1; return; }
        if (hipOccupancyMaxActiveBlocksPerMultiprocessor(&per_cu, (const void*)mk_fwd, NTHREADS, LDS_BYTES) != hipSuccess || per_cu < 1) { fprintf(stderr, "kernel_launch: occupancy query says %d blocks per CU\n", per_cu); (void)hipGetLastError(); per_cu = 1; }
        grid = cus * 1;
        fprintf(stderr, "kernel_launch: %d CUs, occupancy %d per CU, grid %d\n", cus, per_cu, grid);
    }
    if (grid < 0) return;
    if (hipMemsetAsync((char*)d_ws + WS_CTL, 0, CTL_ZERO_BYTES, stream) != hipSuccess) { fprintf(stderr, "kernel_launch: memset failed\n"); return; }
    Args a{};
    for (int i = 0; i < 21; ++i) a.in[i] = (const float*)d_in[i];
    a.out = (float*)d_out; a.ws = (unsigned char*)d_ws;
#if MK_N_LAUNCHES == 1
    a.ph_lo = 0; a.ph_hi = N_PHASES;
    void* kargs[] = {&a};
    hipError_t e = hipLaunchCooperativeKernel((const void*)mk_fwd, dim3(grid), dim3(NTHREADS), kargs, LDS_BYTES, stream);
    if (e != hipSuccess) fprintf(stderr, "kernel_launch: cooperative launch failed: %s (grid %d)\n", hipGetErrorString(e), grid);
#else
    for (int p = 0; p < N_PHASES; ++p) { a.ph_lo = p; a.ph_hi = p + 1; hipLaunchKernelGGL(mk_fwd, dim3(grid), dim3(NTHREADS), LDS_BYTES, stream, a);
        const hipError_t le = hipPeekAtLastError(); if (le != hipSuccess) { fprintf(stderr, "kernel_launch: launch %d failed: %s\n", p, hipGetErrorName(le)); break; } }
#endif
}
```

```cpp
#include <hip/hip_runtime.h>
#include <hip/hip_cooperative_groups.h>
#include <cstdio>
#include <cstdint>
namespace pg8 {
#define PG8_LAS __attribute__((address_space(3)))
typedef unsigned short bf16_t;
typedef short bf16x8 __attribute__((ext_vector_type(8)));
typedef float f32x4 __attribute__((ext_vector_type(4)));
typedef unsigned u32x4 __attribute__((ext_vector_type(4)));
constexpr int BM = 256, BK = 64, HALF = 128, HTB = HALF * BK * 2  , STAGE_BYTES = 8 * HTB, NXCD = 8, WGM = 8;

__host__ __device__ __forceinline__ int lds_byte(int r, int c) { const int st = (r >> 4) * 2 + (c >> 5), rr = r & 15, cc = c & 31, ob = rr * 64 + cc * 2; return st * 1024 + (ob ^ (((ob >> 9) & 1) << 5)); }
__host__ __device__ __forceinline__ void stage_rc(int b, int& R, int& C) { const int st = b / 1024, sb = b % 1024, swz = sb ^ (((sb >> 9) & 1) << 5); R = (st >> 1) * 16 + swz / 64; C = (st & 1) * 32 + (swz % 64) / 2; }
__host__ __device__ __forceinline__ int perm32(int rho) { const int n = rho >> 4, i = rho & 15; return 8 * (i >> 2) + 4 * n + (i & 3); }

struct Unit { int pm, pn; };
struct Gemm { const bf16_t* A; const bf16_t* Bt; int M, N, K; };

struct StaticOrder {
    int nM, nN, nwg, G, c;
    __host__ __device__ void init(int M, int N, int G_, int c_) { nM = M / BM; nN = N / BM; nwg = nM * nN; G = G_; c = c_; }
    __host__ __device__ bool next(int i, Unit& u) const {
        const long L = (long)i * G + c; if (L >= nwg) return false;
        int wgid = (int)L; { const int q = nwg / NXCD, r = nwg % NXCD, xcd = wgid % NXCD, off = wgid / NXCD; wgid = (xcd < r ? xcd * (q + 1) : r * (q + 1) + (xcd - r) * q) + off; }
        const int nig = WGM * nN, gid = wgid / nig, fm = gid * WGM, gsz = (nM - fm) < WGM ? (nM - fm) : WGM;
        u.pm = fm + ((wgid % nig) % gsz); u.pn = (wgid % nig) / gsz; return true;
    }
    static constexpr bool GATHER_A = false;
    __device__ __forceinline__ void gather(const Unit&, int, int, unsigned (&)[2][2]) const {}
    __device__ __forceinline__ void a_ready(const Unit&) const {}
    __device__ __forceinline__ void done(const Unit&) const {}
};
__device__ __forceinline__ unsigned cvt_pk_bf16(float lo, float hi) { unsigned r; asm volatile("v_cvt_pk_bf16_f32 %0, %1, %2" : "=v"(r) : "v"(lo), "v"(hi)); return r; }
typedef float f32x2 __attribute__((ext_vector_type(2)));
__device__ __forceinline__ float sigm(float x) { return __builtin_amdgcn_rcpf(1.0f + __builtin_amdgcn_exp2f(-1.4426950408889634f * x)); }
__device__ __forceinline__ float bf_lo(unsigned w) { return __uint_as_float(w << 16); }
__device__ __forceinline__ float bf_hi(unsigned w) { return __uint_as_float(w & 0xffff0000u); }
struct EpiZ {
    static constexpr bool PERM = true, AFTER_DRAIN = false; static constexpr int MID_T = 0;
    bf16_t* O; int ldc; const float* bias; int sig_pn;
    __device__ __forceinline__ void operator()(const f32x4 (&acc)[2][2][4][2], const Unit& u, int wr, int wc, int fr, int fq) const {
        const int row0 = u.pm * BM + wr * 64 + fr, col0 = u.pn * BM + wc * 32 + 8 * fq; const bool sg = u.pn >= sig_pn;
        f32x4 bv[2][2];
#pragma unroll
        for (int bj = 0; bj < 2; ++bj)
#pragma unroll
            for (int n = 0; n < 2; ++n) bv[bj][n] = *(const f32x4*)(bias + col0 + bj * HALF + 4 * n);
#pragma unroll
        for (int ai = 0; ai < 2; ++ai)
#pragma unroll
            for (int m = 0; m < 4; ++m) { bf16_t* rowp = O + (size_t)(row0 + ai * HALF + m * 16) * ldc + col0;
#pragma unroll
                for (int bj = 0; bj < 2; ++bj) { f32x4 v0 = acc[ai][bj][m][0] + bv[bj][0], v1 = acc[ai][bj][m][1] + bv[bj][1];
                    if (sg) {
#pragma unroll
                        for (int j = 0; j < 4; ++j) { v0[j] = sigm(v0[j]); v1[j] = sigm(v1[j]); } }
                    u32x4 w; w.x = cvt_pk_bf16(v0[0], v0[1]); w.y = cvt_pk_bf16(v0[2], v0[3]); w.z = cvt_pk_bf16(v1[0], v1[1]); w.w = cvt_pk_bf16(v1[2], v1[3]);
                    *(u32x4*)(rowp + bj * HALF) = w; } }
    }
};
struct EpiMix {
    static constexpr bool PERM = true, AFTER_DRAIN = false; static constexpr int MID_T = 8;
    bf16_t* O; const bf16_t* ga; const bf16_t* gb; int ldg;
    __device__ __forceinline__ void mid(f32x4 (&acc)[2][2][4][2], const Unit& u, int wr, int wc, int fr, int fq) const {
        int row0 = u.pm * BM + wr * 64 + fr; const int col0 = u.pn * BM + wc * 32 + 8 * fq;
        asm volatile("" : "+v"(row0));
#pragma unroll
        for (int ai = 0; ai < 2; ++ai)
#pragma unroll
            for (int m = 0; m < 4; ++m) { const size_t r = (size_t)(row0 + ai * HALF + m * 16);
#pragma unroll
                for (int bj = 0; bj < 2; ++bj) {
                    const u32x4 a = *(const u32x4*)(ga + r * ldg + col0 + bj * HALF), b = *(const u32x4*)(gb + r * ldg + col0 + bj * HALF);
                    f32x4& v0 = acc[ai][bj][m][0]; f32x4& v1 = acc[ai][bj][m][1];
                    v0[0] *= bf_lo(b.x) * __builtin_amdgcn_rcpf(bf_lo(a.x)); v0[1] *= bf_hi(b.x) * __builtin_amdgcn_rcpf(bf_hi(a.x)); v0[2] *= bf_lo(b.y) * __builtin_amdgcn_rcpf(bf_lo(a.y)); v0[3] *= bf_hi(b.y) * __builtin_amdgcn_rcpf(bf_hi(a.y));
                    v1[0] *= bf_lo(b.z) * __builtin_amdgcn_rcpf(bf_lo(a.z)); v1[1] *= bf_hi(b.z) * __builtin_amdgcn_rcpf(bf_hi(a.z)); v1[2] *= bf_lo(b.w) * __builtin_amdgcn_rcpf(bf_lo(a.w)); v1[3] *= bf_hi(b.w) * __builtin_amdgcn_rcpf(bf_hi(a.w)); }
                asm volatile("" ::: "memory"); }
    }
    __device__ __forceinline__ void operator()(const f32x4 (&acc)[2][2][4][2], const Unit& u, int wr, int wc, int fr, int fq) const {
        const int row0 = u.pm * BM + wr * 64 + fr, col0 = u.pn * BM + wc * 32 + 8 * fq;
#pragma unroll
        for (int ai = 0; ai < 2; ++ai)
#pragma unroll
            for (int m = 0; m < 4; ++m) { const size_t r = (size_t)(row0 + ai * HALF + m * 16);
#pragma unroll
                for (int bj = 0; bj < 2; ++bj) {
                    const u32x4 a = *(const u32x4*)(ga + r * ldg + col0 + bj * HALF);
                    const f32x4 v0 = acc[ai][bj][m][0], v1 = acc[ai][bj][m][1];
                    u32x4 w; w.x = cvt_pk_bf16(v0[0] * bf_lo(a.x), v0[1] * bf_hi(a.x)); w.y = cvt_pk_bf16(v0[2] * bf_lo(a.y), v0[3] * bf_hi(a.y));
                    w.z = cvt_pk_bf16(v1[0] * bf_lo(a.z), v1[1] * bf_hi(a.z)); w.w = cvt_pk_bf16(v1[2] * bf_lo(a.w), v1[3] * bf_hi(a.w));
                    *(u32x4*)(O + r * 2048 + col0 + bj * HALF) = w; } }
    }
};
struct EpiY1 {
    static constexpr bool PERM = false, AFTER_DRAIN = false; static constexpr int MID_T = 0;
    float* Y; const float* X; const float* stats; const float* g0; const float* b0; const float* bo; float alpha;
    __device__ __forceinline__ void operator()(const f32x4 (&acc)[2][2][4][2], const Unit& u, int wr, int wc, int fr, int fq) const {
        const int row0 = u.pm * BM + wr * 64 + fr, col0 = u.pn * BM + wc * 32 + 4 * fq;
        f32x4 ag[2][2], cb[2][2];
#pragma unroll
        for (int bj = 0; bj < 2; ++bj)
#pragma unroll
            for (int n = 0; n < 2; ++n) { const int c = col0 + bj * HALF + n * 16; ag[bj][n] = *(const f32x4*)(g0 + c) * alpha; cb[bj][n] = *(const f32x4*)(b0 + c) * alpha + *(const f32x4*)(bo + c); }
#pragma unroll
        for (int ai = 0; ai < 2; ++ai)
#pragma unroll
            for (int m = 0; m < 4; ++m) { const size_t r = (size_t)(row0 + ai * HALF + m * 16); const float mu = stats[2 * r], rs = stats[2 * r + 1];
#pragma unroll
                for (int bj = 0; bj < 2; ++bj)
#pragma unroll
                    for (int n = 0; n < 2; ++n) { const size_t o = r * 2048 + col0 + bj * HALF + n * 16; const f32x4 xv = *(const f32x4*)(X + o);
                        *(f32x4*)(Y + o) = (xv - mu) * rs * ag[bj][n] + cb[bj][n] + acc[ai][bj][m][n]; }
                asm volatile("" ::: "memory"); }
    }
};
struct EpiSwiGLU {
    static constexpr bool PERM = true, AFTER_DRAIN = false; static constexpr int MID_T = 0;
    bf16_t* H;
    __device__ __forceinline__ void operator()(const f32x4 (&acc)[2][2][4][2], const Unit& u, int wr, int wc, int fr, int fq) const {
        const int row0 = u.pm * BM + wr * 64 + fr, col0 = (u.pn & 3) * 128 + wc * 32 + 8 * fq;
#pragma unroll
        for (int ai = 0; ai < 2; ++ai)
#pragma unroll
            for (int m = 0; m < 4; ++m) { f32x4 v0, v1;
#pragma unroll
                for (int j = 0; j < 4; ++j) { const float a = acc[ai][0][m][0][j], b = acc[ai][0][m][1][j]; v0[j] = a * sigm(a) * acc[ai][1][m][0][j]; v1[j] = b * sigm(b) * acc[ai][1][m][1][j]; }
                u32x4 w; w.x = cvt_pk_bf16(v0[0], v0[1]); w.y = cvt_pk_bf16(v0[2], v0[3]); w.z = cvt_pk_bf16(v1[0], v1[1]); w.w = cvt_pk_bf16(v1[2], v1[3]);
                *(u32x4*)(H + (size_t)(row0 + ai * HALF + m * 16) * 512 + col0) = w; }
    }
};
struct EpiYs {
    static constexpr bool PERM = true, AFTER_DRAIN = false; static constexpr int MID_T = 0;
    bf16_t* O; int ldc; int pn_mask;
    __device__ __forceinline__ void operator()(const f32x4 (&acc)[2][2][4][2], const Unit& u, int wr, int wc, int fr, int fq) const {
        const int row0 = u.pm * BM + wr * 64 + fr, col0 = (u.pn & pn_mask) * BM + wc * 32 + 8 * fq;
#pragma unroll
        for (int ai = 0; ai < 2; ++ai)
#pragma unroll
            for (int m = 0; m < 4; ++m) { bf16_t* rowp = O + (size_t)(row0 + ai * HALF + m * 16) * ldc + col0;
#pragma unroll
                for (int bj = 0; bj < 2; ++bj) { const f32x4 v0 = acc[ai][bj][m][0], v1 = acc[ai][bj][m][1];
                    u32x4 w; w.x = cvt_pk_bf16(v0[0], v0[1]); w.y = cvt_pk_bf16(v0[2], v0[3]); w.z = cvt_pk_bf16(v1[0], v1[1]); w.w = cvt_pk_bf16(v1[2], v1[3]);
                    *(u32x4*)(rowp + bj * HALF) = w; } }
    }
};
template <bool GA_, int NL2> struct MoeOrder {
    static constexpr bool GATHER_A = GA_;
    const PG8_LAS int* tab; const int* list; int G, c;
    __device__ __forceinline__ bool next(int i, Unit& u) const {
        const long L = (long)i * G + c; const int nt = __builtin_amdgcn_readfirstlane(tab[512]); if (L >= ((long)nt << NL2)) return false;
        const int j = (int)(L >> NL2), t = (int)(L & ((1 << NL2) - 1)); u.pm = j; u.pn = (__builtin_amdgcn_readfirstlane(tab[j]) << NL2) + t; return true;
    }
    __device__ __forceinline__ void gather(const Unit& u, int tid, int K, unsigned (&v)[2][2]) const {
        const int e = __builtin_amdgcn_readfirstlane(tab[u.pm]), r0 = __builtin_amdgcn_readfirstlane(tab[192 + u.pm]), n = __builtin_amdgcn_readfirstlane(tab[448 + e]);
#pragma unroll
        for (int h = 0; h < 2; ++h)
#pragma unroll
            for (int i = 0; i < 2; ++i) { int R, C; stage_rc(tid * 16 + i * 8192, R, C); const int row = r0 + 128 * h + R; const int tok = row < n ? list[(size_t)e * 16384 + row] : 0;
                v[h][i] = (unsigned)(tok * K + C) * 2u; }
    }
    __device__ __forceinline__ void a_ready(const Unit&) const {}
    __device__ __forceinline__ void done(const Unit&) const {}
};
template <class Epi, class Sched, bool ALIGN_EPI = false, bool SP2 = false>
__device__ __forceinline__ void gemm_phase(PG8_LAS unsigned char* lds, const Gemm g, const Sched& S, const Epi& E) {
    const int tid = threadIdx.x, wid = __builtin_amdgcn_readfirstlane(tid >> 6), lane = tid & 63, wr = wid >> 2, wc = wid & 3, fr = lane & 15, fq = lane >> 4;
    const int K = g.K, nt = K / BK;
    unsigned voffA[2], voffB[2];
#pragma unroll
    for (int i = 0; i < 2; ++i) { int R, C; stage_rc(tid * 16 + i * 8192, R, C); const int Rb = Epi::PERM ? ((R & ~31) + perm32(R & 31)) : R;
        voffA[i] = (unsigned)(R * K + C) * 2u; voffB[i] = (unsigned)(Rb * K + C) * 2u; }
    constexpr bool GA = Sched::GATHER_A;
    static_assert(!GA || SP2, "the gathered-A form exists for the SP2 loop only");
    unsigned vga[2][2], vgn[2][2];
    const size_t kstep = (size_t)(BK * 2);
    const size_t hstep = (size_t)HALF * K * 2;
    const size_t tstep = 2 * hstep;
    const size_t hstepA = GA ? 0 : hstep, tstepA = GA ? 0 : tstep;
    const unsigned ldsw = (unsigned)wid * 1024u;
    const int aoff = lds_byte(wr * 64 + fr, fq * 8), boff = lds_byte(wc * 32 + fr, fq * 8);
#define PG8_SA(b, h) (((b) * 2 + (h)) * HTB)
#define PG8_SB(b, h) ((4 + (b) * 2 + (h)) * HTB)
#define PG8_STAGE2(bufoff, gbase, o0, o1) do { \
        __builtin_amdgcn_global_load_lds((const unsigned*)((const char*)(gbase) + (o0)), (PG8_LAS unsigned*)(lds + (bufoff) + ldsw), 16, 0, 0); \
        __builtin_amdgcn_global_load_lds((const unsigned*)((const char*)(gbase) + (o1)), (PG8_LAS unsigned*)(lds + (bufoff) + ldsw + 8192), 16, 0, 0); } while (0)
#define PG8_STAGE(bufoff, gbase, voff) PG8_STAGE2(bufoff, gbase, (voff)[0], (voff)[1])
#define PG8_STAGE_A(bufoff, gbase, h, nx) PG8_STAGE2(bufoff, gbase, (GA ? ((nx) ? vgn[h][0] : vga[h][0]) : voffA[0]), (GA ? ((nx) ? vgn[h][1] : vga[h][1]) : voffA[1]))
#define PG8_LDA(dst, b, h) do { _Pragma("unroll") for (int m = 0; m < 4; ++m) _Pragma("unroll") for (int k = 0; k < 2; ++k) dst[m][k] = *(const PG8_LAS bf16x8*)(lds + PG8_SA(b, h) + aoff + m * 2048 + k * 1024); } while (0)
#define PG8_LDB(dst, b, h) do { _Pragma("unroll") for (int n = 0; n < 2; ++n) _Pragma("unroll") for (int k = 0; k < 2; ++k) dst[n][k] = *(const PG8_LAS bf16x8*)(lds + PG8_SB(b, h) + boff + n * 2048 + k * 1024); } while (0)
#define PG8_MMA(ai, bj, At, Bt) do { __builtin_amdgcn_s_setprio(1); _Pragma("unroll") for (int m = 0; m < 4; ++m) _Pragma("unroll") for (int n = 0; n < 2; ++n) _Pragma("unroll") for (int k = 0; k < 2; ++k) \
        acc[ai][bj][m][n] = __builtin_amdgcn_mfma_f32_16x16x32_bf16(Bt[n][k], At[m][k], acc[ai][bj][m][n], 0, 0, 0); __builtin_amdgcn_s_setprio(0); } while (0)
#define PG8_WAIT_V(n) asm volatile("s_waitcnt vmcnt(" #n ")" ::: "memory")
#define PG8_WAIT_L(n) asm volatile("s_waitcnt lgkmcnt(" #n ")" ::: "memory")
#define PG8_BAR __builtin_amdgcn_s_barrier()
#define PG8_SCHED __builtin_amdgcn_sched_barrier(0)
    Unit cur, nxt; int ui = 0;
    if (!S.next(0, cur)) return;
    f32x4 acc[2][2][4][2];
#pragma unroll
    for (int a = 0; a < 2; ++a)
#pragma unroll
        for (int b = 0; b < 2; ++b)
#pragma unroll
            for (int m = 0; m < 4; ++m)
#pragma unroll
                for (int n = 0; n < 2; ++n) acc[a][b][m][n] = (f32x4){0.f, 0.f, 0.f, 0.f};
    bf16x8 At[4][2], B0[2][2], B1[2][2];
    const char* cA = (const char*)g.A + (size_t)cur.pm * tstepA; const char* cB = (const char*)g.Bt + (size_t)cur.pn * tstep;
    S.a_ready(cur);
    if constexpr (GA) S.gather(cur, tid, K, vga);
    if constexpr (SP2) {
        PG8_STAGE(PG8_SB(0, 0), cB, voffB); PG8_STAGE(PG8_SB(0, 1), cB + hstep, voffB); PG8_STAGE_A(PG8_SA(0, 0), cA, 0, false); PG8_STAGE_A(PG8_SA(0, 1), cA + hstepA, 1, false);
        if (wr == 1) PG8_BAR;
        PG8_WAIT_V(2); PG8_BAR;
        PG8_STAGE(PG8_SB(1, 0), cB + kstep, voffB); PG8_STAGE_A(PG8_SA(1, 0), cA + kstep, 0, false); PG8_STAGE(PG8_SB(1, 1), cB + hstep + kstep, voffB);
        PG8_WAIT_V(6); PG8_BAR;
    } else {
        PG8_STAGE(PG8_SB(0, 0), cB, voffB); PG8_STAGE(PG8_SA(0, 0), cA, voffA); PG8_STAGE(PG8_SB(0, 1), cB + hstep, voffB); PG8_STAGE(PG8_SA(0, 1), cA + hstep, voffA);
        if (wr == 1) PG8_BAR;
        PG8_WAIT_V(4); PG8_BAR;
        PG8_STAGE(PG8_SB(1, 0), cB + kstep, voffB); PG8_STAGE(PG8_SA(1, 0), cA + kstep, voffA); PG8_STAGE(PG8_SB(1, 1), cB + hstep + kstep, voffB);
        PG8_WAIT_V(6); PG8_BAR;
    }
    for (;;) {
        const bool has_next = S.next(ui + 1, nxt);
        if constexpr (GA) { if (has_next) S.gather(nxt, tid, K, vgn); else { vgn[0][0] = vga[0][0]; vgn[0][1] = vga[0][1]; vgn[1][0] = vga[1][0]; vgn[1][1] = vga[1][1]; } }
        const char* nA = has_next ? (const char*)g.A + (size_t)nxt.pm * tstepA : cA; const char* nB = has_next ? (const char*)g.Bt + (size_t)nxt.pn * tstep : cB;
        for (int t = 0; t < nt; t += 2) {
            const bool last = (t == nt - 2);
            const char* a1 = cA + (size_t)(t + 1) * kstep;
            const char* a2 = last ? nA : cA + (size_t)(t + 2) * kstep; const char* b2 = last ? nB : cB + (size_t)(t + 2) * kstep;
            const char* a3 = a2 + kstep; const char* b3 = b2 + kstep;
            if (last && has_next) S.a_ready(nxt);
            if constexpr (Epi::MID_T > 0) { if (t == Epi::MID_T) E.mid(acc, cur, wr, wc, fr, fq); }
            if constexpr (SP2) {
            PG8_LDB(B0, 0, 0); PG8_LDB(B1, 0, 1); PG8_SCHED; PG8_LDA(At, 0, 0); PG8_STAGE_A(PG8_SA(1, 1), a1 + hstepA, 1, false);
            PG8_WAIT_V(8); PG8_WAIT_L(0); PG8_BAR; PG8_MMA(0, 0, At, B0); PG8_MMA(0, 1, At, B1); PG8_BAR; PG8_SCHED;
            PG8_LDA(At, 0, 1); PG8_STAGE(PG8_SB(0, 0), b2, voffB); PG8_STAGE(PG8_SB(0, 1), b2 + hstep, voffB); PG8_STAGE_A(PG8_SA(0, 0), a2, 0, last);
            PG8_WAIT_V(8); PG8_WAIT_L(0); PG8_BAR; PG8_MMA(1, 0, At, B0); PG8_MMA(1, 1, At, B1); PG8_BAR; PG8_SCHED;
            PG8_LDB(B0, 1, 0); PG8_LDB(B1, 1, 1); PG8_SCHED; PG8_LDA(At, 1, 0); PG8_STAGE_A(PG8_SA(0, 1), a2 + hstepA, 1, last);
            PG8_WAIT_V(8); PG8_WAIT_L(0); PG8_BAR; PG8_MMA(0, 0, At, B0); PG8_MMA(0, 1, At, B1); PG8_BAR; PG8_SCHED;
            PG8_LDA(At, 1, 1); PG8_STAGE(PG8_SB(1, 0), b3, voffB); PG8_STAGE(PG8_SB(1, 1), b3 + hstep, voffB); PG8_STAGE_A(PG8_SA(1, 0), a3, 0, last);
            PG8_WAIT_V(8); PG8_WAIT_L(0); PG8_BAR; PG8_MMA(1, 0, At, B0); PG8_MMA(1, 1, At, B1); PG8_BAR; PG8_SCHED;
            } else {
            PG8_LDB(B0, 0, 0); PG8_SCHED; PG8_LDA(At, 0, 0); PG8_STAGE(PG8_SA(1, 1), a1 + hstep, voffA);
            PG8_WAIT_L(8); PG8_BAR; PG8_WAIT_L(0); PG8_MMA(0, 0, At, B0); PG8_BAR; PG8_SCHED;
            PG8_LDB(B1, 0, 1); PG8_STAGE(PG8_SB(0, 0), b2, voffB);
            PG8_BAR; PG8_WAIT_L(0); PG8_MMA(0, 1, At, B1); PG8_BAR;
            PG8_LDA(At, 0, 1); PG8_STAGE(PG8_SA(0, 0), a2, voffA);
            PG8_BAR; PG8_WAIT_L(0); PG8_MMA(1, 0, At, B0); PG8_BAR; PG8_SCHED;
            PG8_STAGE(PG8_SB(0, 1), b2 + hstep, voffB);
            PG8_WAIT_V(6); PG8_BAR; PG8_MMA(1, 1, At, B1); PG8_BAR;
            PG8_LDB(B0, 1, 0); PG8_SCHED; PG8_LDA(At, 1, 0); PG8_STAGE(PG8_SA(0, 1), a2 + hstep, voffA);
            PG8_WAIT_L(8); PG8_BAR; PG8_WAIT_L(0); PG8_MMA(0, 0, At, B0); PG8_BAR; PG8_SCHED;
            PG8_LDB(B1, 1, 1); PG8_STAGE(PG8_SB(1, 0), b3, voffB);
            PG8_BAR; PG8_WAIT_L(0); PG8_MMA(0, 1, At, B1); PG8_BAR;
            PG8_LDA(At, 1, 1); PG8_STAGE(PG8_SA(1, 0), a3, voffA);
            PG8_BAR; PG8_WAIT_L(0); PG8_MMA(1, 0, At, B0); PG8_BAR; PG8_SCHED;
            PG8_STAGE(PG8_SB(1, 1), b3 + hstep, voffB);
            PG8_WAIT_V(6); PG8_BAR; PG8_MMA(1, 1, At, B1); PG8_BAR;
            }
        }
        if constexpr (ALIGN_EPI) { if (wr == 0) PG8_BAR; }
        if constexpr (!Epi::AFTER_DRAIN) { E(acc, cur, wr, wc, fr, fq); S.done(cur); }
        if (!has_next) break;
#pragma unroll
        for (int a = 0; a < 2; ++a)
#pragma unroll
            for (int b = 0; b < 2; ++b)
#pragma unroll
                for (int m = 0; m < 4; ++m)
#pragma unroll
                    for (int n = 0; n < 2; ++n) acc[a][b][m][n] = (f32x4){0.f, 0.f, 0.f, 0.f};
        cur = nxt; cA = nA; cB = nB; ++ui;
        if constexpr (GA) { vga[0][0] = vgn[0][0]; vga[0][1] = vgn[0][1]; vga[1][0] = vgn[1][0]; vga[1][1] = vgn[1][1]; }
        if constexpr (ALIGN_EPI) { if (wr == 1) PG8_BAR; }
    }
    PG8_WAIT_V(0);
    if constexpr (!ALIGN_EPI) { if (wr == 0) PG8_BAR; }
    PG8_BAR;
    if constexpr (Epi::AFTER_DRAIN) { E.fused(acc, cur, wr, wc, fr, fq, lds, wid, lane); S.done(cur); }
#undef PG8_STAGE_A
#undef PG8_STAGE2
#undef PG8_SA
#undef PG8_SB
#undef PG8_STAGE
#undef PG8_LDA
#undef PG8_LDB
#undef PG8_MMA
#undef PG8_WAIT_V
#undef PG8_WAIT_L
#undef PG8_BAR
#undef PG8_SCHED
}
}

#ifndef MK_N_LAUNCHES
#define MK_N_LAUNCHES 1
#endif
namespace cg = cooperative_groups;
#define GAS __attribute__((address_space(1)))
#define LAS __attribute__((address_space(3)))
typedef unsigned short bf16;
typedef unsigned u32x4 __attribute__((ext_vector_type(4)));
typedef unsigned u32x2 __attribute__((ext_vector_type(2)));
typedef float f32x4 __attribute__((ext_vector_type(4)));
typedef float f32x2 __attribute__((ext_vector_type(2)));
typedef short bf16x8 __attribute__((ext_vector_type(8)));
typedef short s16x4 __attribute__((ext_vector_type(4)));
typedef __bf16 bf16v2 __attribute__((ext_vector_type(2)));

constexpr int NWAVES = 8, NTHREADS = 512;
constexpr int BATCH = 2, SEQ = 8192, DM = 2048, MTOK = BATCH * SEQ;
constexpr int DIN = 11776, OFF_QA = 0, OFF_KA = 1024, OFF_VA = 2048, OFF_QB = 3072, OFF_KB = 4608, OFF_VB = 6144, OFF_GA = 7680, OFF_GB = 9728;
constexpr int GRID_W = 64, GRID_ROWS = SEQ / GRID_W, NA_HEADS = 8, DIL_HEADS = 12;
constexpr int NEXP = 64, DEXP = 512, PMAX = 49152, MAXTILES = PMAX / 256;
constexpr float LN_EPS = 1e-5f, DN_ALPHA = 1.189207115002721f, ATT_SCALE = 0.08838834764831845f;
constexpr int NRW = 80;
#ifndef MOE_HELPER_ITEMS
#define MOE_HELPER_ITEMS 3584
#endif
constexpr size_t MiB = 1u << 20, KiB = 1u << 10;
constexpr size_t WS_CTL = 0, WS_BAR = 16384, CTL_ZERO_BYTES = 65536;
constexpr size_t WS_STATS0 = 1 * MiB, WS_STATS1 = 1 * MiB + 128 * KiB, WS_TOKE = 1 * MiB + 256 * KiB, WS_TOKW = 1 * MiB + 384 * KiB, WS_TOKP = 1 * MiB + 512 * KiB, WS_TOKS = 1 * MiB + 640 * KiB, WS_TILE = 1 * MiB + 768 * KiB;
constexpr size_t WS_LSE = 2 * MiB;
constexpr size_t WS_WRH = 3 * MiB, WS_WRL = 3 * MiB + 512 * KiB;
constexpr size_t WS_WIN = 4 * MiB, WS_WAB = 50 * MiB, WS_WO = 56 * MiB;
constexpr size_t WS_ACT = 64 * MiB;
constexpr size_t WS_ATT = 128 * MiB, WS_DILG = 176 * MiB;
constexpr int ATT_LD = 1536;
constexpr size_t WS_Z = 224 * MiB;
constexpr size_t WS_WUP = 592 * MiB, WS_WDN = 848 * MiB, WS_LIST = 976 * MiB, WS_END = 980 * MiB;
constexpr size_t WS_HID = 416 * MiB, WS_YS = 224 * MiB, WS_LO = 464 * MiB;
static_assert(WS_WIN + (size_t)DIN * DM * 2 <= WS_WAB && WS_ATT + (size_t)MTOK * ATT_LD * 2 <= WS_DILG && WS_DILG + (size_t)3 * MTOK * 512 * 2 <= WS_Z && WS_Z + (size_t)MTOK * DIN * 2 <= WS_WUP && WS_YS + (size_t)PMAX * DM * 2 <= WS_HID && WS_HID + (size_t)PMAX * DEXP * 2 <= WS_LO && WS_LO + (size_t)MTOK * DM * 2 <= WS_WUP, "ws map");
constexpr int RING_BYTES = 131072, RPB_OFF = 147456, XB_LDS_OFF = 147456 + 15360, LDS_BYTES = 163840;
#ifndef CG_SEAM_MASK
#define CG_SEAM_MASK 1
#endif

__device__ __forceinline__ unsigned pk2(float lo, float hi) { f32x2 v = {lo, hi}; bf16v2 b = __builtin_convertvector(v, bf16v2); return __builtin_bit_cast(unsigned, b); }
__device__ __forceinline__ float bfl(unsigned w) { return __uint_as_float(w << 16); }
__device__ __forceinline__ float bfh(unsigned w) { return __uint_as_float(w & 0xffff0000u); }
__device__ __forceinline__ float wave_sum(float v) {
#pragma unroll
    for (int o = 1; o < 64; o <<= 1) v += __shfl_xor(v, o);
    return v;
}
#define LDS_WAIT() asm volatile("s_waitcnt lgkmcnt(0)" ::: "memory")
#define VM_WAIT() asm volatile("s_waitcnt vmcnt(0)" ::: "memory")

struct Args { const float* in[21]; float* out; unsigned char* ws; int ph_lo, ph_hi; };
enum { IN_X = 0, IN_LN0G, IN_LN0B, IN_WIN, IN_BIN, IN_RPB, IN_WPA, IN_WPB, IN_WO, IN_BO, IN_LN1G, IN_LN1B, IN_WRG, IN_BRG, IN_WRE, IN_BRE, IN_WG, IN_WU, IN_WD, IN_LN2G, IN_LN2B };

__device__ __forceinline__ unsigned xv_(unsigned row) { return ((row & 3u) << 2) | ((row >> 2) & 3u); }
__device__ __forceinline__ void p0_transpose_item(const float* W, int N, int K, bf16* WT, long dst_row0, int k0, int n0, LAS float* scr, int lane, int kdst = 0) {
#pragma unroll 8
    for (int i = 0; i < 32; ++i) { const int kk = 2 * i + (lane >> 5); scr[kk * 33 + (lane & 31)] = W[(size_t)(k0 + kk) * N + n0 + (lane & 31)]; }
    LDS_WAIT();
    const int c = lane & 7;
#pragma unroll
    for (int j = 0; j < 4; ++j) { const int n = (lane >> 3) + 8 * j; const LAS float* s = scr + (8 * c) * 33 + n;
        u32x4 o; o.x = pk2(s[0 * 33], s[1 * 33]); o.y = pk2(s[2 * 33], s[3 * 33]); o.z = pk2(s[4 * 33], s[5 * 33]); o.w = pk2(s[6 * 33], s[7 * 33]);
        *(u32x4*)(WT + (size_t)(dst_row0 + n) * K + kdst + k0 + 8 * c) = o; }
    LDS_WAIT();
}
__device__ __forceinline__ void p0_prologue(const Args& a, LAS unsigned char* lds, int gw, int NGW, int wave, int lane) {
    LAS float* scr = (LAS float*)(lds + wave * 16384);
    unsigned char* ws = a.ws;
    constexpr int I0 = 32 * 368, I1 = 16 * 64, I2 = 8 * 64, I3 = 32 * 64, I4 = NEXP * 32 * 16, I5 = I4, I6 = NEXP * 8 * 64;
    constexpr int NITEMS = I0 + I1 + I2 + I3 + I4 + I5 + I6;
    for (int it = gw; it < NITEMS; it += NGW) {
        int r = it;
        if (r < I0) { const int kb = r / 368, nb = r % 368; p0_transpose_item(a.in[IN_WIN], DIN, DM, (bf16*)(ws + WS_WIN), 32 * nb, 64 * kb, 32 * nb, scr, lane); continue; } r -= I0;
        if (r < I1) { const int kb = r / 64, nb = r % 64; p0_transpose_item(a.in[IN_WPA], DM, ATT_LD, (bf16*)(ws + WS_WAB), 32 * nb, 64 * kb, 32 * nb, scr, lane, 512); continue; } r -= I1;
        if (r < I2) { const int kb = r / 64, nb = r % 64; p0_transpose_item(a.in[IN_WPB], DM, ATT_LD, (bf16*)(ws + WS_WAB), 32 * nb, 64 * kb, 32 * nb, scr, lane, 0); continue; } r -= I2;
        if (r < I3) { const int kb = r / 64, nb = r % 64; p0_transpose_item(a.in[IN_WO], DM, DM, (bf16*)(ws + WS_WO), 32 * nb, 64 * kb, 32 * nb, scr, lane); continue; } r -= I3;
        if (r < I4 + I5) { const int mat = r >= I4; if (mat) r -= I4; const int e = r / 512, q = r % 512, kb = q / 16, nb = q % 16, n0 = 32 * nb;
            const float* W = (mat ? a.in[IN_WU] : a.in[IN_WG]) + (size_t)e * DM * DEXP;
            p0_transpose_item(W, DEXP, DM, (bf16*)(ws + WS_WUP), (long)e * 1024 + (n0 >> 7) * 256 + mat * 128 + (n0 & 127), 64 * kb, n0, scr, lane); continue; } r -= I4 + I5;
        { const int e = r / 512, q = r % 512, kb = q / 64, nb = q % 64;
            p0_transpose_item(a.in[IN_WD] + (size_t)e * DEXP * DM, DM, DEXP, (bf16*)(ws + WS_WDN), (long)e * 2048 + 32 * nb, 64 * kb, 32 * nb, scr, lane); }
    }
    { bf16* wh = (bf16*)(ws + WS_WRH); bf16* wl = (bf16*)(ws + WS_WRL);
      for (int i = gw * 64 + lane; i < NRW * DM; i += NGW * 64) { const int n = i / DM, k = i % DM;
          const float v = n < 8 ? a.in[IN_WRG][(size_t)k * 8 + n] : (n < 72 ? a.in[IN_WRE][(size_t)k * 64 + (n - 8)] : 0.f);
          const unsigned h = pk2(v, 0.f) & 0xffffu; const float r = v - __uint_as_float(h << 16);
          wh[i] = (bf16)h; wl[i] = (bf16)(pk2(r, 0.f) & 0xffffu); } }
    { const float* g = a.in[IN_LN0G]; const float* bb = a.in[IN_LN0B]; float* st = (float*)(ws + WS_STATS0); bf16* H = (bf16*)(ws + WS_ACT);
      f32x4 gv[8], bv[8];
#pragma unroll
      for (int j = 0; j < 8; ++j) { gv[j] = *(const f32x4*)(g + 256 * j + 4 * lane); bv[j] = *(const f32x4*)(bb + 256 * j + 4 * lane); }
      for (int m = gw; m < MTOK; m += NGW) {
          const float* xr = a.in[IN_X] + (size_t)m * DM + 4 * lane; f32x4 v[8]; float s = 0.f;
#pragma unroll
          for (int j = 0; j < 8; ++j) { v[j] = *(const f32x4*)(xr + 256 * j); s += (v[j].x + v[j].y) + (v[j].z + v[j].w); }
          const float mean = wave_sum(s) * (1.f / DM); float s2 = 0.f;
#pragma unroll
          for (int j = 0; j < 8; ++j) { v[j] = v[j] - mean; s2 += (v[j].x * v[j].x + v[j].y * v[j].y) + (v[j].z * v[j].z + v[j].w * v[j].w); }
          const float rstd = 1.0f / sqrtf(wave_sum(s2) * (1.f / DM) + LN_EPS);
          if (lane == 0) { st[2 * m] = mean; st[2 * m + 1] = rstd; }
          bf16* orow = H + (size_t)m * DM + 4 * lane;
#pragma unroll
          for (int j = 0; j < 8; ++j) { const f32x4 y = v[j] * rstd * gv[j] + bv[j]; u32x2 w; w.x = pk2(y.x, y.y); w.y = pk2(y.z, y.w); *(u32x2*)(orow + 256 * j) = w; }
      } }
}
#define XB_TMO      128
#define XB_XCNT(j)  (256  + 64 * (j))
#define XB_XSUB(j)  (1280 + 64 * (j))
#define XB_XGEN(j)  (2304 + 64 * (j))
#define XB_TOP      3328
#define XB_TOPGEN   3392
#define XCD_BAR_WORDS 3456
#define XB_SPIN_CAP (1u << 18)

__device__ __forceinline__ unsigned xb_ld(unsigned* p)              { return __hip_atomic_load(p, __ATOMIC_RELAXED, __HIP_MEMORY_SCOPE_AGENT); }
__device__ __forceinline__ unsigned xb_add(unsigned* p, unsigned v) { return __hip_atomic_fetch_add(p, v, __ATOMIC_RELAXED, __HIP_MEMORY_SCOPE_AGENT); }
__device__ __forceinline__ unsigned xb_xcc_id() { return (unsigned)__builtin_amdgcn_s_getreg((3 << 11) | 20) & 0xFu; }
#define XB_SPIN(cond, bar) do { unsigned _sp = 0; while (cond) { __builtin_amdgcn_s_sleep(1); \
    if ((++_sp & 255u) == 0u) { if (xb_ld(&(bar)[XB_TMO])) break; if (_sp > XB_SPIN_CAP) { atomicAdd(&(bar)[XB_TMO], 1u); break; } } } } while (0)

struct XcdBarrier {
    unsigned* bar; unsigned x;
    volatile LAS unsigned* st;
};

__device__ __forceinline__ XcdBarrier xcd_barrier_post(unsigned* bar, volatile LAS unsigned* st) {
    XcdBarrier b; b.bar = bar; b.x = xb_xcc_id(); b.st = st;
    if (threadIdx.x == 0) (void)xb_add(&bar[XB_XCNT(b.x)], 1u);
    return b;
}
__device__ __forceinline__ void xcd_barrier_complete(unsigned* bar, unsigned x, unsigned& nloc, unsigned& nx) {
    const unsigned G = gridDim.x * gridDim.y * gridDim.z;
    unsigned sum, cnt, mine, sp = 0u;
    for (;;) {
        sum = 0u; cnt = 0u; mine = 0u;
#pragma unroll
        for (unsigned j = 0; j < 16; ++j) { const unsigned c = xb_ld(&bar[XB_XCNT(j)]); sum += c; cnt += (c > 0u) ? 1u : 0u; mine = (j == x) ? c : mine; }
        if (sum == G) break;
        __builtin_amdgcn_s_sleep(1);
        if ((++sp & 255u) == 0u) { if (xb_ld(&bar[XB_TMO])) break; if (sp > XB_SPIN_CAP) { atomicAdd(&bar[XB_TMO], 1u); break; } }
    }
    nloc = mine > 0u ? mine : 1u; nx = cnt > 0u ? cnt : 1u;
}

__device__ __forceinline__ void xcd_barrier(const XcdBarrier& b) {
    asm volatile("s_waitcnt vmcnt(0)" ::: "memory");
    __syncthreads();
    if (threadIdx.x == 0) {
        unsigned* bar = b.bar;
        __builtin_amdgcn_s_waitcnt(0);
        unsigned nloc = b.st[0], nx = b.st[1];
        if (nloc == 0u) { xcd_barrier_complete(bar, b.x, nloc, nx); b.st[0] = nloc; b.st[1] = nx; }
        const unsigned old = xb_add(&bar[XB_XSUB(b.x)], 1u);
        const unsigned gen = old / nloc;
        if (old + 1u == (gen + 1u) * nloc) {
            __builtin_amdgcn_fence(__ATOMIC_RELEASE, "agent");
            asm volatile("s_waitcnt vmcnt(0)" ::: "memory");
            const unsigned og = xb_add(&bar[XB_TOP], 1u);
            const unsigned tg = og / nx;
            if (og + 1u == (tg + 1u) * nx) xb_add(&bar[XB_TOPGEN], 1u);
            else XB_SPIN(xb_ld(&bar[XB_TOPGEN]) == tg, bar);
            __builtin_amdgcn_fence(__ATOMIC_ACQUIRE, "agent");
            xb_add(&bar[XB_XGEN(b.x)], 1u);
            asm volatile("s_waitcnt vmcnt(0)" ::: "memory");
        } else {
            XB_SPIN(xb_ld(&bar[XB_XGEN(b.x)]) == gen, bar);
            __builtin_amdgcn_fence(__ATOMIC_ACQUIRE, "agent");
            asm volatile("s_waitcnt vmcnt(0)" ::: "memory");
        }
    }
    __syncthreads();
}

__device__ __forceinline__ unsigned xk_(unsigned row) { return (row & 3u) | (((row >> 3) & 3u) << 2); }
constexpr int ATT_RING = 147456;
constexpr int DIL_V_OFF = 69632;

struct NaFix { int c, r, start, kc0; const LAS float* rpb;
    __device__ __forceinline__ float operator()(float s, int ks, int idx, int q) const {
        const int kcol = kc0 + idx, qcol = 16 * c + q; int qcs = qcol - 8; qcs = qcs < 0 ? 0 : (qcs > 48 ? 48 : qcs);
        int dc = kcol - qcol + 15; dc = dc < 0 ? 0 : (dc > 30 ? 30 : dc);
        const float bias = rpb[(start + ks - r + 7) * 31 + dc];
        return (kcol >= qcs && kcol < qcs + 16) ? s * ATT_SCALE + bias : -INFINITY; } };
struct DilFix { int pq0, L; float slope_d;
    __device__ __forceinline__ float operator()(float s, int ks, int idx, int q) const {
        const int rel = -64 + 32 * ks + idx - q, pk = pq0 - 64 + 32 * ks + idx; const int ar = rel < 0 ? -rel : rel;
        return (ar <= 64 && pk >= 0 && pk < L) ? s * ATT_SCALE - slope_d * (float)ar : -INFINITY; } };

template <int NKS, int KSTRIDE>
__device__ __forceinline__ void att_qk(const LAS unsigned char* kimg, int kbase, const bf16* qrow, int lane, f32x4 (&s)[NKS][2]) {
    const int q = lane & 15, g = lane >> 4;
    bf16x8 qf[4];
#pragma unroll
    for (int dk = 0; dk < 4; ++dk) qf[dk] = *(const bf16x8*)(qrow + 8 * g + 32 * dk);
    const unsigned row0 = (unsigned)(kbase + 8 * (q >> 2) + (q & 3));
    const unsigned b0 = 256u * row0 + 16u * ((unsigned)g ^ xk_(row0));
#pragma unroll
    for (int ks = 0; ks < NKS; ++ks)
#pragma unroll
        for (int blk = 0; blk < 2; ++blk) {
            const unsigned b = b0 + 256u * (unsigned)(ks * KSTRIDE + 4 * blk);
            f32x4 acc = {0.f, 0.f, 0.f, 0.f};
#pragma unroll
            for (int dk = 0; dk < 4; ++dk) { const bf16x8 kf = *(const LAS bf16x8*)(kimg + (b ^ (64u * dk))); acc = __builtin_amdgcn_mfma_f32_16x16x32_bf16(kf, qf[dk], acc, 0, 0, 0); }
            s[ks][blk] = acc;
        }
}
template <int NKS, class FIX>
__device__ __forceinline__ void att_softmax(const FIX& fix, int lane, f32x4 (&s)[NKS][2], u32x4 (&pw)[NKS], float& lse) {
    const int q = lane & 15, g = lane >> 4;
    float mx = -INFINITY;
#pragma unroll
    for (int ks = 0; ks < NKS; ++ks)
#pragma unroll
        for (int blk = 0; blk < 2; ++blk)
#pragma unroll
            for (int r = 0; r < 4; ++r) { const float v = fix(s[ks][blk][r], ks, 8 * g + 4 * blk + r, q); s[ks][blk][r] = v; mx = fmaxf(mx, v); }
    mx = fmaxf(mx, __shfl_xor(mx, 16)); mx = fmaxf(mx, __shfl_xor(mx, 32));
    float sum = 0.f;
#pragma unroll
    for (int ks = 0; ks < NKS; ++ks)
#pragma unroll
        for (int blk = 0; blk < 2; ++blk)
#pragma unroll
            for (int r = 0; r < 4; ++r) { const float p = __builtin_amdgcn_exp2f((s[ks][blk][r] - mx) * 1.4426950408889634f); s[ks][blk][r] = p; sum += p; }
    sum += __shfl_xor(sum, 16); sum += __shfl_xor(sum, 32);
    lse = mx + __logf(sum);
    const float inv = 1.0f / sum;
#pragma unroll
    for (int ks = 0; ks < NKS; ++ks) { pw[ks].x = pk2(s[ks][0][0] * inv, s[ks][0][1] * inv); pw[ks].y = pk2(s[ks][0][2] * inv, s[ks][0][3] * inv); pw[ks].z = pk2(s[ks][1][0] * inv, s[ks][1][1] * inv); pw[ks].w = pk2(s[ks][1][2] * inv, s[ks][1][3] * inv);
        asm volatile("" : "+v"(pw[ks].x), "+v"(pw[ks].y), "+v"(pw[ks].z), "+v"(pw[ks].w)); }
}
template <int NKS, int KSTRIDE>
__device__ __forceinline__ void att_pv(const LAS unsigned char* vimg, int vbase, int lane, const u32x4 (&pw)[NKS], f32x4 (&o)[8]) {
    const unsigned g = lane >> 4, qq = (lane & 15) >> 2, p = lane & 3;
    unsigned tra[2];
#pragma unroll
    for (int t = 0; t < 2; ++t) { const unsigned row = (unsigned)vbase + 8u * g + 4u * t + qq; tra[t] = 256u * row + 16u * (xv_(row) ^ (p >> 1)) + 8u * (p & 1); }
#pragma unroll
    for (int c = 0; c < 8; ++c) o[c] = (f32x4){0.f, 0.f, 0.f, 0.f};
#pragma unroll
    for (int ks = 0; ks < NKS; ++ks) {
        const bf16x8 pf = __builtin_bit_cast(bf16x8, pw[ks]);
#pragma unroll
        for (int c = 0; c < 8; ++c) {
            const s16x4 t0 = __builtin_amdgcn_ds_read_tr16_b64_v4i16((LAS s16x4*)(vimg + ((tra[0] + 256u * (unsigned)(ks * KSTRIDE)) ^ (32u * c))));
            const s16x4 t1 = __builtin_amdgcn_ds_read_tr16_b64_v4i16((LAS s16x4*)(vimg + ((tra[1] + 256u * (unsigned)(ks * KSTRIDE)) ^ (32u * c))));
            const bf16x8 vf = __builtin_shufflevector(t0, t1, 0, 1, 2, 3, 4, 5, 6, 7);
            o[c] = __builtin_amdgcn_mfma_f32_16x16x32_bf16(vf, pf, o[c], 0, 0, 0);
        }
    }
}
#define ATT_GLDS(src_, dst_) __builtin_amdgcn_global_load_lds((const unsigned*)(src_), (LAS unsigned*)(dst_), 16, 0, 0)
__device__ __forceinline__ void p2_attention(const Args& a, LAS unsigned char* lds, int wave, int lane) {
    unsigned char* ws = a.ws; const bf16* z = (const bf16*)(ws + WS_Z);
    LAS float* rpb = (LAS float*)(lds + RPB_OFF);
    for (int i = threadIdx.x; i < NA_HEADS * 465; i += NTHREADS) rpb[i] = a.in[IN_RPB][i];
    __syncthreads();
    const int G = gridDim.x, bx = blockIdx.x, vcu = (G % 8 == 0) ? (bx % 8) * (G / 8) + bx / 8 : bx;
    constexpr int N_NA = BATCH * NA_HEADS * (GRID_ROWS / 2), N_DIL = DIL_HEADS * BATCH * 64;
    for (int it = vcu; it < N_NA + N_DIL; it += G) {
        asm volatile("" : "+v"(lane));
        const int q = lane & 15, g = lane >> 4, vrow = lane >> 4, slot = lane & 15;
        f32x4 o[8]; float lse;
        if (it < N_NA) {
            const int rp = it & 63, h = (it >> 6) & 7, b = it >> 9, r0 = 2 * rp;
            int st0 = r0 - 4; st0 = st0 < 0 ? 0 : (st0 > GRID_ROWS - 8 ? GRID_ROWS - 8 : st0);
            const bf16* zb = z + (size_t)b * SEQ * DIN;
            const int c = wave & 3, r = r0 + (wave >> 2); int st = r - 4; st = st < 0 ? 0 : (st > GRID_ROWS - 8 ? GRID_ROWS - 8 : st);
            int kc = 16 * c - 8; kc = kc < 0 ? 0 : (kc > 32 ? 32 : kc);
            const int base = (st - st0) * 64 + kc;
#pragma unroll 2
            for (int pc = wave; pc < 144; pc += 8) { const unsigned row = 4u * pc + vrow; int kr = st0 + (int)(row >> 6); kr = kr > GRID_ROWS - 1 ? GRID_ROWS - 1 : kr;
                ATT_GLDS(zb + (size_t)(kr * GRID_W + (int)(row & 63)) * DIN + OFF_KA + h * 128 + 8 * (slot ^ xk_(row)), lds + pc * 1024); }
            const bf16* qrow = zb + (size_t)(r * GRID_W + 16 * c + q) * DIN + OFF_QA + h * 128;
            f32x4 s[8][2]; u32x4 pw[8];
            VM_WAIT(); __syncthreads();
            att_qk<8, 64>(lds, base, qrow, lane, s);
            __syncthreads();
#pragma unroll 2
            for (int pc = wave; pc < 144; pc += 8) { const unsigned row = 4u * pc + vrow; int kr = st0 + (int)(row >> 6); kr = kr > GRID_ROWS - 1 ? GRID_ROWS - 1 : kr;
                ATT_GLDS(zb + (size_t)(kr * GRID_W + (int)(row & 63)) * DIN + OFF_VA + h * 128 + 8 * (slot ^ xv_(row)), lds + pc * 1024); }
            NaFix fx; fx.c = c; fx.r = r; fx.start = st; fx.kc0 = kc; fx.rpb = rpb + h * 465;
            att_softmax<8>(fx, lane, s, pw, lse);
            VM_WAIT(); __syncthreads();
            att_pv<8, 64>(lds, base, lane, pw, o);
            bf16* orow = (bf16*)(ws + WS_ATT) + (size_t)(b * SEQ + r * GRID_W + 16 * c + q) * ATT_LD + 512 + h * 128 + 4 * g;
#pragma unroll
            for (int cc = 0; cc < 8; ++cc) { u32x2 w; w.x = pk2(o[cc][0], o[cc][1]); w.y = pk2(o[cc][2], o[cc][3]); *(u32x2*)(orow + 16 * cc) = w; }
            __syncthreads();
        } else {
            const int j = it - N_NA, blk = j & 63, b = (j >> 6) & 1, hd = j >> 7;
            const int grp = hd >> 2, hslot = hd & 3, d = grp == 0 ? 1 : (grp == 1 ? 4 : 16), L = SEQ / d, nb = L / 128, res = blk / nb, n = blk % nb;
            const bf16* zb = z + (size_t)b * SEQ * DIN;
            const int p0 = n * 128 - 64;
#pragma unroll 2
            for (int pc = wave; pc < 68; pc += 8) { const unsigned row = 4u * pc + vrow; int p = p0 + (int)row; p = p < 0 ? 0 : (p > L - 1 ? L - 1 : p);
                ATT_GLDS(zb + (size_t)(p * d + res) * DIN + OFF_KB + hd * 128 + 8 * (slot ^ xk_(row)), lds + pc * 1024); }
#pragma unroll 2
            for (int pc = wave; pc < 68; pc += 8) { const unsigned row = 4u * pc + vrow; int p = p0 + (int)row; p = p < 0 ? 0 : (p > L - 1 ? L - 1 : p);
                ATT_GLDS(zb + (size_t)(p * d + res) * DIN + OFF_VB + hd * 128 + 8 * (slot ^ xv_(row)), lds + DIL_V_OFF + pc * 1024); }
            const int pq0 = n * 128 + 16 * wave;
            const bf16* qrow = zb + (size_t)((pq0 + q) * d + res) * DIN + OFF_QB + hd * 128;
            f32x4 s[5][2]; u32x4 pw[5];
            VM_WAIT(); __syncthreads();
            att_qk<5, 32>(lds, 16 * wave, qrow, lane, s);
            DilFix fx; fx.pq0 = pq0; fx.L = L; fx.slope_d = exp2f(-8.0f * (float)(hd + 1) / 12.0f) * (float)d;
            att_softmax<5>(fx, lane, s, pw, lse);
            att_pv<5, 32>(lds + DIL_V_OFF, 16 * wave, lane, pw, o);
            const size_t row = (size_t)b * SEQ + (size_t)(pq0 + q) * d + res;
            bf16* orow = (bf16*)(ws + WS_DILG) + ((size_t)grp * MTOK + row) * 512 + hslot * 128 + 4 * g;
#pragma unroll
            for (int cc = 0; cc < 8; ++cc) { u32x2 w; w.x = pk2(o[cc][0], o[cc][1]); w.y = pk2(o[cc][2], o[cc][3]); *(u32x2*)(orow + 16 * cc) = w; }
            if (g == 0) ((float*)(ws + WS_LSE))[((size_t)grp * MTOK + row) * 4 + hslot] = lse;
            __syncthreads();
        }
    }
}
__device__ __forceinline__ void p3_combine(const Args& a, int gtid, int NT) {
    unsigned char* ws = a.ws; const float* lse = (const float*)(ws + WS_LSE); const bf16* og = (const bf16*)(ws + WS_DILG); bf16* out = (bf16*)(ws + WS_ATT);
    for (int i = gtid; i < MTOK * 64; i += NT) {
        const int row = i >> 6, ch = i & 63, slot = ch >> 4;
        const float l0 = lse[((size_t)0 * MTOK + row) * 4 + slot], l1 = lse[((size_t)1 * MTOK + row) * 4 + slot], l2 = lse[((size_t)2 * MTOK + row) * 4 + slot];
        const float mx = fmaxf(l0, fmaxf(l1, l2)); float w0 = __expf(l0 - mx), w1 = __expf(l1 - mx), w2 = __expf(l2 - mx); const float inv = 1.0f / (w0 + w1 + w2); w0 *= inv; w1 *= inv; w2 *= inv;
        const u32x4 a0 = *(const u32x4*)(og + ((size_t)0 * MTOK + row) * 512 + 8 * ch), a1 = *(const u32x4*)(og + ((size_t)1 * MTOK + row) * 512 + 8 * ch), a2 = *(const u32x4*)(og + ((size_t)2 * MTOK + row) * 512 + 8 * ch);
        u32x4 r;
        r.x = pk2(w0 * bfl(a0.x) + w1 * bfl(a1.x) + w2 * bfl(a2.x), w0 * bfh(a0.x) + w1 * bfh(a1.x) + w2 * bfh(a2.x));
        r.y = pk2(w0 * bfl(a0.y) + w1 * bfl(a1.y) + w2 * bfl(a2.y), w0 * bfh(a0.y) + w1 * bfh(a1.y) + w2 * bfh(a2.y));
        r.z = pk2(w0 * bfl(a0.z) + w1 * bfl(a1.z) + w2 * bfl(a2.z), w0 * bfh(a0.z) + w1 * bfh(a1.z) + w2 * bfh(a2.z));
        r.w = pk2(w0 * bfl(a0.w) + w1 * bfl(a1.w) + w2 * bfl(a2.w), w0 * bfh(a0.w) + w1 * bfh(a1.w) + w2 * bfh(a2.w));
        *(u32x4*)(out + (size_t)row * ATT_LD + 8 * ch) = r;
    }
}

__device__ __forceinline__ void p6_ln1_router(const Args& a, LAS unsigned char* lds, int wave, int lane, bool do_route = true) {
    unsigned char* ws = a.ws; const float* Y = a.out; bf16* HI = (bf16*)(ws + WS_ACT); bf16* LO = (bf16*)(ws + WS_LO); float* st = (float*)(ws + WS_STATS1);
    const bf16* WH = (const bf16*)(ws + WS_WRH); const bf16* WL = (const bf16*)(ws + WS_WRL);
    LAS float* P = (LAS float*)lds;
    LAS float* BIAS = P + 64 * NRW;
    const float* g1 = a.in[IN_LN1G]; const float* b1 = a.in[IN_LN1B];
    for (int rg = blockIdx.x; rg < MTOK / 64; rg += gridDim.x) {
        if (threadIdx.x < 8) BIAS[threadIdx.x] = a.in[IN_BRG][threadIdx.x]; else if (threadIdx.x < 72) BIAS[threadIdx.x] = a.in[IN_BRE][threadIdx.x - 8];
#pragma unroll 1
        for (int i4 = 0; i4 < 2; ++i4) {
            const int m0 = rg * 64 + wave * 8 + i4 * 4;
            f32x4 v[4][8]; float s[4];
#pragma unroll
            for (int r = 0; r < 4; ++r) { const float* yr = Y + (size_t)(m0 + r) * DM + 4 * lane;
#pragma unroll
                for (int j = 0; j < 8; ++j) v[r][j] = *(const f32x4*)(yr + 256 * j); }
#pragma unroll
            for (int r = 0; r < 4; ++r) { s[r] = 0.f;
#pragma unroll
                for (int j = 0; j < 8; ++j) s[r] += (v[r][j].x + v[r][j].y) + (v[r][j].z + v[r][j].w); }
#pragma unroll
            for (int o = 1; o < 64; o <<= 1) {
#pragma unroll
                for (int r = 0; r < 4; ++r) s[r] += __shfl_xor(s[r], o); }
            float mean[4], s2[4];
#pragma unroll
            for (int r = 0; r < 4; ++r) { mean[r] = s[r] * (1.f / DM); s2[r] = 0.f;
#pragma unroll
                for (int j = 0; j < 8; ++j) { v[r][j] = v[r][j] - mean[r]; s2[r] += (v[r][j].x * v[r][j].x + v[r][j].y * v[r][j].y) + (v[r][j].z * v[r][j].z + v[r][j].w * v[r][j].w); } }
#pragma unroll
            for (int o = 1; o < 64; o <<= 1) {
#pragma unroll
                for (int r = 0; r < 4; ++r) s2[r] += __shfl_xor(s2[r], o); }
#pragma unroll
            for (int r = 0; r < 4; ++r) { const int m = m0 + r; const float rstd = 1.0f / sqrtf(s2[r] * (1.f / DM) + LN_EPS);
                if (lane == 0) { st[2 * m] = mean[r]; st[2 * m + 1] = rstd; }
                bf16* hrow = HI + (size_t)m * DM + 4 * lane; bf16* lrow = LO + (size_t)m * DM + 4 * lane;
#pragma unroll
                for (int j = 0; j < 8; ++j) { const f32x4 gv = *(const f32x4*)(g1 + 256 * j + 4 * lane), bv = *(const f32x4*)(b1 + 256 * j + 4 * lane); const f32x4 y = v[r][j] * rstd * gv + bv;
                    u32x2 h; h.x = pk2(y.x, y.y); h.y = pk2(y.z, y.w);
                    u32x2 l; l.x = pk2(y.x - bfl(h.x), y.y - bfh(h.x)); l.y = pk2(y.z - bfl(h.y), y.w - bfh(h.y));
                    *(u32x2*)(hrow + 256 * j) = h; *(u32x2*)(lrow + 256 * j) = l; } }
        }
        VM_WAIT(); __syncthreads();
        {
            const int fr = lane & 15, fq = lane >> 4;
            const size_t aoff = (size_t)(rg * 64 + fr) * DM + wave * 256 + 8 * fq, boff = (size_t)fr * DM + wave * 256 + 8 * fq;
            f32x4 acc[4][5];
#pragma unroll
            for (int rb = 0; rb < 4; ++rb)
#pragma unroll
                for (int cb = 0; cb < 5; ++cb) acc[rb][cb] = (f32x4){0.f, 0.f, 0.f, 0.f};
#pragma unroll 2
            for (int s = 0; s < 8; ++s) {
                bf16x8 bh[5], bl[5];
#pragma unroll
                for (int cb = 0; cb < 5; ++cb) { bh[cb] = *(const bf16x8*)(WH + boff + (size_t)(16 * cb) * DM + 32 * s); bl[cb] = *(const bf16x8*)(WL + boff + (size_t)(16 * cb) * DM + 32 * s); }
#pragma unroll
                for (int rb = 0; rb < 4; ++rb) { const bf16x8 ah = *(const bf16x8*)(HI + aoff + (size_t)(16 * rb) * DM + 32 * s), al = *(const bf16x8*)(LO + aoff + (size_t)(16 * rb) * DM + 32 * s);
#pragma unroll
                    for (int cb = 0; cb < 5; ++cb) {
                        acc[rb][cb] = __builtin_amdgcn_mfma_f32_16x16x32_bf16(ah, bh[cb], acc[rb][cb], 0, 0, 0);
                        acc[rb][cb] = __builtin_amdgcn_mfma_f32_16x16x32_bf16(ah, bl[cb], acc[rb][cb], 0, 0, 0);
                        acc[rb][cb] = __builtin_amdgcn_mfma_f32_16x16x32_bf16(al, bh[cb], acc[rb][cb], 0, 0, 0); } }
            }
            LAS float* T = P + (wave >> 2) * (64 * NRW + 128);
#pragma unroll 1
            for (int k = 0; k < 4; ++k) {
                if ((wave & 3) == k) {
#pragma unroll
                    for (int rb = 0; rb < 4; ++rb)
#pragma unroll
                        for (int cb = 0; cb < 5; ++cb)
#pragma unroll
                            for (int r = 0; r < 4; ++r) { LAS float* p = &T[(16 * rb + 4 * fq + r) * NRW + 16 * cb + fr]; *p = (k == 0 ? 0.f : *p) + acc[rb][cb][r]; }
                }
                __syncthreads();
            }
        }
        if (threadIdx.x < 64 && do_route) {
            const int t = threadIdx.x, m = rg * 64 + t; const LAS float* p0 = P + (size_t)t * NRW; const LAS float* p1 = p0 + (64 * NRW + 128);
            float gl[8]; int gs = 0; float gm = -INFINITY;
#pragma unroll
            for (int n = 0; n < 8; ++n) { gl[n] = p0[n] + p1[n] + BIAS[n]; if (gl[n] > gm) { gm = gl[n]; gs = n; } }
            float gsum = 0.f;
#pragma unroll
            for (int n = 0; n < 8; ++n) gsum += __expf(gl[n] - gm);
            const float gprob = 1.0f / gsum;
            float v0 = -INFINITY, v1 = -INFINITY; int i0 = 0, i1 = 0;
#pragma unroll
            for (int n = 0; n < 8; ++n) { const float ev = p0[8 + gs * 8 + n] + p1[8 + gs * 8 + n] + BIAS[8 + gs * 8 + n];
                if (ev > v0) { v1 = v0; i1 = i0; v0 = ev; i0 = n; } else if (ev > v1) { v1 = ev; i1 = n; } }
            const float e1 = __expf(v1 - v0), w0 = gprob / (1.0f + e1), w1 = gprob * e1 / (1.0f + e1);
            const int x0 = gs * 8 + i0, x1 = gs * 8 + i1;
            unsigned* cnt = (unsigned*)(ws + WS_CTL);
            const unsigned q0 = atomicAdd(cnt + x0, 1u), q1 = atomicAdd(cnt + x1, 1u);
            int* te = (int*)(ws + WS_TOKE); float* tw = (float*)(ws + WS_TOKW); int* tp = (int*)(ws + WS_TOKP);
            te[2 * m] = x0; te[2 * m + 1] = x1; tw[2 * m] = w0; tw[2 * m + 1] = w1; tp[2 * m] = (int)q0; tp[2 * m + 1] = (int)q1;
            int* list = (int*)(ws + WS_LIST); list[(size_t)x0 * 16384 + q0] = m; list[(size_t)x1 * 16384 + q1] = m;
        }
        __syncthreads();
    }
}
constexpr int MOE_TAB_OFF = 147456;
__device__ __forceinline__ void moe_tables(const Args& a, LAS unsigned char* lds) {
    LAS int* tab = (LAS int*)(lds + MOE_TAB_OFF); const unsigned* cnt = (const unsigned*)(a.ws + WS_CTL);
    __syncthreads();
    if (threadIdx.x < NEXP) tab[448 + threadIdx.x] = (int)__hip_atomic_load(cnt + threadIdx.x, __ATOMIC_RELAXED, __HIP_MEMORY_SCOPE_AGENT);
    __syncthreads();
    if (threadIdx.x == 0) { int pos = 0, nt = 0;
        for (int e = 0; e < NEXP; ++e) { const int c = tab[448 + e], ne = (c + 255) >> 8; tab[384 + e] = pos;
            for (int j = 0; j < ne; ++j) { tab[nt + j] = e; tab[192 + nt + j] = 256 * j; }
            nt += ne; pos += 256 * ne; }
        tab[512] = nt; }
    __syncthreads();
}
__device__ __forceinline__ void p10_final(const Args& a, LAS unsigned char* lds, int gw, int NGW, int lane, float* dstbase) {
    unsigned char* ws = a.ws; float* Y = a.out; const float* st = (const float*)(ws + WS_STATS1); const bf16* YS = (const bf16*)(ws + WS_YS);
    const int* te = (const int*)(ws + WS_TOKE); const int* tp = (const int*)(ws + WS_TOKP); const float* tw = (const float*)(ws + WS_TOKW); const LAS int* tab = (const LAS int*)(lds + MOE_TAB_OFF);
    const float* g1 = a.in[IN_LN1G]; const float* b1 = a.in[IN_LN1B]; const float* g2 = a.in[IN_LN2G]; const float* b2 = a.in[IN_LN2B];
    for (int m = gw; m < MTOK; m += NGW) {
        float* yr = Y + (size_t)m * DM + 4 * lane; const float mu = st[2 * m], rs = st[2 * m + 1];
        const int s0 = tab[384 + te[2 * m]] + tp[2 * m], s1 = tab[384 + te[2 * m + 1]] + tp[2 * m + 1]; const float w0 = tw[2 * m], w1 = tw[2 * m + 1];
        const bf16* e0 = YS + (size_t)s0 * DM + 4 * lane; const bf16* e1 = YS + (size_t)s1 * DM + 4 * lane;
        f32x4 v[8]; float s = 0.f;
#pragma unroll
        for (int j = 0; j < 8; ++j) { const f32x4 y = *(const f32x4*)(yr + 256 * j); const f32x4 gv = *(const f32x4*)(g1 + 256 * j + 4 * lane), bv = *(const f32x4*)(b1 + 256 * j + 4 * lane);
            const u32x2 c0 = *(const u32x2*)(e0 + 256 * j), c1 = *(const u32x2*)(e1 + 256 * j);
            f32x4 f; f.x = w0 * bfl(c0.x) + w1 * bfl(c1.x); f.y = w0 * bfh(c0.x) + w1 * bfh(c1.x); f.z = w0 * bfl(c0.y) + w1 * bfl(c1.y); f.w = w0 * bfh(c0.y) + w1 * bfh(c1.y);
            v[j] = ((y - mu) * rs * gv + bv) * DN_ALPHA + f; s += (v[j].x + v[j].y) + (v[j].z + v[j].w); }
        const float mean = wave_sum(s) * (1.f / DM); float s2 = 0.f;
#pragma unroll
        for (int j = 0; j < 8; ++j) { v[j] = v[j] - mean; s2 += (v[j].x * v[j].x + v[j].y * v[j].y) + (v[j].z * v[j].z + v[j].w * v[j].w); }
        const float rstd = 1.0f / sqrtf(wave_sum(s2) * (1.f / DM) + LN_EPS);
#pragma unroll
        for (int j = 0; j < 8; ++j) { const f32x4 gv = *(const f32x4*)(g2 + 256 * j + 4 * lane), bv = *(const f32x4*)(b2 + 256 * j + 4 * lane); *(f32x4*)(dstbase + (size_t)m * DM + 4 * lane + 256 * j) = v[j] * rstd * gv + bv; }
    }
}

__device__ __forceinline__ int fresh_lane() { int l = (int)(threadIdx.x & 63u); asm volatile("" : "+v"(l)); return l; }
constexpr int N_PHASES = 10;
#ifndef HELPER_ROWS
#define HELPER_ROWS 1
#endif
__global__ void __launch_bounds__(NTHREADS, 2) mk_fwd(Args args) {
    extern __shared__ __attribute__((aligned(16))) unsigned char lds_raw[];
    LAS unsigned char* lds = (LAS unsigned char*)lds_raw;
    const int tid = threadIdx.x, wave = __builtin_amdgcn_readfirstlane(tid >> 6);
#define lane fresh_lane()
    const int G = gridDim.x, gw = blockIdx.x * NWAVES + wave, NGW = G * NWAVES;
    unsigned char* ws = args.ws;
    const int vcu = (G % 8 == 0) ? ((int)blockIdx.x % 8) * (G / 8) + (int)blockIdx.x / 8 : (int)blockIdx.x;
    const int lo = args.ph_lo, hi = args.ph_hi;
#ifndef PHASE_MASK
#define PHASE_MASK 0x3ff
#endif
#define IN(k) (((PHASE_MASK >> (k)) & 1) && lo <= (k) && (k) < hi)
#ifndef DOUBLE_PHASE
#define DOUBLE_PHASE 0
#endif
#define REP(k) for (int rep_ = 0; rep_ < (((DOUBLE_PHASE >> (k)) & 1) ? 2 : 1); ++rep_)
#if MK_N_LAUNCHES == 1
    cg::grid_group grid = cg::this_grid();
    { volatile LAS unsigned* st = (volatile LAS unsigned*)(lds + XB_LDS_OFF); if (tid < 2) st[tid] = 0u; }
    __syncthreads();
    const XcdBarrier bar = xcd_barrier_post((unsigned*)(ws + WS_BAR), (volatile LAS unsigned*)(lds + XB_LDS_OFF));
#define SEAM(k) do { if (IN(k) && IN((k) + 1)) { if (CG_SEAM_MASK >> (k) & 1) grid.sync(); else xcd_barrier(bar); } } while (0)
#else
#define SEAM(k) do { } while (0)
#endif
    if (IN(0)) REP(0) p0_prologue(args, lds, gw, NGW, wave, lane);
    SEAM(0);
    if (IN(1)) REP(1) { pg8::Gemm g{(const bf16*)(ws + WS_ACT), (const bf16*)(ws + WS_WIN), MTOK, DIN, DM}; pg8::StaticOrder S; S.init(MTOK, DIN, G, (int)blockIdx.x);
        pg8::EpiZ E{(bf16*)(ws + WS_Z), DIN, args.in[IN_BIN], OFF_GA / 256};
        pg8::gemm_phase<pg8::EpiZ, pg8::StaticOrder, true, true>(lds, g, S, E); }
    SEAM(1);
    if (IN(2)) REP(2) p2_attention(args, lds, wave, lane);
    SEAM(2);
    if (IN(3)) REP(3) p3_combine(args, blockIdx.x * NTHREADS + tid, G * NTHREADS);
    SEAM(3);
    if (IN(4)) REP(4) { pg8::Gemm g{(const bf16*)(ws + WS_ATT), (const bf16*)(ws + WS_WAB), MTOK, DM, ATT_LD}; pg8::StaticOrder S; S.init(MTOK, DM, G, (int)blockIdx.x);
        pg8::EpiMix E{(bf16*)(ws + WS_ACT), (const bf16*)(ws + WS_Z) + OFF_GA, (const bf16*)(ws + WS_Z) + OFF_GB, DIN};
        pg8::gemm_phase<pg8::EpiMix, pg8::StaticOrder, true, true>(lds, g, S, E); }
    SEAM(4);
    if (IN(5)) REP(5) { pg8::Gemm g{(const bf16*)(ws + WS_ACT), (const bf16*)(ws + WS_WO), MTOK, DM, DM}; pg8::StaticOrder S; S.init(MTOK, DM, G, (int)blockIdx.x);
        pg8::EpiY1 E{args.out, args.in[IN_X], (const float*)(ws + WS_STATS0), args.in[IN_LN0G], args.in[IN_LN0B], args.in[IN_BO], DN_ALPHA};
        pg8::gemm_phase<pg8::EpiY1, pg8::StaticOrder, true, true>(lds, g, S, E); }
    SEAM(5);
    if (IN(6)) REP(6) p6_ln1_router(args, lds, wave, lane, rep_ == (((DOUBLE_PHASE >> 6) & 1) ? 1 : 0));
    SEAM(6);
    if (IN(7)) REP(7) { moe_tables(args, lds);
        pg8::Gemm g{(const bf16*)(ws + WS_ACT), (const bf16*)(ws + WS_WUP), PMAX, NEXP * 1024, DM};
        pg8::MoeOrder<true, 2> S{(const LAS int*)(lds + MOE_TAB_OFF), (const int*)(ws + WS_LIST), G, vcu};
        pg8::EpiSwiGLU E{(bf16*)(ws + WS_HID)};
        pg8::gemm_phase<pg8::EpiSwiGLU, pg8::MoeOrder<true, 2>, true, true>(lds, g, S, E); }
    SEAM(7);
    if (IN(8)) REP(8) { moe_tables(args, lds);
        pg8::Gemm g{(const bf16*)(ws + WS_HID), (const bf16*)(ws + WS_WDN), PMAX, NEXP * 2048, DEXP};
        pg8::MoeOrder<false, 3> S{(const LAS int*)(lds + MOE_TAB_OFF), nullptr, G, vcu};
        pg8::EpiYs E{(bf16*)(ws + WS_YS), DM, 7};
        pg8::gemm_phase<pg8::EpiYs, pg8::MoeOrder<false, 3>, true, true>(lds, g, S, E); }
    SEAM(8);
    if (IN(9)) REP(9) { moe_tables(args, lds); p10_final(args, lds, gw, NGW, lane, (((DOUBLE_PHASE >> 9) & 1) && rep_ == 0) ? (float*)(ws + WS_WUP) : args.out); }
#undef lane
#undef IN
#undef SEAM
}

extern "C" void kernel_launch(void* const* d_in, const int* in_sizes, int n_in, void* d_out, int out_size, void* d_ws, size_t ws_size, hipStream_t stream) {
    static int grid = 0;
    if (grid == 0) {
        if (n_in != 21 || in_sizes[0] != MTOK * DM || out_size != MTOK * DM || ws_size < WS_END) { fprintf(stderr, "kernel_launch: unexpected shapes (n_in %d, in0 %d, out %d, ws %zu < %zu)\n", n_in, n_in > 0 ? in_sizes[0] : -1, out_size, ws_size, (size_t)WS_END); grid = -1; return; }
        int dev = 0, cus = 0, per_cu = 0;
        if (hipGetDevice(&dev) != hipSuccess || hipDeviceGetAttribute(&cus, hipDeviceAttributeMultiprocessorCount, dev) != hipSuccess) { fprintf(stderr, "kernel_launch: device query failed\n"); grid = -1; return; }
        if (hipFuncSetAttribute((const void*)mk_fwd, hipFuncAttributeMaxDynamicSharedMemorySize, LDS_BYTES) != hipSuccess) { fprintf(stderr, "kernel_launch: hipFuncSetAttribute failed\n"); grid = -1; return; }
        if (hipOccupancyMaxActiveBlocksPerMultiprocessor(&per_cu, (const void*)mk_fwd, NTHREADS, LDS_BYTES) != hipSuccess || per_cu < 1) { fprintf(stderr, "kernel_launch: occupancy query says %d blocks per CU\n", per_cu); (void)hipGetLastError(); per_cu = 1; }
        grid = cus * 1;
        fprintf(stderr, "kernel_launch: %d CUs, occupancy %d per CU, grid %d\n", cus, per_cu, grid);
    }
    if (grid < 0) return;
    if (hipMemsetAsync((char*)d_ws + WS_CTL, 0, CTL_ZERO_BYTES, stream) != hipSuccess) { fprintf(stderr, "kernel_launch: memset failed\n"); return; }
    Args a{};
    for (int i = 0; i < 21; ++i) a.in[i] = (const float*)d_in[i];
    a.out = (float*)d_out; a.ws = (unsigned char*)d_ws;
#if MK_N_LAUNCHES == 1
    a.ph_lo = 0; a.ph_hi = N_PHASES;
    void* kargs[] = {&a};
    hipError_t e = hipLaunchCooperativeKernel((const void*)mk_fwd, dim3(grid), dim3(NTHREADS), kargs, LDS_BYTES, stream);
    if (e != hipSuccess) fprintf(stderr, "kernel_launch: cooperative launch failed: %s (grid %d)\n", hipGetErrorString(e), grid);
#else
    for (int p = 0; p < N_PHASES; ++p) { a.ph_lo = p; a.ph_hi = p + 1; hipLaunchKernelGGL(mk_fwd, dim3(grid), dim3(NTHREADS), LDS_BYTES, stream, a);
        const hipError_t le = hipPeekAtLastError(); if (le != hipSuccess) { fprintf(stderr, "kernel_launch: launch %d failed: %s\n", p, hipGetErrorName(le)); break; } }
#endif
}
```

```cpp
#include <hip/hip_runtime.h>
#include <hip/hip_cooperative_groups.h>
#include <cstdio>
#include <cstdint>
namespace pg8 {
#define PG8_LAS __attribute__((address_space(3)))
typedef unsigned short bf16_t;
typedef short bf16x8 __attribute__((ext_vector_type(8)));
typedef float f32x4 __attribute__((ext_vector_type(4)));
typedef unsigned u32x4 __attribute__((ext_vector_type(4)));
constexpr int BM = 256, BK = 64, HALF = 128, HTB = HALF * BK * 2  , STAGE_BYTES = 8 * HTB, NXCD = 8, WGM = 8;

__host__ __device__ __forceinline__ int lds_byte(int r, int c) { const int st = (r >> 4) * 2 + (c >> 5), rr = r & 15, cc = c & 31, ob = rr * 64 + cc * 2; return st * 1024 + (ob ^ (((ob >> 9) & 1) << 5)); }
__host__ __device__ __forceinline__ void stage_rc(int b, int& R, int& C) { const int st = b / 1024, sb = b % 1024, swz = sb ^ (((sb >> 9) & 1) << 5); R = (st >> 1) * 16 + swz / 64; C = (st & 1) * 32 + (swz % 64) / 2; }
__host__ __device__ __forceinline__ int perm32(int rho) { const int n = rho >> 4, i = rho & 15; return 8 * (i >> 2) + 4 * n + (i & 3); }

struct Unit { int pm, pn; };
struct Gemm { const bf16_t* A; const bf16_t* Bt; int M, N, K; };

struct StaticOrder {
    int nM, nN, nwg, G, c;
    __host__ __device__ void init(int M, int N, int G_, int c_) { nM = M / BM; nN = N / BM; nwg = nM * nN; G = G_; c = c_; }
    __host__ __device__ bool next(int i, Unit& u) const {
        const long L = (long)i * G + c; if (L >= nwg) return false;
        int wgid = (int)L; { const int q = nwg / NXCD, r = nwg % NXCD, xcd = wgid % NXCD, off = wgid / NXCD; wgid = (xcd < r ? xcd * (q + 1) : r * (q + 1) + (xcd - r) * q) + off; }
        const int nig = WGM * nN, gid = wgid / nig, fm = gid * WGM, gsz = (nM - fm) < WGM ? (nM - fm) : WGM;
        u.pm = fm + ((wgid % nig) % gsz); u.pn = (wgid % nig) / gsz; return true;
    }
    static constexpr bool GATHER_A = false;
    __device__ __forceinline__ void gather(const Unit&, int, int, unsigned (&)[2][2]) const {}
    __device__ __forceinline__ void a_ready(const Unit&) const {}
    __device__ __forceinline__ void done(const Unit&) const {}
};
__device__ __forceinline__ unsigned cvt_pk_bf16(float lo, float hi) { unsigned r; asm volatile("v_cvt_pk_bf16_f32 %0, %1, %2" : "=v"(r) : "v"(lo), "v"(hi)); return r; }
typedef float f32x2 __attribute__((ext_vector_type(2)));
#ifndef EPI_B
#define EPI_B 2
#endif
__device__ __forceinline__ float sigm(float x) { return __builtin_amdgcn_rcpf(1.0f + __builtin_amdgcn_exp2f(-1.4426950408889634f * x)); }
__device__ __forceinline__ float bf_lo(unsigned w) { return __uint_as_float(w << 16); }
__device__ __forceinline__ float bf_hi(unsigned w) { return __uint_as_float(w & 0xffff0000u); }
struct EpiZ {
    static constexpr bool PERM = true, AFTER_DRAIN = false; static constexpr int MID_T = 0;
    bf16_t* O; int ldc; const float* bias; int sig_pn;
    __device__ __forceinline__ void operator()(const f32x4 (&acc)[2][2][4][2], const Unit& u, int wr, int wc, int fr, int fq) const {
        const int row0 = u.pm * BM + wr * 64 + fr, col0 = u.pn * BM + wc * 32 + 8 * fq; const bool sg = u.pn >= sig_pn;
        f32x4 bv[2][2];
#pragma unroll
        for (int bj = 0; bj < 2; ++bj)
#pragma unroll
            for (int n = 0; n < 2; ++n) bv[bj][n] = *(const f32x4*)(bias + col0 + bj * HALF + 4 * n);
#pragma unroll
        for (int ai = 0; ai < 2; ++ai)
#pragma unroll
            for (int m = 0; m < 4; ++m) { bf16_t* rowp = O + (size_t)(row0 + ai * HALF + m * 16) * ldc + col0;
#pragma unroll
                for (int bj = 0; bj < 2; ++bj) { f32x4 v0 = acc[ai][bj][m][0] + bv[bj][0], v1 = acc[ai][bj][m][1] + bv[bj][1];
                    if (sg) {
#pragma unroll
                        for (int j = 0; j < 4; ++j) { v0[j] = sigm(v0[j]); v1[j] = sigm(v1[j]); } }
                    u32x4 w; w.x = cvt_pk_bf16(v0[0], v0[1]); w.y = cvt_pk_bf16(v0[2], v0[3]); w.z = cvt_pk_bf16(v1[0], v1[1]); w.w = cvt_pk_bf16(v1[2], v1[3]);
                    *(u32x4*)(rowp + bj * HALF) = w; } }
    }
};
struct EpiMix {
    static constexpr bool PERM = true, AFTER_DRAIN = false; static constexpr int MID_T = 8;
    bf16_t* O; const bf16_t* ga; const bf16_t* gb; int ldg;
    __device__ __forceinline__ void mid(f32x4 (&acc)[2][2][4][2], const Unit& u, int wr, int wc, int fr, int fq) const {
        int row0 = u.pm * BM + wr * 64 + fr; const int col0 = u.pn * BM + wc * 32 + 8 * fq;
        asm volatile("" : "+v"(row0));
#pragma unroll
        for (int ai = 0; ai < 2; ++ai)
#pragma unroll
            for (int m0 = 0; m0 < 4; m0 += 2) {
                u32x4 a[2][2], b[2][2];
#pragma unroll
                for (int mm = 0; mm < 2; ++mm) { const size_t r = (size_t)(row0 + ai * HALF + (m0 + mm) * 16);
#pragma unroll
                    for (int bj = 0; bj < 2; ++bj) { a[mm][bj] = *(const u32x4*)(ga + r * ldg + col0 + bj * HALF); b[mm][bj] = *(const u32x4*)(gb + r * ldg + col0 + bj * HALF); } }
#pragma unroll
                for (int mm = 0; mm < 2; ++mm)
#pragma unroll
                    for (int bj = 0; bj < 2; ++bj) { const u32x4 av = a[mm][bj], bv = b[mm][bj]; f32x4& v0 = acc[ai][bj][m0 + mm][0]; f32x4& v1 = acc[ai][bj][m0 + mm][1];
                        v0[0] *= bf_lo(bv.x) * __builtin_amdgcn_rcpf(bf_lo(av.x)); v0[1] *= bf_hi(bv.x) * __builtin_amdgcn_rcpf(bf_hi(av.x)); v0[2] *= bf_lo(bv.y) * __builtin_amdgcn_rcpf(bf_lo(av.y)); v0[3] *= bf_hi(bv.y) * __builtin_amdgcn_rcpf(bf_hi(av.y));
                        v1[0] *= bf_lo(bv.z) * __builtin_amdgcn_rcpf(bf_lo(av.z)); v1[1] *= bf_hi(bv.z) * __builtin_amdgcn_rcpf(bf_hi(av.z)); v1[2] *= bf_lo(bv.w) * __builtin_amdgcn_rcpf(bf_lo(av.w)); v1[3] *= bf_hi(bv.w) * __builtin_amdgcn_rcpf(bf_hi(av.w)); }
                asm volatile("" ::: "memory"); }
    }
    __device__ __forceinline__ void operator()(const f32x4 (&acc)[2][2][4][2], const Unit& u, int wr, int wc, int fr, int fq) const {
        const int row0 = u.pm * BM + wr * 64 + fr, col0 = u.pn * BM + wc * 32 + 8 * fq;
#pragma unroll
        for (int ai = 0; ai < 2; ++ai) {
            u32x4 a[4][2];
#pragma unroll
            for (int m = 0; m < 4; ++m) { const size_t r = (size_t)(row0 + ai * HALF + m * 16);
#pragma unroll
                for (int bj = 0; bj < 2; ++bj) a[m][bj] = *(const u32x4*)(ga + r * ldg + col0 + bj * HALF); }
            asm volatile("" ::: "memory");
#pragma unroll
            for (int m = 0; m < 4; ++m) { const size_t r = (size_t)(row0 + ai * HALF + m * 16);
#pragma unroll
                for (int bj = 0; bj < 2; ++bj) { const u32x4 av = a[m][bj]; const f32x4 v0 = acc[ai][bj][m][0], v1 = acc[ai][bj][m][1];
                    u32x4 w; w.x = cvt_pk_bf16(v0[0] * bf_lo(av.x), v0[1] * bf_hi(av.x)); w.y = cvt_pk_bf16(v0[2] * bf_lo(av.y), v0[3] * bf_hi(av.y));
                    w.z = cvt_pk_bf16(v1[0] * bf_lo(av.z), v1[1] * bf_hi(av.z)); w.w = cvt_pk_bf16(v1[2] * bf_lo(av.w), v1[3] * bf_hi(av.w));
                    *(u32x4*)(O + r * 2048 + col0 + bj * HALF) = w; } }
            asm volatile("" ::: "memory"); }
    }
};
struct EpiY1 {
    static constexpr bool PERM = false, AFTER_DRAIN = false; static constexpr int MID_T = 0;
    float* Y; const float* X; const float* stats; const float* g0; const float* b0; const float* bo; float alpha;
    __device__ __forceinline__ void operator()(const f32x4 (&acc)[2][2][4][2], const Unit& u, int wr, int wc, int fr, int fq) const {
        const int row0 = u.pm * BM + wr * 64 + fr, col0 = u.pn * BM + wc * 32 + 4 * fq;
        f32x4 ag[2][2], cb[2][2];
#pragma unroll
        for (int bj = 0; bj < 2; ++bj)
#pragma unroll
            for (int n = 0; n < 2; ++n) { const int c = col0 + bj * HALF + n * 16; ag[bj][n] = *(const f32x4*)(g0 + c) * alpha; cb[bj][n] = *(const f32x4*)(b0 + c) * alpha + *(const f32x4*)(bo + c); }
#pragma unroll
        for (int ai = 0; ai < 2; ++ai)
#pragma unroll
            for (int m0 = 0; m0 < 4; m0 += EPI_B) {
                f32x4 xv[EPI_B][2][2]; float mu[EPI_B], rs[EPI_B];
#pragma unroll
                for (int mm = 0; mm < EPI_B; ++mm) { const size_t r = (size_t)(row0 + ai * HALF + (m0 + mm) * 16); mu[mm] = stats[2 * r]; rs[mm] = stats[2 * r + 1];
#pragma unroll
                    for (int bj = 0; bj < 2; ++bj)
#pragma unroll
                        for (int n = 0; n < 2; ++n) xv[mm][bj][n] = *(const f32x4*)(X + r * 2048 + col0 + bj * HALF + n * 16); }
                asm volatile("" ::: "memory");
#pragma unroll
                for (int mm = 0; mm < EPI_B; ++mm) { const size_t r = (size_t)(row0 + ai * HALF + (m0 + mm) * 16);
#pragma unroll
                    for (int bj = 0; bj < 2; ++bj)
#pragma unroll
                        for (int n = 0; n < 2; ++n) *(f32x4*)(Y + r * 2048 + col0 + bj * HALF + n * 16) = (xv[mm][bj][n] - mu[mm]) * rs[mm] * ag[bj][n] + cb[bj][n] + acc[ai][bj][m0 + mm][n]; }
                asm volatile("" ::: "memory"); }
    }
};
struct EpiSwiGLU {
    static constexpr bool PERM = true, AFTER_DRAIN = false; static constexpr int MID_T = 0;
    bf16_t* H;
    __device__ __forceinline__ void operator()(const f32x4 (&acc)[2][2][4][2], const Unit& u, int wr, int wc, int fr, int fq) const {
        const int row0 = u.pm * BM + wr * 64 + fr, col0 = (u.pn & 3) * 128 + wc * 32 + 8 * fq;
#pragma unroll
        for (int ai = 0; ai < 2; ++ai)
#pragma unroll
            for (int m = 0; m < 4; ++m) { f32x4 v0, v1;
#pragma unroll
                for (int j = 0; j < 4; ++j) { const float a = acc[ai][0][m][0][j], b = acc[ai][0][m][1][j]; v0[j] = a * sigm(a) * acc[ai][1][m][0][j]; v1[j] = b * sigm(b) * acc[ai][1][m][1][j]; }
                u32x4 w; w.x = cvt_pk_bf16(v0[0], v0[1]); w.y = cvt_pk_bf16(v0[2], v0[3]); w.z = cvt_pk_bf16(v1[0], v1[1]); w.w = cvt_pk_bf16(v1[2], v1[3]);
                *(u32x4*)(H + (size_t)(row0 + ai * HALF + m * 16) * 512 + col0) = w; }
    }
};
struct EpiYs {
    static constexpr bool PERM = true, AFTER_DRAIN = false; static constexpr int MID_T = 0;
    bf16_t* O; int ldc; int pn_mask;
    __device__ __forceinline__ void operator()(const f32x4 (&acc)[2][2][4][2], const Unit& u, int wr, int wc, int fr, int fq) const {
        const int row0 = u.pm * BM + wr * 64 + fr, col0 = (u.pn & pn_mask) * BM + wc * 32 + 8 * fq;
#pragma unroll
        for (int ai = 0; ai < 2; ++ai)
#pragma unroll
            for (int m = 0; m < 4; ++m) { bf16_t* rowp = O + (size_t)(row0 + ai * HALF + m * 16) * ldc + col0;
#pragma unroll
                for (int bj = 0; bj < 2; ++bj) { const f32x4 v0 = acc[ai][bj][m][0], v1 = acc[ai][bj][m][1];
                    u32x4 w; w.x = cvt_pk_bf16(v0[0], v0[1]); w.y = cvt_pk_bf16(v0[2], v0[3]); w.z = cvt_pk_bf16(v1[0], v1[1]); w.w = cvt_pk_bf16(v1[2], v1[3]);
                    *(u32x4*)(rowp + bj * HALF) = w; } }
    }
};
template <bool GA_, int NL2> struct MoeOrder {
    static constexpr bool GATHER_A = GA_;
    const PG8_LAS int* tab; const int* list; int G, c;
    __device__ __forceinline__ bool next(int i, Unit& u) const {
        const long L = (long)i * G + c; const int nt = __builtin_amdgcn_readfirstlane(tab[512]); if (L >= ((long)nt << NL2)) return false;
        const int j = (int)(L >> NL2), t = (int)(L & ((1 << NL2) - 1)); u.pm = j; u.pn = (__builtin_amdgcn_readfirstlane(tab[j]) << NL2) + t; return true;
    }
    __device__ __forceinline__ void gather(const Unit& u, int tid, int K, unsigned (&v)[2][2]) const {
        const int e = __builtin_amdgcn_readfirstlane(tab[u.pm]), r0 = __builtin_amdgcn_readfirstlane(tab[192 + u.pm]), n = __builtin_amdgcn_readfirstlane(tab[448 + e]);
#pragma unroll
        for (int h = 0; h < 2; ++h)
#pragma unroll
            for (int i = 0; i < 2; ++i) { int R, C; stage_rc(tid * 16 + i * 8192, R, C); const int row = r0 + 128 * h + R; const int tok = row < n ? list[(size_t)e * 16384 + row] : 0;
                v[h][i] = (unsigned)(tok * K + C) * 2u; }
    }
    __device__ __forceinline__ void a_ready(const Unit&) const {}
    __device__ __forceinline__ void done(const Unit&) const {}
};
template <class Epi, class Sched, bool ALIGN_EPI = false, bool SP2 = false>
__device__ __forceinline__ void gemm_phase(PG8_LAS unsigned char* lds, const Gemm g, const Sched& S, const Epi& E) {
    const int tid = threadIdx.x, wid = __builtin_amdgcn_readfirstlane(tid >> 6), lane = tid & 63, wr = wid >> 2, wc = wid & 3, fr = lane & 15, fq = lane >> 4;
    const int K = g.K, nt = K / BK;
    unsigned voffA[2], voffB[2];
#pragma unroll
    for (int i = 0; i < 2; ++i) { int R, C; stage_rc(tid * 16 + i * 8192, R, C); const int Rb = Epi::PERM ? ((R & ~31) + perm32(R & 31)) : R;
        voffA[i] = (unsigned)(R * K + C) * 2u; voffB[i] = (unsigned)(Rb * K + C) * 2u; }
    constexpr bool GA = Sched::GATHER_A;
    static_assert(!GA || SP2, "the gathered-A form exists for the SP2 loop only");
    unsigned vga[2][2], vgn[2][2];
    const size_t kstep = (size_t)(BK * 2);
    const size_t hstep = (size_t)HALF * K * 2;
    const size_t tstep = 2 * hstep;
    const size_t hstepA = GA ? 0 : hstep, tstepA = GA ? 0 : tstep;
    const unsigned ldsw = (unsigned)wid * 1024u;
    const int aoff = lds_byte(wr * 64 + fr, fq * 8), boff = lds_byte(wc * 32 + fr, fq * 8);
#define PG8_SA(b, h) (((b) * 2 + (h)) * HTB)
#define PG8_SB(b, h) ((4 + (b) * 2 + (h)) * HTB)
#define PG8_STAGE2(bufoff, gbase, o0, o1) do { \
        __builtin_amdgcn_global_load_lds((const unsigned*)((const char*)(gbase) + (o0)), (PG8_LAS unsigned*)(lds + (bufoff) + ldsw), 16, 0, 0); \
        __builtin_amdgcn_global_load_lds((const unsigned*)((const char*)(gbase) + (o1)), (PG8_LAS unsigned*)(lds + (bufoff) + ldsw + 8192), 16, 0, 0); } while (0)
#define PG8_STAGE(bufoff, gbase, voff) PG8_STAGE2(bufoff, gbase, (voff)[0], (voff)[1])
#define PG8_STAGE_A(bufoff, gbase, h, nx) PG8_STAGE2(bufoff, gbase, (GA ? ((nx) ? vgn[h][0] : vga[h][0]) : voffA[0]), (GA ? ((nx) ? vgn[h][1] : vga[h][1]) : voffA[1]))
#define PG8_LDA(dst, b, h) do { _Pragma("unroll") for (int m = 0; m < 4; ++m) _Pragma("unroll") for (int k = 0; k < 2; ++k) dst[m][k] = *(const PG8_LAS bf16x8*)(lds + PG8_SA(b, h) + aoff + m * 2048 + k * 1024); } while (0)
#define PG8_LDB(dst, b, h) do { _Pragma("unroll") for (int n = 0; n < 2; ++n) _Pragma("unroll") for (int k = 0; k < 2; ++k) dst[n][k] = *(const PG8_LAS bf16x8*)(lds + PG8_SB(b, h) + boff + n * 2048 + k * 1024); } while (0)
#define PG8_MMA(ai, bj, At, Bt) do { __builtin_amdgcn_s_setprio(1); _Pragma("unroll") for (int m = 0; m < 4; ++m) _Pragma("unroll") for (int n = 0; n < 2; ++n) _Pragma("unroll") for (int k = 0; k < 2; ++k) \
        acc[ai][bj][m][n] = __builtin_amdgcn_mfma_f32_16x16x32_bf16(Bt[n][k], At[m][k], acc[ai][bj][m][n], 0, 0, 0); __builtin_amdgcn_s_setprio(0); } while (0)
#define PG8_WAIT_V(n) asm volatile("s_waitcnt vmcnt(" #n ")" ::: "memory")
#define PG8_WAIT_L(n) asm volatile("s_waitcnt lgkmcnt(" #n ")" ::: "memory")
#define PG8_BAR __builtin_amdgcn_s_barrier()
#define PG8_SCHED __builtin_amdgcn_sched_barrier(0)
    Unit cur, nxt; int ui = 0;
    if (!S.next(0, cur)) return;
    f32x4 acc[2][2][4][2];
#pragma unroll
    for (int a = 0; a < 2; ++a)
#pragma unroll
        for (int b = 0; b < 2; ++b)
#pragma unroll
            for (int m = 0; m < 4; ++m)
#pragma unroll
                for (int n = 0; n < 2; ++n) acc[a][b][m][n] = (f32x4){0.f, 0.f, 0.f, 0.f};
    bf16x8 At[4][2], B0[2][2], B1[2][2];
    const char* cA = (const char*)g.A + (size_t)cur.pm * tstepA; const char* cB = (const char*)g.Bt + (size_t)cur.pn * tstep;
    S.a_ready(cur);
    if constexpr (GA) S.gather(cur, tid, K, vga);
    if constexpr (SP2) {
        PG8_STAGE(PG8_SB(0, 0), cB, voffB); PG8_STAGE(PG8_SB(0, 1), cB + hstep, voffB); PG8_STAGE_A(PG8_SA(0, 0), cA, 0, false); PG8_STAGE_A(PG8_SA(0, 1), cA + hstepA, 1, false);
        if (wr == 1) PG8_BAR;
        PG8_WAIT_V(2); PG8_BAR;
        PG8_STAGE(PG8_SB(1, 0), cB + kstep, voffB); PG8_STAGE_A(PG8_SA(1, 0), cA + kstep, 0, false); PG8_STAGE(PG8_SB(1, 1), cB + hstep + kstep, voffB);
        PG8_WAIT_V(6); PG8_BAR;
    } else {
        PG8_STAGE(PG8_SB(0, 0), cB, voffB); PG8_STAGE(PG8_SA(0, 0), cA, voffA); PG8_STAGE(PG8_SB(0, 1), cB + hstep, voffB); PG8_STAGE(PG8_SA(0, 1), cA + hstep, voffA);
        if (wr == 1) PG8_BAR;
        PG8_WAIT_V(4); PG8_BAR;
        PG8_STAGE(PG8_SB(1, 0), cB + kstep, voffB); PG8_STAGE(PG8_SA(1, 0), cA + kstep, voffA); PG8_STAGE(PG8_SB(1, 1), cB + hstep + kstep, voffB);
        PG8_WAIT_V(6); PG8_BAR;
    }
    for (;;) {
        const bool has_next = S.next(ui + 1, nxt);
        if constexpr (GA) { if (has_next) S.gather(nxt, tid, K, vgn); else { vgn[0][0] = vga[0][0]; vgn[0][1] = vga[0][1]; vgn[1][0] = vga[1][0]; vgn[1][1] = vga[1][1]; } }
        const char* nA = has_next ? (const char*)g.A + (size_t)nxt.pm * tstepA : cA; const char* nB = has_next ? (const char*)g.Bt + (size_t)nxt.pn * tstep : cB;
        for (int t = 0; t < nt; t += 2) {
            const bool last = (t == nt - 2);
            const char* a1 = cA + (size_t)(t + 1) * kstep;
            const char* a2 = last ? nA : cA + (size_t)(t + 2) * kstep; const char* b2 = last ? nB : cB + (size_t)(t + 2) * kstep;
            const char* a3 = a2 + kstep; const char* b3 = b2 + kstep;
            if (last && has_next) S.a_ready(nxt);
            if constexpr (Epi::MID_T > 0) { if (t == Epi::MID_T) E.mid(acc, cur, wr, wc, fr, fq); }
            if constexpr (SP2) {
            PG8_LDB(B0, 0, 0); PG8_LDB(B1, 0, 1); PG8_SCHED; PG8_LDA(At, 0, 0); PG8_STAGE_A(PG8_SA(1, 1), a1 + hstepA, 1, false);
            PG8_WAIT_V(8); PG8_WAIT_L(0); PG8_BAR; PG8_MMA(0, 0, At, B0); PG8_MMA(0, 1, At, B1); PG8_BAR; PG8_SCHED;
            PG8_LDA(At, 0, 1); PG8_STAGE(PG8_SB(0, 0), b2, voffB); PG8_STAGE(PG8_SB(0, 1), b2 + hstep, voffB); PG8_STAGE_A(PG8_SA(0, 0), a2, 0, last);
            PG8_WAIT_V(8); PG8_WAIT_L(0); PG8_BAR; PG8_MMA(1, 0, At, B0); PG8_MMA(1, 1, At, B1); PG8_BAR; PG8_SCHED;
            PG8_LDB(B0, 1, 0); PG8_LDB(B1, 1, 1); PG8_SCHED; PG8_LDA(At, 1, 0); PG8_STAGE_A(PG8_SA(0, 1), a2 + hstepA, 1, last);
            PG8_WAIT_V(8); PG8_WAIT_L(0); PG8_BAR; PG8_MMA(0, 0, At, B0); PG8_MMA(0, 1, At, B1); PG8_BAR; PG8_SCHED;
            PG8_LDA(At, 1, 1); PG8_STAGE(PG8_SB(1, 0), b3, voffB); PG8_STAGE(PG8_SB(1, 1), b3 + hstep, voffB); PG8_STAGE_A(PG8_SA(1, 0), a3, 0, last);
            PG8_WAIT_V(8); PG8_WAIT_L(0); PG8_BAR; PG8_MMA(1, 0, At, B0); PG8_MMA(1, 1, At, B1); PG8_BAR; PG8_SCHED;
            } else {
            PG8_LDB(B0, 0, 0); PG8_SCHED; PG8_LDA(At, 0, 0); PG8_STAGE(PG8_SA(1, 1), a1 + hstep, voffA);
            PG8_WAIT_L(8); PG8_BAR; PG8_WAIT_L(0); PG8_MMA(0, 0, At, B0); PG8_BAR; PG8_SCHED;
            PG8_LDB(B1, 0, 1); PG8_STAGE(PG8_SB(0, 0), b2, voffB);
            PG8_BAR; PG8_WAIT_L(0); PG8_MMA(0, 1, At, B1); PG8_BAR;
            PG8_LDA(At, 0, 1); PG8_STAGE(PG8_SA(0, 0), a2, voffA);
            PG8_BAR; PG8_WAIT_L(0); PG8_MMA(1, 0, At, B0); PG8_BAR; PG8_SCHED;
            PG8_STAGE(PG8_SB(0, 1), b2 + hstep, voffB);
            PG8_WAIT_V(6); PG8_BAR; PG8_MMA(1, 1, At, B1); PG8_BAR;
            PG8_LDB(B0, 1, 0); PG8_SCHED; PG8_LDA(At, 1, 0); PG8_STAGE(PG8_SA(0, 1), a2 + hstep, voffA);
            PG8_WAIT_L(8); PG8_BAR; PG8_WAIT_L(0); PG8_MMA(0, 0, At, B0); PG8_BAR; PG8_SCHED;
            PG8_LDB(B1, 1, 1); PG8_STAGE(PG8_SB(1, 0), b3, voffB);
            PG8_BAR; PG8_WAIT_L(0); PG8_MMA(0, 1, At, B1); PG8_BAR;
            PG8_LDA(At, 1, 1); PG8_STAGE(PG8_SA(1, 0), a3, voffA);
            PG8_BAR; PG8_WAIT_L(0); PG8_MMA(1, 0, At, B0); PG8_BAR; PG8_SCHED;
            PG8_STAGE(PG8_SB(1, 1), b3 + hstep, voffB);
            PG8_WAIT_V(6); PG8_BAR; PG8_MMA(1, 1, At, B1); PG8_BAR;
            }
        }
        if constexpr (ALIGN_EPI) { if (wr == 0) PG8_BAR; }
        if constexpr (!Epi::AFTER_DRAIN) { E(acc, cur, wr, wc, fr, fq); S.done(cur); }
        if (!has_next) break;
#pragma unroll
        for (int a = 0; a < 2; ++a)
#pragma unroll
            for (int b = 0; b < 2; ++b)
#pragma unroll
                for (int m = 0; m < 4; ++m)
#pragma unroll
                    for (int n = 0; n < 2; ++n) acc[a][b][m][n] = (f32x4){0.f, 0.f, 0.f, 0.f};
        cur = nxt; cA = nA; cB = nB; ++ui;
        if constexpr (GA) { vga[0][0] = vgn[0][0]; vga[0][1] = vgn[0][1]; vga[1][0] = vgn[1][0]; vga[1][1] = vgn[1][1]; }
        if constexpr (ALIGN_EPI) { if (wr == 1) PG8_BAR; }
    }
    PG8_WAIT_V(0);
    if constexpr (!ALIGN_EPI) { if (wr == 0) PG8_BAR; }
    PG8_BAR;
    if constexpr (Epi::AFTER_DRAIN) { E.fused(acc, cur, wr, wc, fr, fq, lds, wid, lane); S.done(cur); }
#undef PG8_STAGE_A
#undef PG8_STAGE2
#undef PG8_SA
#undef PG8_SB
#undef PG8_STAGE
#undef PG8_LDA
#undef PG8_LDB
#undef PG8_MMA
#undef PG8_WAIT_V
#undef PG8_WAIT_L
#undef PG8_BAR
#undef PG8_SCHED
}
}

#ifndef MK_N_LAUNCHES
#define MK_N_LAUNCHES 1
#endif
namespace cg = cooperative_groups;
#define GAS __attribute__((address_space(1)))
#define LAS __attribute__((address_space(3)))
typedef unsigned short bf16;
typedef unsigned u32x4 __attribute__((ext_vector_type(4)));
typedef unsigned u32x2 __attribute__((ext_vector_type(2)));
typedef float f32x4 __attribute__((ext_vector_type(4)));
typedef float f32x2 __attribute__((ext_vector_type(2)));
typedef short bf16x8 __attribute__((ext_vector_type(8)));
typedef short s16x4 __attribute__((ext_vector_type(4)));
typedef __bf16 bf16v2 __attribute__((ext_vector_type(2)));

constexpr int NWAVES = 8, NTHREADS = 512;
constexpr int BATCH = 2, SEQ = 8192, DM = 2048, MTOK = BATCH * SEQ;
constexpr int DIN = 11776, OFF_QA = 0, OFF_KA = 1024, OFF_VA = 2048, OFF_QB = 3072, OFF_KB = 4608, OFF_VB = 6144, OFF_GA = 7680, OFF_GB = 9728;
constexpr int GRID_W = 64, GRID_ROWS = SEQ / GRID_W, NA_HEADS = 8, DIL_HEADS = 12;
constexpr int NEXP = 64, DEXP = 512, PMAX = 49152, MAXTILES = PMAX / 256;
constexpr float LN_EPS = 1e-5f, DN_ALPHA = 1.189207115002721f, ATT_SCALE = 0.08838834764831845f;
constexpr int NRW = 80;
#ifndef MOE_HELPER_ITEMS
#define MOE_HELPER_ITEMS 3584
#endif
constexpr size_t MiB = 1u << 20, KiB = 1u << 10;
constexpr size_t WS_CTL = 0, WS_BAR = 16384, CTL_ZERO_BYTES = 65536;
constexpr size_t WS_STATS0 = 1 * MiB, WS_STATS1 = 1 * MiB + 128 * KiB, WS_TOKE = 1 * MiB + 256 * KiB, WS_TOKW = 1 * MiB + 384 * KiB, WS_TOKP = 1 * MiB + 512 * KiB, WS_TOKS = 1 * MiB + 640 * KiB, WS_TILE = 1 * MiB + 768 * KiB;
constexpr size_t WS_LSE = 2 * MiB;
constexpr size_t WS_WRH = 3 * MiB, WS_WRL = 3 * MiB + 512 * KiB;
constexpr size_t WS_WIN = 4 * MiB, WS_WAB = 50 * MiB, WS_WO = 56 * MiB;
constexpr size_t WS_ACT = 64 * MiB;
constexpr size_t WS_ATT = 128 * MiB, WS_DILG = 176 * MiB;
constexpr int ATT_LD = 1536;
constexpr size_t WS_Z = 224 * MiB;
constexpr size_t WS_WUP = 592 * MiB, WS_WDN = 848 * MiB, WS_LIST = 976 * MiB, WS_END = 980 * MiB;
constexpr size_t WS_HID = 416 * MiB, WS_YS = 224 * MiB, WS_LO = 464 * MiB;
static_assert(WS_WIN + (size_t)DIN * DM * 2 <= WS_WAB && WS_ATT + (size_t)MTOK * ATT_LD * 2 <= WS_DILG && WS_DILG + (size_t)3 * MTOK * 512 * 2 <= WS_Z && WS_Z + (size_t)MTOK * DIN * 2 <= WS_WUP && WS_YS + (size_t)PMAX * DM * 2 <= WS_HID && WS_HID + (size_t)PMAX * DEXP * 2 <= WS_LO && WS_LO + (size_t)MTOK * DM * 2 <= WS_WUP, "ws map");
constexpr int RING_BYTES = 131072, RPB_OFF = 147456, XB_LDS_OFF = 147456 + 15360, LDS_BYTES = 163840;
#ifndef CG_SEAM_MASK
#define CG_SEAM_MASK 1
#endif

__device__ __forceinline__ unsigned pk2(float lo, float hi) { f32x2 v = {lo, hi}; bf16v2 b = __builtin_convertvector(v, bf16v2); return __builtin_bit_cast(unsigned, b); }
__device__ __forceinline__ float bfl(unsigned w) { return __uint_as_float(w << 16); }
__device__ __forceinline__ float bfh(unsigned w) { return __uint_as_float(w & 0xffff0000u); }
__device__ __forceinline__ float wave_sum(float v) {
#pragma unroll
    for (int o = 1; o < 64; o <<= 1) v += __shfl_xor(v, o);
    return v;
}
#define LDS_WAIT() asm volatile("s_waitcnt lgkmcnt(0)" ::: "memory")
#define VM_WAIT() asm volatile("s_waitcnt vmcnt(0)" ::: "memory")

struct Args { const float* in[21]; float* out; unsigned char* ws; int ph_lo, ph_hi; };
enum { IN_X = 0, IN_LN0G, IN_LN0B, IN_WIN, IN_BIN, IN_RPB, IN_WPA, IN_WPB, IN_WO, IN_BO, IN_LN1G, IN_LN1B, IN_WRG, IN_BRG, IN_WRE, IN_BRE, IN_WG, IN_WU, IN_WD, IN_LN2G, IN_LN2B };

__device__ __forceinline__ unsigned xv_(unsigned row) { return ((row & 3u) << 2) | ((row >> 2) & 3u); }
__device__ __forceinline__ void p0_transpose_item(const float* W, int N, int K, bf16* WT, long dst_row0, int k0, int n0, LAS float* scr, int lane, int kdst = 0) {
#pragma unroll 8
    for (int i = 0; i < 32; ++i) { const int kk = 2 * i + (lane >> 5); scr[kk * 33 + (lane & 31)] = W[(size_t)(k0 + kk) * N + n0 + (lane & 31)]; }
    LDS_WAIT();
    const int c = lane & 7;
#pragma unroll
    for (int j = 0; j < 4; ++j) { const int n = (lane >> 3) + 8 * j; const LAS float* s = scr + (8 * c) * 33 + n;
        u32x4 o; o.x = pk2(s[0 * 33], s[1 * 33]); o.y = pk2(s[2 * 33], s[3 * 33]); o.z = pk2(s[4 * 33], s[5 * 33]); o.w = pk2(s[6 * 33], s[7 * 33]);
        *(u32x4*)(WT + (size_t)(dst_row0 + n) * K + kdst + k0 + 8 * c) = o; }
    LDS_WAIT();
}
__device__ __forceinline__ void p0_prologue(const Args& a, LAS unsigned char* lds, int gw, int NGW, int wave, int lane) {
    LAS float* scr = (LAS float*)(lds + wave * 16384);
    unsigned char* ws = a.ws;
    constexpr int I0 = 32 * 368, I1 = 16 * 64, I2 = 8 * 64, I3 = 32 * 64, I4 = NEXP * 32 * 16, I5 = I4, I6 = NEXP * 8 * 64;
    constexpr int NITEMS = I0 + I1 + I2 + I3 + I4 + I5 + I6;
    for (int it = gw; it < NITEMS; it += NGW) {
        int r = it;
        if (r < I0) { const int kb = r / 368, nb = r % 368; p0_transpose_item(a.in[IN_WIN], DIN, DM, (bf16*)(ws + WS_WIN), 32 * nb, 64 * kb, 32 * nb, scr, lane); continue; } r -= I0;
        if (r < I1) { const int kb = r / 64, nb = r % 64; p0_transpose_item(a.in[IN_WPA], DM, ATT_LD, (bf16*)(ws + WS_WAB), 32 * nb, 64 * kb, 32 * nb, scr, lane, 512); continue; } r -= I1;
        if (r < I2) { const int kb = r / 64, nb = r % 64; p0_transpose_item(a.in[IN_WPB], DM, ATT_LD, (bf16*)(ws + WS_WAB), 32 * nb, 64 * kb, 32 * nb, scr, lane, 0); continue; } r -= I2;
        if (r < I3) { const int kb = r / 64, nb = r % 64; p0_transpose_item(a.in[IN_WO], DM, DM, (bf16*)(ws + WS_WO), 32 * nb, 64 * kb, 32 * nb, scr, lane); continue; } r -= I3;
        if (r < I4 + I5) { const int mat = r >= I4; if (mat) r -= I4; const int e = r / 512, q = r % 512, kb = q / 16, nb = q % 16, n0 = 32 * nb;
            const float* W = (mat ? a.in[IN_WU] : a.in[IN_WG]) + (size_t)e * DM * DEXP;
            p0_transpose_item(W, DEXP, DM, (bf16*)(ws + WS_WUP), (long)e * 1024 + (n0 >> 7) * 256 + mat * 128 + (n0 & 127), 64 * kb, n0, scr, lane); continue; } r -= I4 + I5;
        { const int e = r / 512, q = r % 512, kb = q / 64, nb = q % 64;
            p0_transpose_item(a.in[IN_WD] + (size_t)e * DEXP * DM, DM, DEXP, (bf16*)(ws + WS_WDN), (long)e * 2048 + 32 * nb, 64 * kb, 32 * nb, scr, lane); }
    }
    { bf16* wh = (bf16*)(ws + WS_WRH); bf16* wl = (bf16*)(ws + WS_WRL);
      for (int i = gw * 64 + lane; i < NRW * DM; i += NGW * 64) { const int n = i / DM, k = i % DM;
          const float v = n < 8 ? a.in[IN_WRG][(size_t)k * 8 + n] : (n < 72 ? a.in[IN_WRE][(size_t)k * 64 + (n - 8)] : 0.f);
          const unsigned h = pk2(v, 0.f) & 0xffffu; const float r = v - __uint_as_float(h << 16);
          wh[i] = (bf16)h; wl[i] = (bf16)(pk2(r, 0.f) & 0xffffu); } }
    { const float* g = a.in[IN_LN0G]; const float* bb = a.in[IN_LN0B]; float* st = (float*)(ws + WS_STATS0); bf16* H = (bf16*)(ws + WS_ACT);
      f32x4 gv[8], bv[8];
#pragma unroll
      for (int j = 0; j < 8; ++j) { gv[j] = *(const f32x4*)(g + 256 * j + 4 * lane); bv[j] = *(const f32x4*)(bb + 256 * j + 4 * lane); }
      for (int m = gw; m < MTOK; m += NGW) {
          const float* xr = a.in[IN_X] + (size_t)m * DM + 4 * lane; f32x4 v[8]; float s = 0.f;
#pragma unroll
          for (int j = 0; j < 8; ++j) { v[j] = *(const f32x4*)(xr + 256 * j); s += (v[j].x + v[j].y) + (v[j].z + v[j].w); }
          const float mean = wave_sum(s) * (1.f / DM); float s2 = 0.f;
#pragma unroll
          for (int j = 0; j < 8; ++j) { v[j] = v[j] - mean; s2 += (v[j].x * v[j].x + v[j].y * v[j].y) + (v[j].z * v[j].z + v[j].w * v[j].w); }
          const float rstd = 1.0f / sqrtf(wave_sum(s2) * (1.f / DM) + LN_EPS);
          if (lane == 0) { st[2 * m] = mean; st[2 * m + 1] = rstd; }
          bf16* orow = H + (size_t)m * DM + 4 * lane;
#pragma unroll
          for (int j = 0; j < 8; ++j) { const f32x4 y = v[j] * rstd * gv[j] + bv[j]; u32x2 w; w.x = pk2(y.x, y.y); w.y = pk2(y.z, y.w); *(u32x2*)(orow + 256 * j) = w; }
      } }
}
#define XB_TMO      128
#define XB_XCNT(j)  (256  + 64 * (j))
#define XB_XSUB(j)  (1280 + 64 * (j))
#define XB_XGEN(j)  (2304 + 64 * (j))
#define XB_TOP      3328
#define XB_TOPGEN   3392
#define XCD_BAR_WORDS 3456
#define XB_SPIN_CAP (1u << 18)

__device__ __forceinline__ unsigned xb_ld(unsigned* p)              { return __hip_atomic_load(p, __ATOMIC_RELAXED, __HIP_MEMORY_SCOPE_AGENT); }
__device__ __forceinline__ unsigned xb_add(unsigned* p, unsigned v) { return __hip_atomic_fetch_add(p, v, __ATOMIC_RELAXED, __HIP_MEMORY_SCOPE_AGENT); }
__device__ __forceinline__ unsigned xb_xcc_id() { return (unsigned)__builtin_amdgcn_s_getreg((3 << 11) | 20) & 0xFu; }
#define XB_SPIN(cond, bar) do { unsigned _sp = 0; while (cond) { __builtin_amdgcn_s_sleep(1); \
    if ((++_sp & 255u) == 0u) { if (xb_ld(&(bar)[XB_TMO])) break; if (_sp > XB_SPIN_CAP) { atomicAdd(&(bar)[XB_TMO], 1u); break; } } } } while (0)

struct XcdBarrier {
    unsigned* bar; unsigned x;
    volatile LAS unsigned* st;
};

__device__ __forceinline__ XcdBarrier xcd_barrier_post(unsigned* bar, volatile LAS unsigned* st) {
    XcdBarrier b; b.bar = bar; b.x = xb_xcc_id(); b.st = st;
    if (threadIdx.x == 0) (void)xb_add(&bar[XB_XCNT(b.x)], 1u);
    return b;
}
__device__ __forceinline__ void xcd_barrier_complete(unsigned* bar, unsigned x, unsigned& nloc, unsigned& nx) {
    const unsigned G = gridDim.x * gridDim.y * gridDim.z;
    unsigned sum, cnt, mine, sp = 0u;
    for (;;) {
        sum = 0u; cnt = 0u; mine = 0u;
#pragma unroll
        for (unsigned j = 0; j < 16; ++j) { const unsigned c = xb_ld(&bar[XB_XCNT(j)]); sum += c; cnt += (c > 0u) ? 1u : 0u; mine = (j == x) ? c : mine; }
        if (sum == G) break;
        __builtin_amdgcn_s_sleep(1);
        if ((++sp & 255u) == 0u) { if (xb_ld(&bar[XB_TMO])) break; if (sp > XB_SPIN_CAP) { atomicAdd(&bar[XB_TMO], 1u); break; } }
    }
    nloc = mine > 0u ? mine : 1u; nx = cnt > 0u ? cnt : 1u;
}

__device__ __forceinline__ void xcd_barrier(const XcdBarrier& b) {
    asm volatile("s_waitcnt vmcnt(0)" ::: "memory");
    __syncthreads();
    if (threadIdx.x == 0) {
        unsigned* bar = b.bar;
        __builtin_amdgcn_s_waitcnt(0);
        unsigned nloc = b.st[0], nx = b.st[1];
        if (nloc == 0u) { xcd_barrier_complete(bar, b.x, nloc, nx); b.st[0] = nloc; b.st[1] = nx; }
        const unsigned old = xb_add(&bar[XB_XSUB(b.x)], 1u);
        const unsigned gen = old / nloc;
        if (old + 1u == (gen + 1u) * nloc) {
            __builtin_amdgcn_fence(__ATOMIC_RELEASE, "agent");
            asm volatile("s_waitcnt vmcnt(0)" ::: "memory");
            const unsigned og = xb_add(&bar[XB_TOP], 1u);
            const unsigned tg = og / nx;
            if (og + 1u == (tg + 1u) * nx) xb_add(&bar[XB_TOPGEN], 1u);
            else XB_SPIN(xb_ld(&bar[XB_TOPGEN]) == tg, bar);
            __builtin_amdgcn_fence(__ATOMIC_ACQUIRE, "agent");
            xb_add(&bar[XB_XGEN(b.x)], 1u);
            asm volatile("s_waitcnt vmcnt(0)" ::: "memory");
        } else {
            XB_SPIN(xb_ld(&bar[XB_XGEN(b.x)]) == gen, bar);
            __builtin_amdgcn_fence(__ATOMIC_ACQUIRE, "agent");
            asm volatile("s_waitcnt vmcnt(0)" ::: "memory");
        }
    }
    __syncthreads();
}

__device__ __forceinline__ unsigned xk_(unsigned row) { return (row & 3u) | (((row >> 3) & 3u) << 2); }
constexpr int ATT_RING = 147456;
constexpr int DIL_V_OFF = 69632;

struct NaFix { int c, r, start, kc0; const LAS float* rpb;
    __device__ __forceinline__ float operator()(float s, int ks, int idx, int q) const {
        const int kcol = kc0 + idx, qcol = 16 * c + q; int qcs = qcol - 8; qcs = qcs < 0 ? 0 : (qcs > 48 ? 48 : qcs);
        int dc = kcol - qcol + 15; dc = dc < 0 ? 0 : (dc > 30 ? 30 : dc);
        const float bias = rpb[(start + ks - r + 7) * 31 + dc];
        return (kcol >= qcs && kcol < qcs + 16) ? s * ATT_SCALE + bias : -INFINITY; } };
struct DilFix { int pq0, L; float slope_d;
    __device__ __forceinline__ float operator()(float s, int ks, int idx, int q) const {
        const int rel = -64 + 32 * ks + idx - q, pk = pq0 - 64 + 32 * ks + idx; const int ar = rel < 0 ? -rel : rel;
        return (ar <= 64 && pk >= 0 && pk < L) ? s * ATT_SCALE - slope_d * (float)ar : -INFINITY; } };

template <int NKS, int KSTRIDE>
__device__ __forceinline__ void att_qk(const LAS unsigned char* kimg, int kbase, const bf16* qrow, int lane, f32x4 (&s)[NKS][2]) {
    const int q = lane & 15, g = lane >> 4;
    bf16x8 qf[4];
#pragma unroll
    for (int dk = 0; dk < 4; ++dk) qf[dk] = *(const bf16x8*)(qrow + 8 * g + 32 * dk);
    const unsigned row0 = (unsigned)(kbase + 8 * (q >> 2) + (q & 3));
    const unsigned b0 = 256u * row0 + 16u * ((unsigned)g ^ xk_(row0));
#pragma unroll
    for (int ks = 0; ks < NKS; ++ks)
#pragma unroll
        for (int blk = 0; blk < 2; ++blk) {
            const unsigned b = b0 + 256u * (unsigned)(ks * KSTRIDE + 4 * blk);
            f32x4 acc = {0.f, 0.f, 0.f, 0.f};
#pragma unroll
            for (int dk = 0; dk < 4; ++dk) { const bf16x8 kf = *(const LAS bf16x8*)(kimg + (b ^ (64u * dk))); acc = __builtin_amdgcn_mfma_f32_16x16x32_bf16(kf, qf[dk], acc, 0, 0, 0); }
            s[ks][blk] = acc;
        }
}
template <int NKS, class FIX>
__device__ __forceinline__ void att_softmax(const FIX& fix, int lane, f32x4 (&s)[NKS][2], u32x4 (&pw)[NKS], float& lse) {
    const int q = lane & 15, g = lane >> 4;
    float mx = -INFINITY;
#pragma unroll
    for (int ks = 0; ks < NKS; ++ks)
#pragma unroll
        for (int blk = 0; blk < 2; ++blk)
#pragma unroll
            for (int r = 0; r < 4; ++r) { const float v = fix(s[ks][blk][r], ks, 8 * g + 4 * blk + r, q); s[ks][blk][r] = v; mx = fmaxf(mx, v); }
    mx = fmaxf(mx, __shfl_xor(mx, 16)); mx = fmaxf(mx, __shfl_xor(mx, 32));
    float sum = 0.f;
#pragma unroll
    for (int ks = 0; ks < NKS; ++ks)
#pragma unroll
        for (int blk = 0; blk < 2; ++blk)
#pragma unroll
            for (int r = 0; r < 4; ++r) { const float p = __builtin_amdgcn_exp2f((s[ks][blk][r] - mx) * 1.4426950408889634f); s[ks][blk][r] = p; sum += p; }
    sum += __shfl_xor(sum, 16); sum += __shfl_xor(sum, 32);
    lse = mx + __logf(sum);
    const float inv = 1.0f / sum;
#pragma unroll
    for (int ks = 0; ks < NKS; ++ks) { pw[ks].x = pk2(s[ks][0][0] * inv, s[ks][0][1] * inv); pw[ks].y = pk2(s[ks][0][2] * inv, s[ks][0][3] * inv); pw[ks].z = pk2(s[ks][1][0] * inv, s[ks][1][1] * inv); pw[ks].w = pk2(s[ks][1][2] * inv, s[ks][1][3] * inv);
        asm volatile("" : "+v"(pw[ks].x), "+v"(pw[ks].y), "+v"(pw[ks].z), "+v"(pw[ks].w)); }
}
template <int NKS, int KSTRIDE>
__device__ __forceinline__ void att_pv(const LAS unsigned char* vimg, int vbase, int lane, const u32x4 (&pw)[NKS], f32x4 (&o)[8]) {
    const unsigned g = lane >> 4, qq = (lane & 15) >> 2, p = lane & 3;
    unsigned tra[2];
#pragma unroll
    for (int t = 0; t < 2; ++t) { const unsigned row = (unsigned)vbase + 8u * g + 4u * t + qq; tra[t] = 256u * row + 16u * (xv_(row) ^ (p >> 1)) + 8u * (p & 1); }
#pragma unroll
    for (int c = 0; c < 8; ++c) o[c] = (f32x4){0.f, 0.f, 0.f, 0.f};
#pragma unroll
    for (int ks = 0; ks < NKS; ++ks) {
        const bf16x8 pf = __builtin_bit_cast(bf16x8, pw[ks]);
#pragma unroll
        for (int c = 0; c < 8; ++c) {
            const s16x4 t0 = __builtin_amdgcn_ds_read_tr16_b64_v4i16((LAS s16x4*)(vimg + ((tra[0] + 256u * (unsigned)(ks * KSTRIDE)) ^ (32u * c))));
            const s16x4 t1 = __builtin_amdgcn_ds_read_tr16_b64_v4i16((LAS s16x4*)(vimg + ((tra[1] + 256u * (unsigned)(ks * KSTRIDE)) ^ (32u * c))));
            const bf16x8 vf = __builtin_shufflevector(t0, t1, 0, 1, 2, 3, 4, 5, 6, 7);
            o[c] = __builtin_amdgcn_mfma_f32_16x16x32_bf16(vf, pf, o[c], 0, 0, 0);
        }
    }
}
#define ATT_GLDS(src_, dst_) __builtin_amdgcn_global_load_lds((const unsigned*)(src_), (LAS unsigned*)(dst_), 16, 0, 0)
__device__ __forceinline__ void p2_attention(const Args& a, LAS unsigned char* lds, int wave, int lane) {
    unsigned char* ws = a.ws; const bf16* z = (const bf16*)(ws + WS_Z);
    LAS float* rpb = (LAS float*)(lds + RPB_OFF);
    for (int i = threadIdx.x; i < NA_HEADS * 465; i += NTHREADS) rpb[i] = a.in[IN_RPB][i];
    __syncthreads();
    const int G = gridDim.x, bx = blockIdx.x, vcu = (G % 8 == 0) ? (bx % 8) * (G / 8) + bx / 8 : bx;
    constexpr int N_NA = BATCH * NA_HEADS * (GRID_ROWS / 2), N_DIL = DIL_HEADS * BATCH * 64;
    for (int it = vcu; it < N_NA + N_DIL; it += G) {
        asm volatile("" : "+v"(lane));
        const int q = lane & 15, g = lane >> 4, vrow = lane >> 4, slot = lane & 15;
        f32x4 o[8]; float lse;
        if (it < N_NA) {
            const int rp = it & 63, h = (it >> 6) & 7, b = it >> 9, r0 = 2 * rp;
            int st0 = r0 - 4; st0 = st0 < 0 ? 0 : (st0 > GRID_ROWS - 8 ? GRID_ROWS - 8 : st0);
            const bf16* zb = z + (size_t)b * SEQ * DIN;
            const int c = wave & 3, r = r0 + (wave >> 2); int st = r - 4; st = st < 0 ? 0 : (st > GRID_ROWS - 8 ? GRID_ROWS - 8 : st);
            int kc = 16 * c - 8; kc = kc < 0 ? 0 : (kc > 32 ? 32 : kc);
            const int base = (st - st0) * 64 + kc;
#pragma unroll 2
            for (int pc = wave; pc < 144; pc += 8) { const unsigned row = 4u * pc + vrow; int kr = st0 + (int)(row >> 6); kr = kr > GRID_ROWS - 1 ? GRID_ROWS - 1 : kr;
                ATT_GLDS(zb + (size_t)(kr * GRID_W + (int)(row & 63)) * DIN + OFF_KA + h * 128 + 8 * (slot ^ xk_(row)), lds + pc * 1024); }
            const bf16* qrow = zb + (size_t)(r * GRID_W + 16 * c + q) * DIN + OFF_QA + h * 128;
            f32x4 s[8][2]; u32x4 pw[8];
            VM_WAIT(); __syncthreads();
            att_qk<8, 64>(lds, base, qrow, lane, s);
            __syncthreads();
#pragma unroll 2
            for (int pc = wave; pc < 144; pc += 8) { const unsigned row = 4u * pc + vrow; int kr = st0 + (int)(row >> 6); kr = kr > GRID_ROWS - 1 ? GRID_ROWS - 1 : kr;
                ATT_GLDS(zb + (size_t)(kr * GRID_W + (int)(row & 63)) * DIN + OFF_VA + h * 128 + 8 * (slot ^ xv_(row)), lds + pc * 1024); }
            NaFix fx; fx.c = c; fx.r = r; fx.start = st; fx.kc0 = kc; fx.rpb = rpb + h * 465;
            att_softmax<8>(fx, lane, s, pw, lse);
            VM_WAIT(); __syncthreads();
            att_pv<8, 64>(lds, base, lane, pw, o);
            bf16* orow = (bf16*)(ws + WS_ATT) + (size_t)(b * SEQ + r * GRID_W + 16 * c + q) * ATT_LD + 512 + h * 128 + 4 * g;
#pragma unroll
            for (int cc = 0; cc < 8; ++cc) { u32x2 w; w.x = pk2(o[cc][0], o[cc][1]); w.y = pk2(o[cc][2], o[cc][3]); *(u32x2*)(orow + 16 * cc) = w; }
            __syncthreads();
        } else {
            const int j = it - N_NA, blk = j & 63, b = (j >> 6) & 1, hd = j >> 7;
            const int grp = hd >> 2, hslot = hd & 3, d = grp == 0 ? 1 : (grp == 1 ? 4 : 16), L = SEQ / d, nb = L / 128, res = blk / nb, n = blk % nb;
            const bf16* zb = z + (size_t)b * SEQ * DIN;
            const int p0 = n * 128 - 64;
#pragma unroll 2
            for (int pc = wave; pc < 68; pc += 8) { const unsigned row = 4u * pc + vrow; int p = p0 + (int)row; p = p < 0 ? 0 : (p > L - 1 ? L - 1 : p);
                ATT_GLDS(zb + (size_t)(p * d + res) * DIN + OFF_KB + hd * 128 + 8 * (slot ^ xk_(row)), lds + pc * 1024); }
#pragma unroll 2
            for (int pc = wave; pc < 68; pc += 8) { const unsigned row = 4u * pc + vrow; int p = p0 + (int)row; p = p < 0 ? 0 : (p > L - 1 ? L - 1 : p);
                ATT_GLDS(zb + (size_t)(p * d + res) * DIN + OFF_VB + hd * 128 + 8 * (slot ^ xv_(row)), lds + DIL_V_OFF + pc * 1024); }
            const int pq0 = n * 128 + 16 * wave;
            const bf16* qrow = zb + (size_t)((pq0 + q) * d + res) * DIN + OFF_QB + hd * 128;
            f32x4 s[5][2]; u32x4 pw[5];
            VM_WAIT(); __syncthreads();
            att_qk<5, 32>(lds, 16 * wave, qrow, lane, s);
            DilFix fx; fx.pq0 = pq0; fx.L = L; fx.slope_d = exp2f(-8.0f * (float)(hd + 1) / 12.0f) * (float)d;
            att_softmax<5>(fx, lane, s, pw, lse);
            att_pv<5, 32>(lds + DIL_V_OFF, 16 * wave, lane, pw, o);
            const size_t row = (size_t)b * SEQ + (size_t)(pq0 + q) * d + res;
            bf16* orow = (bf16*)(ws + WS_DILG) + ((size_t)grp * MTOK + row) * 512 + hslot * 128 + 4 * g;
#pragma unroll
            for (int cc = 0; cc < 8; ++cc) { u32x2 w; w.x = pk2(o[cc][0], o[cc][1]); w.y = pk2(o[cc][2], o[cc][3]); *(u32x2*)(orow + 16 * cc) = w; }
            if (g == 0) ((float*)(ws + WS_LSE))[((size_t)grp * MTOK + row) * 4 + hslot] = lse;
            __syncthreads();
        }
    }
}
__device__ __forceinline__ void p3_combine(const Args& a, int gtid, int NT) {
    unsigned char* ws = a.ws; const float* lse = (const float*)(ws + WS_LSE); const bf16* og = (const bf16*)(ws + WS_DILG); bf16* out = (bf16*)(ws + WS_ATT);
    for (int i = gtid; i < MTOK * 64; i += NT) {
        const int row = i >> 6, ch = i & 63, slot = ch >> 4;
        const float l0 = lse[((size_t)0 * MTOK + row) * 4 + slot], l1 = lse[((size_t)1 * MTOK + row) * 4 + slot], l2 = lse[((size_t)2 * MTOK + row) * 4 + slot];
        const float mx = fmaxf(l0, fmaxf(l1, l2)); float w0 = __expf(l0 - mx), w1 = __expf(l1 - mx), w2 = __expf(l2 - mx); const float inv = 1.0f / (w0 + w1 + w2); w0 *= inv; w1 *= inv; w2 *= inv;
        const u32x4 a0 = *(const u32x4*)(og + ((size_t)0 * MTOK + row) * 512 + 8 * ch), a1 = *(const u32x4*)(og + ((size_t)1 * MTOK + row) * 512 + 8 * ch), a2 = *(const u32x4*)(og + ((size_t)2 * MTOK + row) * 512 + 8 * ch);
        u32x4 r;
        r.x = pk2(w0 * bfl(a0.x) + w1 * bfl(a1.x) + w2 * bfl(a2.x), w0 * bfh(a0.x) + w1 * bfh(a1.x) + w2 * bfh(a2.x));
        r.y = pk2(w0 * bfl(a0.y) + w1 * bfl(a1.y) + w2 * bfl(a2.y), w0 * bfh(a0.y) + w1 * bfh(a1.y) + w2 * bfh(a2.y));
        r.z = pk2(w0 * bfl(a0.z) + w1 * bfl(a1.z) + w2 * bfl(a2.z), w0 * bfh(a0.z) + w1 * bfh(a1.z) + w2 * bfh(a2.z));
        r.w = pk2(w0 * bfl(a0.w) + w1 * bfl(a1.w) + w2 * bfl(a2.w), w0 * bfh(a0.w) + w1 * bfh(a1.w) + w2 * bfh(a2.w));
        *(u32x4*)(out + (size_t)row * ATT_LD + 8 * ch) = r;
    }
}

__device__ __forceinline__ void p6_ln1_router(const Args& a, LAS unsigned char* lds, int wave, int lane, bool do_route = true) {
    unsigned char* ws = a.ws; const float* Y = a.out; bf16* HI = (bf16*)(ws + WS_ACT); bf16* LO = (bf16*)(ws + WS_LO); float* st = (float*)(ws + WS_STATS1);
    const bf16* WH = (const bf16*)(ws + WS_WRH); const bf16* WL = (const bf16*)(ws + WS_WRL);
    LAS float* P = (LAS float*)lds;
    LAS float* BIAS = P + 64 * NRW;
    const float* g1 = a.in[IN_LN1G]; const float* b1 = a.in[IN_LN1B];
    for (int rg = blockIdx.x; rg < MTOK / 64; rg += gridDim.x) {
        if (threadIdx.x < 8) BIAS[threadIdx.x] = a.in[IN_BRG][threadIdx.x]; else if (threadIdx.x < 72) BIAS[threadIdx.x] = a.in[IN_BRE][threadIdx.x - 8];
#pragma unroll 1
        for (int i4 = 0; i4 < 2; ++i4) {
            const int m0 = rg * 64 + wave * 8 + i4 * 4;
            f32x4 v[4][8]; float s[4];
#pragma unroll
            for (int r = 0; r < 4; ++r) { const float* yr = Y + (size_t)(m0 + r) * DM + 4 * lane;
#pragma unroll
                for (int j = 0; j < 8; ++j) v[r][j] = *(const f32x4*)(yr + 256 * j); }
#pragma unroll
            for (int r = 0; r < 4; ++r) { s[r] = 0.f;
#pragma unroll
                for (int j = 0; j < 8; ++j) s[r] += (v[r][j].x + v[r][j].y) + (v[r][j].z + v[r][j].w); }
#pragma unroll
            for (int o = 1; o < 64; o <<= 1) {
#pragma unroll
                for (int r = 0; r < 4; ++r) s[r] += __shfl_xor(s[r], o); }
            float mean[4], s2[4];
#pragma unroll
            for (int r = 0; r < 4; ++r) { mean[r] = s[r] * (1.f / DM); s2[r] = 0.f;
#pragma unroll
                for (int j = 0; j < 8; ++j) { v[r][j] = v[r][j] - mean[r]; s2[r] += (v[r][j].x * v[r][j].x + v[r][j].y * v[r][j].y) + (v[r][j].z * v[r][j].z + v[r][j].w * v[r][j].w); } }
#pragma unroll
            for (int o = 1; o < 64; o <<= 1) {
#pragma unroll
                for (int r = 0; r < 4; ++r) s2[r] += __shfl_xor(s2[r], o); }
#pragma unroll
            for (int r = 0; r < 4; ++r) { const int m = m0 + r; const float rstd = 1.0f / sqrtf(s2[r] * (1.f / DM) + LN_EPS);
                if (lane == 0) { st[2 * m] = mean[r]; st[2 * m + 1] = rstd; }
                bf16* hrow = HI + (size_t)m * DM + 4 * lane; bf16* lrow = LO + (size_t)m * DM + 4 * lane;
#pragma unroll
                for (int j = 0; j < 8; ++j) { const f32x4 gv = *(const f32x4*)(g1 + 256 * j + 4 * lane), bv = *(const f32x4*)(b1 + 256 * j + 4 * lane); const f32x4 y = v[r][j] * rstd * gv + bv;
                    u32x2 h; h.x = pk2(y.x, y.y); h.y = pk2(y.z, y.w);
                    u32x2 l; l.x = pk2(y.x - bfl(h.x), y.y - bfh(h.x)); l.y = pk2(y.z - bfl(h.y), y.w - bfh(h.y));
                    *(u32x2*)(hrow + 256 * j) = h; *(u32x2*)(lrow + 256 * j) = l; } }
        }
        VM_WAIT(); __syncthreads();
        {
            const int fr = lane & 15, fq = lane >> 4;
            const size_t aoff = (size_t)(rg * 64 + fr) * DM + wave * 256 + 8 * fq, boff = (size_t)fr * DM + wave * 256 + 8 * fq;
            f32x4 acc[4][5];
#pragma unroll
            for (int rb = 0; rb < 4; ++rb)
#pragma unroll
                for (int cb = 0; cb < 5; ++cb) acc[rb][cb] = (f32x4){0.f, 0.f, 0.f, 0.f};
#pragma unroll 2
            for (int s = 0; s < 8; ++s) {
                bf16x8 bh[5], bl[5];
#pragma unroll
                for (int cb = 0; cb < 5; ++cb) { bh[cb] = *(const bf16x8*)(WH + boff + (size_t)(16 * cb) * DM + 32 * s); bl[cb] = *(const bf16x8*)(WL + boff + (size_t)(16 * cb) * DM + 32 * s); }
#pragma unroll
                for (int rb = 0; rb < 4; ++rb) { const bf16x8 ah = *(const bf16x8*)(HI + aoff + (size_t)(16 * rb) * DM + 32 * s), al = *(const bf16x8*)(LO + aoff + (size_t)(16 * rb) * DM + 32 * s);
#pragma unroll
                    for (int cb = 0; cb < 5; ++cb) {
                        acc[rb][cb] = __builtin_amdgcn_mfma_f32_16x16x32_bf16(ah, bh[cb], acc[rb][cb], 0, 0, 0);
                        acc[rb][cb] = __builtin_amdgcn_mfma_f32_16x16x32_bf16(ah, bl[cb], acc[rb][cb], 0, 0, 0);
                        acc[rb][cb] = __builtin_amdgcn_mfma_f32_16x16x32_bf16(al, bh[cb], acc[rb][cb], 0, 0, 0); } }
            }
            LAS float* T = P + (wave >> 2) * (64 * NRW + 128);
#pragma unroll 1
            for (int k = 0; k < 4; ++k) {
                if ((wave & 3) == k) {
#pragma unroll
                    for (int rb = 0; rb < 4; ++rb)
#pragma unroll
                        for (int cb = 0; cb < 5; ++cb)
#pragma unroll
                            for (int r = 0; r < 4; ++r) { LAS float* p = &T[(16 * rb + 4 * fq + r) * NRW + 16 * cb + fr]; *p = (k == 0 ? 0.f : *p) + acc[rb][cb][r]; }
                }
                __syncthreads();
            }
        }
        if (threadIdx.x < 64 && do_route) {
            const int t = threadIdx.x, m = rg * 64 + t; const LAS float* p0 = P + (size_t)t * NRW; const LAS float* p1 = p0 + (64 * NRW + 128);
            float gl[8]; int gs = 0; float gm = -INFINITY;
#pragma unroll
            for (int n = 0; n < 8; ++n) { gl[n] = p0[n] + p1[n] + BIAS[n]; if (gl[n] > gm) { gm = gl[n]; gs = n; } }
            float gsum = 0.f;
#pragma unroll
            for (int n = 0; n < 8; ++n) gsum += __expf(gl[n] - gm);
            const float gprob = 1.0f / gsum;
            float v0 = -INFINITY, v1 = -INFINITY; int i0 = 0, i1 = 0;
#pragma unroll
            for (int n = 0; n < 8; ++n) { const float ev = p0[8 + gs * 8 + n] + p1[8 + gs * 8 + n] + BIAS[8 + gs * 8 + n];
                if (ev > v0) { v1 = v0; i1 = i0; v0 = ev; i0 = n; } else if (ev > v1) { v1 = ev; i1 = n; } }
            const float e1 = __expf(v1 - v0), w0 = gprob / (1.0f + e1), w1 = gprob * e1 / (1.0f + e1);
            const int x0 = gs * 8 + i0, x1 = gs * 8 + i1;
            unsigned* cnt = (unsigned*)(ws + WS_CTL);
            const unsigned q0 = atomicAdd(cnt + x0, 1u), q1 = atomicAdd(cnt + x1, 1u);
            int* te = (int*)(ws + WS_TOKE); float* tw = (float*)(ws + WS_TOKW); int* tp = (int*)(ws + WS_TOKP);
            te[2 * m] = x0; te[2 * m + 1] = x1; tw[2 * m] = w0; tw[2 * m + 1] = w1; tp[2 * m] = (int)q0; tp[2 * m + 1] = (int)q1;
            int* list = (int*)(ws + WS_LIST); list[(size_t)x0 * 16384 + q0] = m; list[(size_t)x1 * 16384 + q1] = m;
        }
        __syncthreads();
    }
}
constexpr int MOE_TAB_OFF = 147456;
__device__ __forceinline__ void moe_tables(const Args& a, LAS unsigned char* lds) {
    LAS int* tab = (LAS int*)(lds + MOE_TAB_OFF); const unsigned* cnt = (const unsigned*)(a.ws + WS_CTL);
    __syncthreads();
    if (threadIdx.x < NEXP) tab[448 + threadIdx.x] = (int)__hip_atomic_load(cnt + threadIdx.x, __ATOMIC_RELAXED, __HIP_MEMORY_SCOPE_AGENT);
    __syncthreads();
    if (threadIdx.x == 0) { int pos = 0, nt = 0;
        for (int e = 0; e < NEXP; ++e) { const int c = tab[448 + e], ne = (c + 255) >> 8; tab[384 + e] = pos;
            for (int j = 0; j < ne; ++j) { tab[nt + j] = e; tab[192 + nt + j] = 256 * j; }
            nt += ne; pos += 256 * ne; }
        tab[512] = nt; }
    __syncthreads();
}
__device__ __forceinline__ void p10_final(const Args& a, LAS unsigned char* lds, int gw, int NGW, int lane, float* dstbase) {
    unsigned char* ws = a.ws; float* Y = a.out; const float* st = (const float*)(ws + WS_STATS1); const bf16* YS = (const bf16*)(ws + WS_YS);
    const int* te = (const int*)(ws + WS_TOKE); const int* tp = (const int*)(ws + WS_TOKP); const float* tw = (const float*)(ws + WS_TOKW); const LAS int* tab = (const LAS int*)(lds + MOE_TAB_OFF);
    const float* g1 = a.in[IN_LN1G]; const float* b1 = a.in[IN_LN1B]; const float* g2 = a.in[IN_LN2G]; const float* b2 = a.in[IN_LN2B];
    for (int m = gw; m < MTOK; m += NGW) {
        float* yr = Y + (size_t)m * DM + 4 * lane; const float mu = st[2 * m], rs = st[2 * m + 1];
        const int s0 = tab[384 + te[2 * m]] + tp[2 * m], s1 = tab[384 + te[2 * m + 1]] + tp[2 * m + 1]; const float w0 = tw[2 * m], w1 = tw[2 * m + 1];
        const bf16* e0 = YS + (size_t)s0 * DM + 4 * lane; const bf16* e1 = YS + (size_t)s1 * DM + 4 * lane;
        f32x4 v[8]; float s = 0.f;
#pragma unroll
        for (int j = 0; j < 8; ++j) { const f32x4 y = *(const f32x4*)(yr + 256 * j); const f32x4 gv = *(const f32x4*)(g1 + 256 * j + 4 * lane), bv = *(const f32x4*)(b1 + 256 * j + 4 * lane);
            const u32x2 c0 = *(const u32x2*)(e0 + 256 * j), c1 = *(const u32x2*)(e1 + 256 * j);
            f32x4 f; f.x = w0 * bfl(c0.x) + w1 * bfl(c1.x); f.y = w0 * bfh(c0.x) + w1 * bfh(c1.x); f.z = w0 * bfl(c0.y) + w1 * bfl(c1.y); f.w = w0 * bfh(c0.y) + w1 * bfh(c1.y);
            v[j] = ((y - mu) * rs * gv + bv) * DN_ALPHA + f; s += (v[j].x + v[j].y) + (v[j].z + v[j].w); }
        const float mean = wave_sum(s) * (1.f / DM); float s2 = 0.f;
#pragma unroll
        for (int j = 0; j < 8; ++j) { v[j] = v[j] - mean; s2 += (v[j].x * v[j].x + v[j].y * v[j].y) + (v[j].z * v[j].z + v[j].w * v[j].w); }
        const float rstd = 1.0f / sqrtf(wave_sum(s2) * (1.f / DM) + LN_EPS);
#pragma unroll
        for (int j = 0; j < 8; ++j) { const f32x4 gv = *(const f32x4*)(g2 + 256 * j + 4 * lane), bv = *(const f32x4*)(b2 + 256 * j + 4 * lane); *(f32x4*)(dstbase + (size_t)m * DM + 4 * lane + 256 * j) = v[j] * rstd * gv + bv; }
    }
}

__device__ __forceinline__ int fresh_lane() { int l = (int)(threadIdx.x & 63u); asm volatile("" : "+v"(l)); return l; }
constexpr int N_PHASES = 10;
#ifndef HELPER_ROWS
#define HELPER_ROWS 1
#endif
__global__ void __launch_bounds__(NTHREADS, 2) mk_fwd(Args args) {
    extern __shared__ __attribute__((aligned(16))) unsigned char lds_raw[];
    LAS unsigned char* lds = (LAS unsigned char*)lds_raw;
    const int tid = threadIdx.x, wave = __builtin_amdgcn_readfirstlane(tid >> 6);
#define lane fresh_lane()
    const int G = gridDim.x, gw = blockIdx.x * NWAVES + wave, NGW = G * NWAVES;
    unsigned char* ws = args.ws;
    const int vcu = (G % 8 == 0) ? ((int)blockIdx.x % 8) * (G / 8) + (int)blockIdx.x / 8 : (int)blockIdx.x;
    const int lo = args.ph_lo, hi = args.ph_hi;
#ifndef PHASE_MASK
#define PHASE_MASK 0x3ff
#endif
#define IN(k) (((PHASE_MASK >> (k)) & 1) && lo <= (k) && (k) < hi)
#ifndef DOUBLE_PHASE
#define DOUBLE_PHASE 0
#endif
#define REP(k) for (int rep_ = 0; rep_ < (((DOUBLE_PHASE >> (k)) & 1) ? 2 : 1); ++rep_)
#if MK_N_LAUNCHES == 1
    cg::grid_group grid = cg::this_grid();
    { volatile LAS unsigned* st = (volatile LAS unsigned*)(lds + XB_LDS_OFF); if (tid < 2) st[tid] = 0u; }
    __syncthreads();
    const XcdBarrier bar = xcd_barrier_post((unsigned*)(ws + WS_BAR), (volatile LAS unsigned*)(lds + XB_LDS_OFF));
#define SEAM(k) do { if (IN(k) && IN((k) + 1)) { if (CG_SEAM_MASK >> (k) & 1) grid.sync(); else xcd_barrier(bar); } } while (0)
#else
#define SEAM(k) do { } while (0)
#endif
    if (IN(0)) REP(0) p0_prologue(args, lds, gw, NGW, wave, lane);
    SEAM(0);
    if (IN(1)) REP(1) { pg8::Gemm g{(const bf16*)(ws + WS_ACT), (const bf16*)(ws + WS_WIN), MTOK, DIN, DM}; pg8::StaticOrder S; S.init(MTOK, DIN, G, (int)blockIdx.x);
        pg8::EpiZ E{(bf16*)(ws + WS_Z), DIN, args.in[IN_BIN], OFF_GA / 256};
        pg8::gemm_phase<pg8::EpiZ, pg8::StaticOrder, true, true>(lds, g, S, E); }
    SEAM(1);
    if (IN(2)) REP(2) p2_attention(args, lds, wave, lane);
    SEAM(2);
    if (IN(3)) REP(3) p3_combine(args, blockIdx.x * NTHREADS + tid, G * NTHREADS);
    SEAM(3);
    if (IN(4)) REP(4) { pg8::Gemm g{(const bf16*)(ws + WS_ATT), (const bf16*)(ws + WS_WAB), MTOK, DM, ATT_LD}; pg8::StaticOrder S; S.init(MTOK, DM, G, (int)blockIdx.x);
        pg8::EpiMix E{(bf16*)(ws + WS_ACT), (const bf16*)(ws + WS_Z) + OFF_GA, (const bf16*)(ws + WS_Z) + OFF_GB, DIN};
        pg8::gemm_phase<pg8::EpiMix, pg8::StaticOrder, true, true>(lds, g, S, E); }
    SEAM(4);
    if (IN(5)) REP(5) { pg8::Gemm g{(const bf16*)(ws + WS_ACT), (const bf16*)(ws + WS_WO), MTOK, DM, DM}; pg8::StaticOrder S; S.init(MTOK, DM, G, (int)blockIdx.x);
        pg8::EpiY1 E{args.out, args.in[IN_X], (const float*)(ws + WS_STATS0), args.in[IN_LN0G], args.in[IN_LN0B], args.in[IN_BO], DN_ALPHA};
        pg8::gemm_phase<pg8::EpiY1, pg8::StaticOrder, true, true>(lds, g, S, E); }
    SEAM(5);
    if (IN(6)) REP(6) p6_ln1_router(args, lds, wave, lane, rep_ == (((DOUBLE_PHASE >> 6) & 1) ? 1 : 0));
    SEAM(6);
    if (IN(7)) REP(7) { moe_tables(args, lds);
        pg8::Gemm g{(const bf16*)(ws + WS_ACT), (const bf16*)(ws + WS_WUP), PMAX, NEXP * 1024, DM};
        pg8::MoeOrder<true, 2> S{(const LAS int*)(lds + MOE_TAB_OFF), (const int*)(ws + WS_LIST), G, vcu};
        pg8::EpiSwiGLU E{(bf16*)(ws + WS_HID)};
        pg8::gemm_phase<pg8::EpiSwiGLU, pg8::MoeOrder<true, 2>, true, true>(lds, g, S, E); }
    SEAM(7);
    if (IN(8)) REP(8) { moe_tables(args, lds);
        pg8::Gemm g{(const bf16*)(ws + WS_HID), (const bf16*)(ws + WS_WDN), PMAX, NEXP * 2048, DEXP};
        pg8::MoeOrder<false, 3> S{(const LAS int*)(lds + MOE_TAB_OFF), nullptr, G, vcu};
        pg8::EpiYs E{(bf16*)(ws + WS_YS), DM, 7};
        pg8::gemm_phase<pg8::EpiYs, pg8::MoeOrder<false, 3>, true, true>(lds, g, S, E); }
    SEAM(8);
    if (IN(9)) REP(9) { moe_tables(args, lds); p10_final(args, lds, gw, NGW, lane, (((DOUBLE_PHASE >> 9) & 1) && rep_ == 0) ? (float*)(ws + WS_WUP) : args.out); }
#undef lane
#undef IN
#undef SEAM
}

extern "C" void kernel_launch(void* const* d_in, const int* in_sizes, int n_in, void* d_out, int out_size, void* d_ws, size_t ws_size, hipStream_t stream) {
    static int grid = 0;
    if (grid == 0) {
        if (n_in != 21 || in_sizes[0] != MTOK * DM || out_size != MTOK * DM || ws_size < WS_END) { fprintf(stderr, "kernel_launch: unexpected shapes (n_in %d, in0 %d, out %d, ws %zu < %zu)\n", n_in, n_in > 0 ? in_sizes[0] : -1, out_size, ws_size, (size_t)WS_END); grid = -1; return; }
        int dev = 0, cus = 0, per_cu = 0;
        if (hipGetDevice(&dev) != hipSuccess || hipDeviceGetAttribute(&cus, hipDeviceAttributeMultiprocessorCount, dev) != hipSuccess) { fprintf(stderr, "kernel_launch: device query failed\n"); grid = -1; return; }
        if (hipFuncSetAttribute((const void*)mk_fwd, hipFuncAttributeMaxDynamicSharedMemorySize, LDS_BYTES) != hipSuccess) { fprintf(stderr, "kernel_launch: hipFuncSetAttribute failed\n"); grid = -1; return; }
        if (hipOccupancyMaxActiveBlocksPerMultiprocessor(&per_cu, (const void*)mk_fwd, NTHREADS, LDS_BYTES) != hipSuccess || per_cu < 1) { fprintf(stderr, "kernel_launch: occupancy query says %d blocks per CU\n", per_cu); (void)hipGetLastError(); per_cu = 1; }
        grid = cus * 1;
        fprintf(stderr, "kernel_launch: %d CUs, occupancy %d per CU, grid %d\n", cus, per_cu, grid);
    }
    if (grid < 0) return;
    if (hipMemsetAsync((char*)d_ws + WS_CTL, 0, CTL_ZERO_BYTES, stream) != hipSuccess) { fprintf(stderr, "kernel_launch: memset failed\n"); return; }
    Args a{};
    for (int i = 0; i < 21; ++i) a.in[i] = (const float*)d_in[i];
    a.out = (float*)d_out; a.ws = (unsigned char*)d_ws;
#if MK_N_LAUNCHES == 1
    a.ph_lo = 0; a.ph_hi = N_PHASES;
    void* kargs[] = {&a};
    hipError_t e = hipLaunchCooperativeKernel((const void*)mk_fwd, dim3(grid), dim3(NTHREADS), kargs, LDS_BYTES, stream);
    if (e != hipSuccess) fprintf(stderr, "kernel_launch: cooperative launch failed: %s (grid %d)\n", hipGetErrorString(e), grid);
#else
    for (int p = 0; p < N_PHASES; ++p) { a.ph_lo = p; a.ph_hi = p + 1; hipLaunchKernelGGL(mk_fwd, dim3(grid), dim3(NTHREADS), LDS_BYTES, stream, a);
        const hipError_t le = hipPeekAtLastError(); if (le != hipSuccess) { fprintf(stderr, "kernel_launch: launch %d failed: %s\n", p, hipGetErrorName(le)); break; } }
#endif
}
```
